# Optimizing an MI355X kernel written in HIP

```python
import jax, jax.numpy as jnp
from jax import lax
import numpy as np

D_MODEL = 1024
BATCH = 8
SEQ = 4096
DEPTH = 1

HEAD_DIM = 64
SB_HEADS = 8
SWA_HEADS = 8
SWA_KV_HEADS = 2
SWA_WINDOW = 128
MEM_HEADS = 4
MEM_HEAD_DIM = 128
MEM_LEN = 256
Q_BLOCK = 128
N_BRANCH = 3
N_EXPERTS = 256
TOP_K = 8
N_GROUPS = 8
TOPK_GROUPS = 4
EXPERT_FF = 256
SHARED_FF = 256
ROUTED_SCALE = 2.5
MOE_BLOCK = 512
LN_EPS = 1e-5
DEEPNORM_ALPHA = (2 * DEPTH) ** 0.25
DEEPNORM_BETA = (8 * DEPTH) ** -0.25

SB_W = SB_HEADS * HEAD_DIM
SWA_Q_W = SWA_HEADS * HEAD_DIM
SWA_KV_W = SWA_KV_HEADS * HEAD_DIM
MEM_W = MEM_HEADS * MEM_HEAD_DIM
IN_SIZES = (SB_W, SB_W, SB_W, SWA_Q_W, SWA_KV_W, SWA_KV_W, MEM_W, N_BRANCH * D_MODEL)
IN_COLS = sum(IN_SIZES)

kernel_name = "hybrid_sb_swa_mem_moe_deepnorm"


def layer_norm(h, g, b):
    hf = h.astype(jnp.float32)
    mu = hf.mean(-1, keepdims=True)
    var = jnp.square(hf - mu).mean(-1, keepdims=True)
    y = (hf - mu) * lax.rsqrt(var + LN_EPS)
    return (y * g.astype(jnp.float32) + b.astype(jnp.float32)).astype(h.dtype)


def stick_breaking_attention(q, k, v):
    B, S, H, d = q.shape
    nblk = S // Q_BLOCK
    scale = d ** -0.5
    r = jnp.arange(Q_BLOCK)
    incl = (r[:, None] >= r[None, :]).astype(jnp.float32)
    outs = []
    for i in range(nblk):
        L = (i + 1) * Q_BLOCK
        z = jnp.einsum('bqhd,bshd->bhqs', q[:, i * Q_BLOCK:L], k[:, :L],
                       preferred_element_type=jnp.float32) * scale
        causal = jnp.arange(L)[None, :] < (i * Q_BLOCK + r)[:, None]
        log_1m = jnp.where(causal, jax.nn.log_sigmoid(-z), 0.0)
        lb = log_1m.reshape(B, H, Q_BLOCK, i + 1, Q_BLOCK)
        within = jnp.einsum('bhqkj,js->bhqks', lb, incl, precision=lax.Precision.HIGHEST)
        m = jnp.arange(i + 1)
        strict = (m[:, None] > m[None, :]).astype(jnp.float32)
        later = jnp.einsum('bhqm,mk->bhqk', lb.sum(-1), strict,
                           precision=lax.Precision.HIGHEST)
        suffix = (within + later[..., None]).reshape(B, H, Q_BLOCK, L) - log_1m
        a = jnp.where(causal, jnp.exp(jax.nn.log_sigmoid(z) + suffix), 0.0)
        outs.append(jnp.einsum('bhqs,bshd->bqhd', a.astype(v.dtype), v[:, :L]))
    return jnp.concatenate(outs, axis=1).reshape(B, S, H * d)


def sliding_window_attention(q, k, v, sinks):
    B, S, Hq, d = q.shape
    Hkv = k.shape[2]
    G = Hq // Hkv
    nblk = S // Q_BLOCK
    scale = d ** -0.5
    qb = q.reshape(B, nblk, Q_BLOCK, Hkv, G, d)

    def band(t):
        tb = t.reshape(B, nblk, Q_BLOCK, Hkv, d)
        prev = jnp.pad(tb[:, :-1], ((0, 0), (1, 0), (0, 0), (0, 0), (0, 0)))
        return jnp.concatenate([prev, tb], axis=2)

    kb, vb = band(k), band(v)
    z = jnp.einsum('bnqhgd,bnkhd->bnhgqk', qb, kb,
                   preferred_element_type=jnp.float32) * scale
    q_rel = jnp.arange(Q_BLOCK)[:, None] + Q_BLOCK
    k_rel = jnp.arange(2 * Q_BLOCK)[None, :]
    dist = (q_rel - k_rel).astype(jnp.float32)
    in_window = (dist >= 0) & (dist < SWA_WINDOW)
    real_key = (jnp.arange(nblk)[:, None, None] > 0) | (k_rel[None] >= Q_BLOCK)
    mask = in_window[None] & real_key
    slopes = jnp.exp2(-8.0 * jnp.arange(1, Hq + 1, dtype=jnp.float32) / Hq)
    alibi = -slopes.reshape(Hkv, G)[:, :, None, None] * dist
    z = jnp.where(mask[None, :, None, None], z + alibi, -jnp.inf)
    sink = jnp.broadcast_to(sinks.astype(jnp.float32).reshape(Hkv, G)[:, :, None, None],
                            z.shape[:-1] + (1,))
    p = jax.nn.softmax(jnp.concatenate([z, sink], axis=-1), axis=-1)[..., :-1]
    o = jnp.einsum('bnhgqk,bnkhd->bnqhgd', p.astype(vb.dtype), vb)
    return o.reshape(B, S, Hq * d)


def memory_attention(q, mem_k, mem_v):
    B, S, H, d = q.shape
    z = jnp.einsum('bshd,bmhd->bhsm', q, mem_k,
                   preferred_element_type=jnp.float32) * d ** -0.5
    p = jax.nn.softmax(z, axis=-1)
    o = jnp.einsum('bhsm,bmhd->bshd', p.astype(mem_v.dtype), mem_v)
    return o.reshape(B, S, H * d)


def swiglu(h, w_gu, w_down):
    gate, up = jnp.split(h @ w_gu, 2, axis=-1)
    return (jax.nn.silu(gate) * up) @ w_down


def moe(u, w_router, router_bias, w_e_gu, w_e_down, w_s_gu, w_s_down):
    B, S, D = u.shape
    t = u.reshape(B * S, D)
    T = t.shape[0]
    scores = jax.nn.sigmoid((t @ w_router).astype(jnp.float32))
    biased = scores + router_bias.astype(jnp.float32)
    grp = biased.reshape(T, N_GROUPS, N_EXPERTS // N_GROUPS)
    grp_score = lax.top_k(grp, 2)[0].sum(-1)
    _, top_grp = lax.top_k(grp_score, TOPK_GROUPS)
    grp_mask = jax.nn.one_hot(top_grp, N_GROUPS, dtype=jnp.float32).sum(1) > 0
    expert_mask = jnp.repeat(grp_mask, N_EXPERTS // N_GROUPS, axis=1)
    _, idx = lax.top_k(jnp.where(expert_mask, biased, -jnp.inf), TOP_K)
    w = jnp.take_along_axis(scores, idx, axis=-1)
    w = w / w.sum(-1, keepdims=True) * ROUTED_SCALE
    n_slots = T * TOP_K
    flat_e = idx.reshape(-1)
    order = jnp.argsort(flat_e)
    sorted_e = flat_e[order]
    tok = order // TOP_K
    sizes = jnp.bincount(flat_e, length=N_EXPERTS).astype(jnp.int32)
    padded = (sizes + MOE_BLOCK - 1) // MOE_BLOCK * MOE_BLOCK
    start = jnp.cumsum(sizes) - sizes
    pad_start = jnp.cumsum(padded) - padded
    dest = pad_start[sorted_e] + jnp.arange(n_slots, dtype=jnp.int32) - start[sorted_e]
    n_blocks = -(-n_slots // MOE_BLOCK) + N_EXPERTS
    xs = jnp.zeros((n_blocks * MOE_BLOCK, D), t.dtype).at[dest].set(t[tok])
    blk_start = jnp.arange(n_blocks, dtype=jnp.int32) * MOE_BLOCK
    blk_e = jnp.minimum(((pad_start + padded)[None, :] <= blk_start[:, None]).sum(-1),
                        N_EXPERTS - 1)
    xb = xs.reshape(n_blocks, MOE_BLOCK, D)
    gate, up = jnp.split(jnp.einsum('nbd,ndf->nbf', xb, w_e_gu[blk_e]), 2, axis=-1)
    yb = jnp.einsum('nbf,nfd->nbd', jax.nn.silu(gate) * up, w_e_down[blk_e])
    ys = yb.reshape(n_blocks * MOE_BLOCK, D)[dest]
    ys = ys * w.reshape(-1)[order][:, None].astype(ys.dtype)
    routed = jnp.zeros_like(t).at[tok].add(ys)
    shared = swiglu(t, w_s_gu, w_s_down)
    return (routed + shared).reshape(B, S, D)


def setup_inputs(seed: int = 0) -> dict:
    key = jax.random.key(seed)
    ks = jax.random.split(key, 24)
    nrm = lambda k, shape, fan_in, s=1.0: jax.random.normal(k, shape, jnp.float32) * (fan_in ** -0.5) * s
    col_scale = jnp.concatenate([
        jnp.ones(2 * SB_W), jnp.full((SB_W,), DEEPNORM_BETA),
        jnp.ones(SWA_Q_W + SWA_KV_W), jnp.full((SWA_KV_W,), DEEPNORM_BETA),
        jnp.ones(MEM_W + N_BRANCH * D_MODEL)])
    mem_scale = jnp.concatenate([jnp.ones(MEM_W), jnp.full((MEM_W,), DEEPNORM_BETA)])
    return {
        "x": jax.random.normal(ks[0], (BATCH, SEQ, D_MODEL), jnp.float32),
        "mem": jax.random.normal(ks[1], (BATCH, MEM_LEN, D_MODEL), jnp.float32),
        "w_in": nrm(ks[2], (D_MODEL, IN_COLS), D_MODEL) * col_scale,
        "b_gate": 0.02 * jax.random.normal(ks[3], (N_BRANCH * D_MODEL,), jnp.float32),
        "w_mem_kv": nrm(ks[4], (D_MODEL, 2 * MEM_W), D_MODEL) * mem_scale,
        "sinks": 0.5 * jax.random.normal(ks[5], (SWA_HEADS,), jnp.float32),
        "w_o_sb": nrm(ks[6], (SB_W, D_MODEL), SB_W),
        "w_o_swa": nrm(ks[7], (SWA_Q_W, D_MODEL), SWA_Q_W),
        "w_o_mem": nrm(ks[8], (MEM_W, D_MODEL), MEM_W),
        "w_out": nrm(ks[9], (D_MODEL, D_MODEL), D_MODEL, DEEPNORM_BETA),
        "ln1_g": 1.0 + 0.02 * jax.random.normal(ks[10], (D_MODEL,), jnp.float32),
        "ln1_b": 0.02 * jax.random.normal(ks[11], (D_MODEL,), jnp.float32),
        "w_router": nrm(ks[12], (D_MODEL, N_EXPERTS), D_MODEL),
        "router_bias": 0.01 * jax.random.normal(ks[13], (N_EXPERTS,), jnp.float32),
        "w_e_gu": nrm(ks[14], (N_EXPERTS, D_MODEL, 2 * EXPERT_FF), D_MODEL),
        "w_e_down": nrm(ks[15], (N_EXPERTS, EXPERT_FF, D_MODEL), EXPERT_FF, DEEPNORM_BETA),
        "w_s_gu": nrm(ks[16], (D_MODEL, 2 * SHARED_FF), D_MODEL),
        "w_s_down": nrm(ks[17], (SHARED_FF, D_MODEL), SHARED_FF, DEEPNORM_BETA),
        "ln2_g": 1.0 + 0.02 * jax.random.normal(ks[18], (D_MODEL,), jnp.float32),
        "ln2_b": 0.02 * jax.random.normal(ks[19], (D_MODEL,), jnp.float32),
    }


def reference(x, mem, w_in, b_gate, w_mem_kv, sinks, w_o_sb, w_o_swa, w_o_mem, w_out,
              ln1_g, ln1_b, w_router, router_bias, w_e_gu, w_e_down, w_s_gu, w_s_down,
              ln2_g, ln2_b):
    B, S, D = x.shape
    offsets = np.cumsum(IN_SIZES)[:-1].tolist()
    for _ in range(DEPTH):
        proj = x @ w_in
        q_sb, k_sb, v_sb, q_sw, k_sw, v_sw, q_m, gate_logits = jnp.split(proj, offsets, axis=-1)
        o_sb = stick_breaking_attention(q_sb.reshape(B, S, SB_HEADS, HEAD_DIM),
                                        k_sb.reshape(B, S, SB_HEADS, HEAD_DIM),
                                        v_sb.reshape(B, S, SB_HEADS, HEAD_DIM))
        o_sw = sliding_window_attention(q_sw.reshape(B, S, SWA_HEADS, HEAD_DIM),
                                        k_sw.reshape(B, S, SWA_KV_HEADS, HEAD_DIM),
                                        v_sw.reshape(B, S, SWA_KV_HEADS, HEAD_DIM),
                                        sinks)
        mk, mv = jnp.split(mem @ w_mem_kv, 2, axis=-1)
        M = mem.shape[1]
        o_m = memory_attention(q_m.reshape(B, S, MEM_HEADS, MEM_HEAD_DIM),
                               mk.reshape(B, M, MEM_HEADS, MEM_HEAD_DIM),
                               mv.reshape(B, M, MEM_HEADS, MEM_HEAD_DIM))
        g_sb, g_sw, g_m = jnp.split(jax.nn.sigmoid(gate_logits + b_gate), N_BRANCH, axis=-1)
        merged = g_sb * (o_sb @ w_o_sb) + g_sw * (o_sw @ w_o_swa) + g_m * (o_m @ w_o_mem)
        x = layer_norm(DEEPNORM_ALPHA * x + merged @ w_out, ln1_g, ln1_b)
        x = layer_norm(DEEPNORM_ALPHA * x + moe(x, w_router, router_bias, w_e_gu, w_e_down,
                                                 w_s_gu, w_s_down), ln2_g, ln2_b)
    return x
```

```cpp
#define HYBRID 0
#include <hip/hip_runtime.h>
#include <stdint.h>
#include <math.h>
#include <cstdio>

constexpr int D = 1024, BATCH = 8, SEQ = 4096, T = BATCH * SEQ;
constexpr int MEM_LEN = 256, MROWS = BATCH * MEM_LEN;
constexpr int IN_COLS = 5888;
constexpr int OFF_QSB = 0, OFF_KSB = 512, OFF_VSB = 1024, OFF_QSW = 1536, OFF_KSW = 2048, OFF_VSW = 2176, OFF_QM = 2304, OFF_GATE = 2816;
constexpr int NE = 256, TOPK = 8, EFF = 256;
constexpr float LN_EPS = 1e-5f;
constexpr float ALPHA = 1.189207115002721f;
constexpr int NSLOT = T * TOPK;
constexpr float LOG2E = 1.4426950408889634f;
constexpr float QS64 = 0.125f * LOG2E;
constexpr float QS128 = 0.08838834764831845f * LOG2E;

constexpr float W8_SCALE = 64.f, W8_INV = 1.f / 64.f;
constexpr float O8_SCALE = 16.f, M8_SCALE = 16.f;
constexpr float H8_SCALE = 16.f;
constexpr float YS_SCALE = 16.f, YS_INV = 1.f / 16.f;
constexpr size_t MiB = 1u << 20;
constexpr size_t WS_CTL = 0, CTL_ZERO_BYTES = 1 * MiB;
constexpr size_t WS_WIN_T = 2 * MiB, WS_WMKV_T = 14 * MiB, WS_WOSB_T = 16 * MiB, WS_WOSW_T = 17 * MiB, WS_WOM_T = 18 * MiB, WS_WOUT_T = 19 * MiB, WS_WRS_T = 21 * MiB, WS_WSD_T = 23 * MiB;
constexpr size_t WS_WEGU_T = 24 * MiB, WS_WED_T = 280 * MiB;
constexpr size_t WS_XB = 408 * MiB, WS_MEMB = 472 * MiB, WS_MKVB = 476 * MiB, WS_PROJB = 480 * MiB;
constexpr size_t WS_OSB = 848 * MiB, WS_OSW = 880 * MiB, WS_OM = 912 * MiB, WS_MERGED = 944 * MiB, WS_Z = 1008 * MiB, WS_X1B = 1136 * MiB, WS_LOGITS = 1200 * MiB, WS_HS = 1232 * MiB, WS_SHOUT = 1248 * MiB;
constexpr size_t WS_XB8 = 1920 * MiB, WS_X1B8 = 1952 * MiB, WS_WG8_T = 1984 * MiB;
constexpr size_t WS_GT = 1728 * MiB;
constexpr size_t WS_ROUTE = 1312 * MiB, WS_HBUF = 1328 * MiB, WS_YS = 1460 * MiB, WS_END = 1988 * MiB;
constexpr size_t RT_IDX = 0, RT_WGT = 1 * MiB, RT_POS = 2 * MiB, RT_STOK = 3 * MiB  , RT_TILES = 5 * MiB  , RT_TILES64 = 6 * MiB  ;
constexpr int MAXT256 = NSLOT / 256 + NE;
constexpr int MAXT64 = NSLOT / 64 + NE;
constexpr int CW_COUNTS = 1024, CW_CURSOR = 1280, CW_QUEUE = 1536  , CW_BAR = 4096;

typedef unsigned short bf16;
typedef short bf16x8 __attribute__((ext_vector_type(8)));
typedef float f32x4 __attribute__((ext_vector_type(4)));
typedef float f32x16 __attribute__((ext_vector_type(16)));
typedef unsigned u32x4 __attribute__((ext_vector_type(4)));
typedef unsigned u32x2 __attribute__((ext_vector_type(2)));

__device__ __forceinline__ unsigned f2bf(float f) { unsigned u = __builtin_bit_cast(unsigned, f); return (u + 0x7fffu + ((u >> 16) & 1u)) >> 16; }
__device__ __forceinline__ unsigned pk2(float lo, float hi) { return f2bf(lo) | (f2bf(hi) << 16); }
__device__ __forceinline__ float bf2f(unsigned b) { return __builtin_bit_cast(float, b << 16); }
__device__ __forceinline__ float bflo(unsigned w) { return __builtin_bit_cast(float, w << 16); }
__device__ __forceinline__ float bfhi(unsigned w) { return __builtin_bit_cast(float, w & 0xffff0000u); }
__device__ __forceinline__ unsigned pack4_e4m3(float a, float b, float c, float d) {
    a = __builtin_amdgcn_fmed3f(a, -448.f, 448.f); b = __builtin_amdgcn_fmed3f(b, -448.f, 448.f); c = __builtin_amdgcn_fmed3f(c, -448.f, 448.f); d = __builtin_amdgcn_fmed3f(d, -448.f, 448.f);
    const unsigned w = __builtin_amdgcn_cvt_pk_fp8_f32(a, b, 0u, false); return __builtin_amdgcn_cvt_pk_fp8_f32(c, d, w, true);
}
__device__ __forceinline__ float wave_sum(float v) {
#pragma unroll
    for (int o = 1; o < 64; o <<= 1) v += __shfl_xor(v, o);
    return v;
}
__device__ __forceinline__ float sigmoidf_(float z) { return 1.f / (1.f + __expf(-z)); }
__device__ __forceinline__ float gate_sig(float z) { z = fminf(fmaxf(z, -30.f), 30.f); return __builtin_amdgcn_rcpf(1.f + __expf(-z)); }

__device__ __forceinline__ int lane_id() { int l; asm volatile("v_mbcnt_lo_u32_b32 %0, -1, 0\n\tv_mbcnt_hi_u32_b32 %0, -1, %0" : "=v"(l)); return l; }
__device__ __forceinline__ int otid(int wave) { int t = (wave << 6) | lane_id(); asm volatile("" : "+v"(t)); return t; }
__device__ __forceinline__ bool is_t0(int wave) { return wave == 0 && lane_id() == 0; }
namespace thin {
#define TLAS __attribute__((address_space(3)))
__device__ __forceinline__ void cvt_rows(const float* __restrict__ src, bf16* __restrict__ dst, unsigned char* __restrict__ dst8  , int rows, int gw, int ngw, int lane) {
    f32x4 cur[4], nxt[4];
    if (gw < rows) {
#pragma unroll
        for (int j = 0; j < 4; ++j) cur[j] = __builtin_nontemporal_load((const f32x4*)(src + (size_t)gw * D) + lane + 64 * j);
    }
    for (int r = gw; r < rows; r += ngw) {
        const int rn = (r + ngw < rows) ? r + ngw : r;
#pragma unroll
        for (int j = 0; j < 4; ++j) nxt[j] = __builtin_nontemporal_load((const f32x4*)(src + (size_t)rn * D) + lane + 64 * j);
        u32x2* d = (u32x2*)(dst + (size_t)r * D) + lane;
#pragma unroll
        for (int j = 0; j < 4; ++j) { u32x2 o; o.x = pk2(cur[j].x, cur[j].y); o.y = pk2(cur[j].z, cur[j].w); d[64 * j] = o; }
        if (dst8) { unsigned* d8 = (unsigned*)(dst8 + (size_t)r * D) + lane;
#pragma unroll
            for (int j = 0; j < 4; ++j) d8[64 * j] = pack4_e4m3(cur[j].x, cur[j].y, cur[j].z, cur[j].w); }
#pragma unroll
        for (int j = 0; j < 4; ++j) cur[j] = nxt[j];
    }
}
__device__ __forceinline__ void ln1_rows(const bf16* __restrict__ Z, const float* __restrict__ g, const float* __restrict__ bta, bf16* __restrict__ XB, unsigned char* __restrict__ XB8, int gw, int ngw, int lane) {
    u32x4 r0[2], r1[2], r2[2];
    const int ra = gw < T ? gw : T - 1, rb = gw + ngw < T ? gw + ngw : T - 1;
#pragma unroll
    for (int j = 0; j < 2; ++j) { r0[j] = __builtin_nontemporal_load((const u32x4*)(Z + (size_t)ra * D) + lane + 64 * j); r1[j] = __builtin_nontemporal_load((const u32x4*)(Z + (size_t)rb * D) + lane + 64 * j); }
    f32x4 gg[4], bb[4];
#pragma unroll
    for (int j = 0; j < 2; ++j) { gg[2 * j] = ((const f32x4*)g)[2 * lane + 128 * j]; gg[2 * j + 1] = ((const f32x4*)g)[2 * lane + 128 * j + 1]; bb[2 * j] = ((const f32x4*)bta)[2 * lane + 128 * j]; bb[2 * j + 1] = ((const f32x4*)bta)[2 * lane + 128 * j + 1]; }
    for (int r = gw; r < T; r += ngw) {
        const int rn = (r + 2 * ngw < T) ? r + 2 * ngw : r;
#pragma unroll
        for (int j = 0; j < 2; ++j) r2[j] = __builtin_nontemporal_load((const u32x4*)(Z + (size_t)rn * D) + lane + 64 * j);
        f32x4 v[4]; float s = 0.f;
#pragma unroll
        for (int j = 0; j < 2; ++j) { const u32x4 z = r0[j]; v[2 * j] = (f32x4){bflo(z.x), bfhi(z.x), bflo(z.y), bfhi(z.y)}; v[2 * j + 1] = (f32x4){bflo(z.z), bfhi(z.z), bflo(z.w), bfhi(z.w)}; }
#pragma unroll
        for (int j = 0; j < 4; ++j) s += (v[j].x + v[j].y) + (v[j].z + v[j].w);
        const float mean = wave_sum(s) * (1.f / D); float s2 = 0.f;
#pragma unroll
        for (int j = 0; j < 4; ++j) { v[j] = v[j] - mean; s2 += (v[j].x * v[j].x + v[j].y * v[j].y) + (v[j].z * v[j].z + v[j].w * v[j].w); }
        const float rstd = rsqrtf(wave_sum(s2) * (1.f / D) + LN_EPS);
        u32x4* xb = (u32x4*)(XB + (size_t)r * D) + lane;
        u32x2* x8 = (u32x2*)(XB8 + (size_t)r * D) + lane;
#pragma unroll
        for (int j = 0; j < 2; ++j) { const f32x4 o0 = v[2 * j] * rstd * gg[2 * j] + bb[2 * j], o1 = v[2 * j + 1] * rstd * gg[2 * j + 1] + bb[2 * j + 1];
            u32x4 w; w.x = pk2(o0.x, o0.y); w.y = pk2(o0.z, o0.w); w.z = pk2(o1.x, o1.y); w.w = pk2(o1.z, o1.w); xb[64 * j] = w;
            u32x2 q; q.x = pack4_e4m3(o0.x, o0.y, o0.z, o0.w); q.y = pack4_e4m3(o1.x, o1.y, o1.z, o1.w); x8[64 * j] = q; }
#pragma unroll
        for (int j = 0; j < 2; ++j) { r0[j] = r1[j]; r1[j] = r2[j]; }
    }
}
__device__ __forceinline__ void route(const float* __restrict__ logits, const float* __restrict__ rbias, int* __restrict__ idx, float* __restrict__ wgt, unsigned* __restrict__ counts,
                                      TLAS int* hist  , int wg, int nwg, int tid) {
    const int lane = tid & 63, wave = tid >> 6;
    if (tid < NE) hist[tid] = 0;
    __syncthreads();
    const int per = (T + nwg - 1) / nwg;
    const f32x4 rb = ((const f32x4*)rbias)[lane];
    constexpr int NT = 2;
    for (int i = wave * NT; i < per; i += 8 * NT) {
        int tok[NT]; bool live[NT]; f32x4 lg[NT];
#pragma unroll
        for (int u = 0; u < NT; ++u) { tok[u] = wg * per + i + u; live[u] = (i + u < per) && tok[u] < T; lg[u] = ((const f32x4*)(logits + (size_t)(live[u] ? tok[u] : wg * per) * NE))[lane]; }
        float s[NT][4], c[NT][4];
#pragma unroll
        for (int u = 0; u < NT; ++u)
#pragma unroll
            for (int j = 0; j < 4; ++j) { s[u][j] = sigmoidf_(lg[u][j]); c[u][j] = s[u][j] + rb[j]; }
        float m1[NT], m2[NT];
#pragma unroll
        for (int u = 0; u < NT; ++u) { const float a = fmaxf(c[u][0], c[u][1]), b = fminf(c[u][0], c[u][1]), d = fmaxf(c[u][2], c[u][3]), e = fminf(c[u][2], c[u][3]); m1[u] = fmaxf(a, d); m2[u] = fmaxf(fminf(a, d), fmaxf(b, e)); }
#pragma unroll
        for (int off = 1; off < 8; off <<= 1)
#pragma unroll
            for (int u = 0; u < NT; ++u) { const float o1 = __shfl_xor(m1[u], off), o2 = __shfl_xor(m2[u], off); const float n1 = fmaxf(m1[u], o1), n2 = fmaxf(fminf(m1[u], o1), fmaxf(m2[u], o2)); m1[u] = n1; m2[u] = n2; }
        const int g = lane >> 3;
        float gs[NT]; int rank[NT];
#pragma unroll
        for (int u = 0; u < NT; ++u) { gs[u] = m1[u] + m2[u]; rank[u] = 0; }
#pragma unroll
        for (int j = 0; j < 8; ++j)
#pragma unroll
            for (int u = 0; u < NT; ++u) { const float gj = __shfl(gs[u], 8 * j); rank[u] += (gj > gs[u] || (gj == gs[u] && j < g)) ? 1 : 0; }
#pragma unroll
        for (int u = 0; u < NT; ++u) if (rank[u] >= 4) { c[u][0] = -INFINITY; c[u][1] = -INFINITY; c[u][2] = -INFINITY; c[u][3] = -INFINITY; }
        int myidx[NT]; float mysc[NT], ssum[NT];
#pragma unroll
        for (int u = 0; u < NT; ++u) { myidx[u] = 0; mysc[u] = 0.f; ssum[u] = 0.f; }
#pragma unroll
        for (int k = 0; k < 8; ++k) {
            float bv[NT]; int be[NT];
#pragma unroll
            for (int u = 0; u < NT; ++u) { bv[u] = c[u][0]; int bi = 0;
#pragma unroll
                for (int j = 1; j < 4; ++j) if (c[u][j] > bv[u]) { bv[u] = c[u][j]; bi = j; }
                be[u] = 4 * lane + bi; }
#pragma unroll
            for (int off = 1; off < 64; off <<= 1)
#pragma unroll
                for (int u = 0; u < NT; ++u) { const float ov = __shfl_xor(bv[u], off); const int oe = __shfl_xor(be[u], off); const bool take = ov > bv[u] || (ov == bv[u] && oe < be[u]); bv[u] = take ? ov : bv[u]; be[u] = take ? oe : be[u]; }
#pragma unroll
            for (int u = 0; u < NT; ++u) { const int wj = be[u] & 3, wl = be[u] >> 2;
                const float sloc = wj == 0 ? s[u][0] : (wj == 1 ? s[u][1] : (wj == 2 ? s[u][2] : s[u][3]));
                const float ssel = __shfl(sloc, wl);
                ssum[u] += ssel; if (lane == k) { myidx[u] = be[u]; mysc[u] = ssel; }
#pragma unroll
                for (int j = 0; j < 4; ++j) c[u][j] = (lane == wl && j == wj) ? -INFINITY : c[u][j]; }
        }
#pragma unroll
        for (int u = 0; u < NT; ++u)
            if (live[u] && lane < 8) { idx[tok[u] * 8 + lane] = myidx[u]; wgt[tok[u] * 8 + lane] = mysc[u] / ssum[u] * 2.5f; __hip_atomic_fetch_add(&hist[myidx[u]], 1, __ATOMIC_RELAXED, __HIP_MEMORY_SCOPE_WORKGROUP); }
    }
    __syncthreads();
    if (tid < NE && hist[tid] > 0) atomicAdd(&counts[tid], (unsigned)hist[tid]);
}
__device__ __forceinline__ void scan_scatter(const unsigned* __restrict__ counts, unsigned* __restrict__ cursor, const int* __restrict__ idx, int* __restrict__ pos_of, int* __restrict__ sorted_tok,
                                             int* __restrict__ tiles256, int* __restrict__ tiles64, TLAS int* lds, int wg, int nwg, int tid) {
    TLAS int* cnt = lds; TLAS int* offs = lds + 256; TLAS int* lcnt = lds + 512; TLAS int* base = lds + 768;
    if (tid < NE) { cnt[tid] = (int)__hip_atomic_load(&counts[tid], __ATOMIC_RELAXED, __HIP_MEMORY_SCOPE_AGENT); lcnt[tid] = 0; }
    __syncthreads();
    if (tid < NE) { int o = 0; for (int j = 0; j < tid; ++j) o += cnt[j]; offs[tid] = o; }
    __syncthreads();
    const int per = NSLOT / nwg;
    int myr[4], mye[4];
#pragma unroll
    for (int i = 0; i < 4; ++i) { const int li = tid + 512 * i; mye[i] = -1; myr[i] = 0;
        if (li < per) { const int e = idx[wg * per + li]; mye[i] = e; myr[i] = __hip_atomic_fetch_add(&lcnt[e], 1, __ATOMIC_RELAXED, __HIP_MEMORY_SCOPE_WORKGROUP); } }
    __syncthreads();
    if (tid < NE) { const int c = lcnt[tid]; base[tid] = offs[tid] + (c > 0 ? (int)atomicAdd(&cursor[tid], (unsigned)c) : 0); }
    __syncthreads();
#pragma unroll
    for (int i = 0; i < 4; ++i) { const int li = tid + 512 * i;
        if (li < per) { const int slot = wg * per + li; const int p = base[mye[i]] + myr[i]; pos_of[slot] = p; sorted_tok[p] = slot >> 3; } }
    if (wg == 0) {
        if (tid < 256) sorted_tok[NSLOT + tid] = 0;
        if (HYBRID && tid < NE) { const int c = cnt[tid], off = offs[tid];
            int t256 = 0, t64 = 0; for (int j = 0; j < tid; ++j) { t256 += (cnt[j] + 255) >> 8; t64 += (cnt[j] + 63) >> 6; }
            const int n256 = (c + 255) >> 8, n64 = (c + 63) >> 6;
            for (int i = 0; i < n256; ++i) { tiles256[t256 + i] = tid; tiles256[MAXT256 + t256 + i] = off + 256 * i; tiles256[2 * MAXT256 + t256 + i] = (c - 256 * i) < 256 ? (c - 256 * i) : 256; }
            for (int i = 0; i < n64; ++i) { tiles64[t64 + i] = tid; tiles64[MAXT64 + t64 + i] = off + 64 * i; tiles64[2 * MAXT64 + t64 + i] = (c - 64 * i) < 64 ? (c - 64 * i) : 64; }
            if (tid == NE - 1) { tiles256[3 * MAXT256] = t256 + n256; tiles64[3 * MAXT64] = t64 + n64; } }
    }
    __syncthreads();
}
__device__ __forceinline__ void final_rows(const bf16* __restrict__ X1, const bf16* __restrict__ SH, const unsigned char* __restrict__ YS, const int* __restrict__ pos_of, const float* __restrict__ wgt,
                                           const float* __restrict__ g, const float* __restrict__ bta, float* __restrict__ out, int gw, int ngw, int lane) {
    typedef float f2_ __attribute__((ext_vector_type(2)));
    f32x4 gg[4], bb[4];
#pragma unroll
    for (int j = 0; j < 4; ++j) { gg[j] = ((const f32x4*)g)[lane + 64 * j]; bb[j] = ((const f32x4*)bta)[lane + 64 * j]; }
    const int l8 = lane & 7;
    unsigned slot_cur = 0u, slot_nxt = 0u;
    if (gw < T) slot_cur = (lane & 8) ? __float_as_uint(wgt[gw * 8 + l8]) : (unsigned)pos_of[gw * 8 + l8];
    for (int row = gw; row < T; row += ngw) {
        const int rn = (row + ngw < T) ? row + ngw : row;
        slot_nxt = (lane & 8) ? __float_as_uint(wgt[rn * 8 + l8]) : (unsigned)pos_of[rn * 8 + l8];
        unsigned yv[8][4];
#pragma unroll
        for (int k = 0; k < 8; ++k) { const int p = __builtin_amdgcn_readlane((int)slot_cur, k);
#pragma unroll
            for (int j = 0; j < 4; ++j) yv[k][j] = __builtin_nontemporal_load((const unsigned*)(YS + (size_t)p * D) + lane + 64 * j); }
        f32x4 v[4];
#pragma unroll
        for (int j = 0; j < 4; ++j) { const u32x2 a = ((const u32x2*)(X1 + (size_t)row * D))[lane + 64 * j]; const u32x2 s = ((const u32x2*)(SH + (size_t)row * D))[lane + 64 * j];
            v[j].x = ALPHA * bflo(a.x) + bflo(s.x); v[j].y = ALPHA * bfhi(a.x) + bfhi(s.x); v[j].z = ALPHA * bflo(a.y) + bflo(s.y); v[j].w = ALPHA * bfhi(a.y) + bfhi(s.y); }
#pragma unroll
        for (int k = 0; k < 8; ++k) { const float w = __uint_as_float((unsigned)__builtin_amdgcn_readlane((int)slot_cur, 8 + k)) * YS_INV;
#pragma unroll
            for (int j = 0; j < 4; ++j) { const f2_ lo = __builtin_amdgcn_cvt_pk_f32_fp8(yv[k][j], false), hi = __builtin_amdgcn_cvt_pk_f32_fp8(yv[k][j], true);
                v[j].x += w * lo.x; v[j].y += w * lo.y; v[j].z += w * hi.x; v[j].w += w * hi.y; } }
        float s = 0.f;
#pragma unroll
        for (int j = 0; j < 4; ++j) s += (v[j].x + v[j].y) + (v[j].z + v[j].w);
        const float mean = wave_sum(s) * (1.f / D); float s2 = 0.f;
#pragma unroll
        for (int j = 0; j < 4; ++j) { v[j] = v[j] - mean; s2 += (v[j].x * v[j].x + v[j].y * v[j].y) + (v[j].z * v[j].z + v[j].w * v[j].w); }
        const float rstd = rsqrtf(wave_sum(s2) * (1.f / D) + LN_EPS);
#pragma unroll
        for (int j = 0; j < 4; ++j) __builtin_nontemporal_store(v[j] * rstd * gg[j] + bb[j], (f32x4*)(out + (size_t)row * D) + lane + 64 * j);
        slot_cur = slot_nxt;
    }
}
}
namespace pg8 {
#define PG8_LAS __attribute__((address_space(3)))
typedef unsigned short bf16_t;
typedef short bf16x8 __attribute__((ext_vector_type(8)));
typedef float f32x4 __attribute__((ext_vector_type(4)));
typedef float f32x2 __attribute__((ext_vector_type(2)));
typedef unsigned u32x4 __attribute__((ext_vector_type(4)));
typedef unsigned u32x2 __attribute__((ext_vector_type(2)));
constexpr int BM = 256, BK = 64, HALF = 128, HTB = HALF * BK * 2  , STAGE_BYTES = 8 * HTB, NXCD = 8, WGM = 8;

__host__ __device__ __forceinline__ int lds_byte(int r, int c) { const int st = (r >> 4) * 2 + (c >> 5), rr = r & 15, cc = c & 31, ob = rr * 64 + cc * 2; return st * 1024 + (ob ^ (((ob >> 9) & 1) << 5)); }
__host__ __device__ __forceinline__ void stage_rc(int b, int& R, int& C) { const int st = b / 1024, sb = b % 1024, swz = sb ^ (((sb >> 9) & 1) << 5); R = (st >> 1) * 16 + swz / 64; C = (st & 1) * 32 + (swz % 64) / 2; }
__host__ __device__ __forceinline__ int perm32(int rho) { const int n = rho >> 4, i = rho & 15; return 8 * (i >> 2) + 4 * n + (i & 3); }

struct Unit { unsigned A; unsigned B; int pm, pn, aux, nr; };

__device__ __forceinline__ unsigned cvt_pk_bf16(float lo, float hi) { typedef __bf16 bf16x2_t __attribute__((ext_vector_type(2))); f32x2 v = {lo, hi}; bf16x2_t b = __builtin_convertvector(v, bf16x2_t); return __builtin_bit_cast(unsigned, b); }

typedef int i32x8 __attribute__((ext_vector_type(8)));
typedef i32x8 i32x8_a16 __attribute__((aligned(16)));
template <class Epi, class Sched, bool GATHER, bool GATHER_NR = false, bool F8 = false>
__device__ __forceinline__ void gemm_phase(PG8_LAS unsigned char* lds, const unsigned char* wsbase, const int K, const Sched& S, Epi& E, const int wave) {
    const __amdgpu_buffer_rsrc_t rsrc = __builtin_amdgcn_make_buffer_rsrc((void*)wsbase, 0, 0x7fffffff, 0x00020000);
    const int tid_ = otid(wave);
    const int tid = tid_, wid = wave, lane = tid & 63, wr = wid >> 2, wc = wid & 3, fr = lane & 15, fq = lane >> 4;
    const int nt = K / BK;
    unsigned voffA[2], voffB[2];
#pragma unroll
    for (int i = 0; i < 2; ++i) { int R, C; stage_rc(tid * 16 + i * 8192, R, C); const int Rb = Epi::PERM ? ((R & ~31) + perm32(R & 31)) : R;
        voffA[i] = (unsigned)(R * K + C) * 2u; voffB[i] = (unsigned)(Rb * K + C) * 2u; }
    const unsigned kstep = (unsigned)(BK * 2);
    const unsigned hstep = (unsigned)HALF * (unsigned)K * 2u;
    const unsigned ldsw = (unsigned)wid * 1024u, ldsb = (unsigned)(size_t)lds;
    const int aoff = lds_byte(wr * 64 + fr, fq * 8), boff = lds_byte(wc * 32 + fr, fq * 8);
#define PG8_SA(b, h) (((b) * 2 + (h)) * HTB)
#define PG8_SB(b, h) ((4 + (b) * 2 + (h)) * HTB)
#define PG8_STAGE(bufoff, gbase, voff) do { _Pragma("unroll") for (int _i = 0; _i < 2; ++_i) \
        asm volatile("s_mov_b32 m0, %0\n\ts_nop 0\n\tbuffer_load_dwordx4 %1, %2, %3 offen lds" :: "s"(ldsb + (unsigned)(bufoff) + ldsw + (unsigned)(_i * 8192)), "v"((voff)[_i]), "s"(rsrc), "s"((unsigned)(gbase)) : "m0", "memory"); } while (0)
#define PG8_STAGE_A(bufoff, p, h, g) do { if (GATHER) PG8_STAGE(bufoff, p, (g)[h]); else PG8_STAGE(bufoff, (p) + (h) * hstep, voffA); } while (0)
    const int aoff8 = lds_byte(wr * 64 + fr, fq * 16), boff8 = lds_byte(wc * 32 + fr, fq * 16);
#define PG8_LDA8(dst, b, h) do { _Pragma("unroll") for (int m = 0; m < 4; ++m) dst[m] = *(const PG8_LAS i32x8_a16*)(lds + PG8_SA(b, h) + aoff8 + m * 2048); } while (0)
#define PG8_LDB8(dst, b, h) do { _Pragma("unroll") for (int n = 0; n < 2; ++n) dst[n] = *(const PG8_LAS i32x8_a16*)(lds + PG8_SB(b, h) + boff8 + n * 2048); } while (0)
#define PG8_MMA8(ai, bj, At, Bt) do { __builtin_amdgcn_s_setprio(1); _Pragma("unroll") for (int m = 0; m < 4; ++m) _Pragma("unroll") for (int n = 0; n < 2; ++n) \
        acc[ai][bj][m][n] = __builtin_amdgcn_mfma_scale_f32_16x16x128_f8f6f4(Bt[n], At[m], acc[ai][bj][m][n], 0, 0, 0, 0x7F7F7F7F, 0, 0x7F7F7F7F); __builtin_amdgcn_s_setprio(0); } while (0)
#define PG8_LDA(dst, b, h) do { _Pragma("unroll") for (int m = 0; m < 4; ++m) _Pragma("unroll") for (int k = 0; k < 2; ++k) dst[m][k] = *(const PG8_LAS bf16x8*)(lds + PG8_SA(b, h) + aoff + m * 2048 + k * 1024); } while (0)
#define PG8_LDB(dst, b, h) do { _Pragma("unroll") for (int n = 0; n < 2; ++n) _Pragma("unroll") for (int k = 0; k < 2; ++k) dst[n][k] = *(const PG8_LAS bf16x8*)(lds + PG8_SB(b, h) + boff + n * 2048 + k * 1024); } while (0)
#define PG8_MMA(ai, bj, At, Bt) do { __builtin_amdgcn_s_setprio(1); _Pragma("unroll") for (int m = 0; m < 4; ++m) _Pragma("unroll") for (int n = 0; n < 2; ++n) _Pragma("unroll") for (int k = 0; k < 2; ++k) \
        acc[ai][bj][m][n] = __builtin_amdgcn_mfma_f32_16x16x32_bf16(Bt[n][k], At[m][k], acc[ai][bj][m][n], 0, 0, 0); __builtin_amdgcn_s_setprio(0); } while (0)
#define PG8_WAIT_V(n) asm volatile("s_waitcnt vmcnt(" #n ")" ::: "memory")
#define PG8_WAIT_L(n) asm volatile("s_waitcnt lgkmcnt(" #n ")" ::: "memory")
#define PG8_BAR __builtin_amdgcn_s_barrier()
#define PG8_SCHED __builtin_amdgcn_sched_barrier(0)
#define PG8_GOFF(dst, u) do { if (GATHER) { _Pragma("unroll") for (int _i = 0; _i < 2; ++_i) { int _R, _C; stage_rc(tid * 16 + _i * 8192, _R, _C); _Pragma("unroll") for (int _h = 0; _h < 2; ++_h) \
        dst[_h][_i] = (unsigned)(S.row_index((u), _R + _h * HALF) * K + _C) * 2u; } } } while (0)
    Unit cur, nxt; int ui = 0;
    if (!S.next(0, cur)) return;
    f32x4 acc[2][2][4][2];
#pragma unroll
    for (int a = 0; a < 2; ++a)
#pragma unroll
        for (int b = 0; b < 2; ++b)
#pragma unroll
            for (int m = 0; m < 4; ++m)
#pragma unroll
                for (int n = 0; n < 2; ++n) acc[a][b][m][n] = (f32x4){0.f, 0.f, 0.f, 0.f};
    bf16x8 At[4][2], B0[2][2], B1[2][2];
    i32x8 At8[4], B08[2], B18[2];
    unsigned curG[2][2] = {{0u, 0u}, {0u, 0u}}, nxtG[2][2] = {{0u, 0u}, {0u, 0u}};
    unsigned cA = cur.A, cB = cur.B;
    PG8_GOFF(curG, cur);
    PG8_STAGE(PG8_SB(0, 0), cB, voffB); PG8_STAGE(PG8_SB(0, 1), cB + hstep, voffB); PG8_STAGE_A(PG8_SA(0, 0), cA, 0, curG); PG8_STAGE_A(PG8_SA(0, 1), cA, 1, curG);
    if (wr == 1) PG8_BAR;
    PG8_WAIT_V(2); PG8_BAR;
    PG8_STAGE(PG8_SB(1, 0), cB + kstep, voffB); PG8_STAGE_A(PG8_SA(1, 0), cA + kstep, 0, curG); PG8_STAGE(PG8_SB(1, 1), cB + hstep + kstep, voffB);
    PG8_WAIT_V(6); PG8_BAR;
    for (;;) {
        const bool has_next = S.next(ui + 1, nxt);
        const unsigned nA = has_next ? nxt.A : cA, nB = has_next ? nxt.B : cB;
        if (GATHER) { if (has_next) PG8_GOFF(nxtG, nxt); else { _Pragma("unroll") for (int _h = 0; _h < 2; ++_h) _Pragma("unroll") for (int _i = 0; _i < 2; ++_i) nxtG[_h][_i] = curG[_h][_i]; } }
#pragma unroll 1
        for (int t = 0; t < nt; t += 2) {
            const bool last = (t == nt - 2);
            const unsigned a1 = cA + (unsigned)(t + 1) * kstep;
            const unsigned a2 = last ? nA : cA + (unsigned)(t + 2) * kstep, b2 = last ? nB : cB + (unsigned)(t + 2) * kstep;
            const unsigned a3 = a2 + kstep, b3 = b2 + kstep;
            if (F8) { PG8_LDB8(B08, 0, 0); PG8_LDB8(B18, 0, 1); PG8_SCHED; PG8_LDA8(At8, 0, 0); } else { PG8_LDB(B0, 0, 0); PG8_LDB(B1, 0, 1); PG8_SCHED; PG8_LDA(At, 0, 0); } PG8_STAGE_A(PG8_SA(1, 1), a1, 1, curG);
            if (GATHER) { if (last) { _Pragma("unroll") for (int _h = 0; _h < 2; ++_h) _Pragma("unroll") for (int _i = 0; _i < 2; ++_i) curG[_h][_i] = nxtG[_h][_i]; } }
            PG8_WAIT_V(8); PG8_WAIT_L(0); PG8_BAR; if (F8) { PG8_MMA8(0, 0, At8, B08); PG8_MMA8(0, 1, At8, B18); } else { PG8_MMA(0, 0, At, B0); PG8_MMA(0, 1, At, B1); } PG8_BAR; PG8_SCHED;
            if (F8) PG8_LDA8(At8, 0, 1); else PG8_LDA(At, 0, 1); PG8_STAGE(PG8_SB(0, 0), b2, voffB); PG8_STAGE(PG8_SB(0, 1), b2 + hstep, voffB); PG8_STAGE_A(PG8_SA(0, 0), a2, 0, curG);
            PG8_WAIT_V(8); PG8_WAIT_L(0); PG8_BAR; if (!GATHER_NR || cur.nr > HALF) { if (F8) { PG8_MMA8(1, 0, At8, B08); PG8_MMA8(1, 1, At8, B18); } else { PG8_MMA(1, 0, At, B0); PG8_MMA(1, 1, At, B1); } } PG8_BAR; PG8_SCHED;
            if (F8) { PG8_LDB8(B08, 1, 0); PG8_LDB8(B18, 1, 1); PG8_SCHED; PG8_LDA8(At8, 1, 0); } else { PG8_LDB(B0, 1, 0); PG8_LDB(B1, 1, 1); PG8_SCHED; PG8_LDA(At, 1, 0); } PG8_STAGE_A(PG8_SA(0, 1), a2, 1, curG);
            PG8_WAIT_V(8); PG8_WAIT_L(0); PG8_BAR; if (F8) { PG8_MMA8(0, 0, At8, B08); PG8_MMA8(0, 1, At8, B18); } else { PG8_MMA(0, 0, At, B0); PG8_MMA(0, 1, At, B1); } PG8_BAR; PG8_SCHED;
            if (F8) PG8_LDA8(At8, 1, 1); else PG8_LDA(At, 1, 1); PG8_STAGE(PG8_SB(1, 0), b3, voffB); PG8_STAGE(PG8_SB(1, 1), b3 + hstep, voffB); PG8_STAGE_A(PG8_SA(1, 0), a3, 0, curG);
            PG8_WAIT_V(8); PG8_WAIT_L(0); PG8_BAR; if (!GATHER_NR || cur.nr > HALF) { if (F8) { PG8_MMA8(1, 0, At8, B08); PG8_MMA8(1, 1, At8, B18); } else { PG8_MMA(1, 0, At, B0); PG8_MMA(1, 1, At, B1); } } PG8_BAR; PG8_SCHED;
        }
        if (wr == 0) PG8_BAR;
        { const int l2 = lane_id();
          E(acc, cur, wr, wc, l2 & 15, l2 >> 4); }
        if (!has_next) break;
        if (!E.keep(cur)) {
#pragma unroll
        for (int a = 0; a < 2; ++a)
#pragma unroll
            for (int b = 0; b < 2; ++b)
#pragma unroll
                for (int m = 0; m < 4; ++m)
#pragma unroll
                    for (int n = 0; n < 2; ++n) acc[a][b][m][n] = (f32x4){0.f, 0.f, 0.f, 0.f};
        }
        cur = nxt; cA = nA; cB = nB; ++ui;
        if (wr == 1) PG8_BAR;
    }
    PG8_WAIT_V(0);
    PG8_BAR;
#undef PG8_SA
#undef PG8_SB
#undef PG8_STAGE
#undef PG8_STAGE_A
#undef PG8_LDA
#undef PG8_LDA8
#undef PG8_LDB8
#undef PG8_MMA8
#undef PG8_LDB
#undef PG8_MMA
#undef PG8_WAIT_V
#undef PG8_WAIT_L
#undef PG8_BAR
#undef PG8_SCHED
#undef PG8_GOFF
}

struct GridOrder {
    unsigned A0, B0, asub, bsub; int nsub, nM, nN, nwg, G, c; unsigned astep, bstep;
    __device__ __forceinline__ void init(int M, int N, int K, int G_, int c_, int nsub_) { nM = M / BM; nN = N / BM; nwg = nM * nN; G = G_; c = c_; nsub = nsub_; astep = (unsigned)BM * (unsigned)K * 2u; bstep = astep; asub = 0; bsub = 0; }
    __device__ __forceinline__ bool next(int i, Unit& u) const {
        const int sub = i % nsub; const long L = (long)(i / nsub) * G + c; if (L >= nwg) return false;
        int wgid = (int)L; { const int q = nwg / NXCD, r = nwg % NXCD, xcd = wgid % NXCD, off = wgid / NXCD; wgid = (xcd < r ? xcd * (q + 1) : r * (q + 1) + (xcd - r) * q) + off; }
        const int nig = WGM * nN, gid = wgid / nig, fm = gid * WGM, gsz = (nM - fm) < WGM ? (nM - fm) : WGM;
        u.pm = fm + ((wgid % nig) % gsz); u.pn = (wgid % nig) / gsz; u.aux = sub; u.nr = BM;
        const unsigned a_ = A0 + (unsigned)sub * asub, b_ = B0 + (unsigned)sub * bsub;
        u.A = a_ + (unsigned)u.pm * astep; u.B = b_ + (unsigned)u.pn * bstep; return true;
    }
    __device__ __forceinline__ int row_index(const Unit&, int r) const { return r; }
};
}
namespace pg8 {
#define EPI_FOR_AI_M _Pragma("unroll") for (int ai = 0; ai < 2; ++ai) _Pragma("unroll") for (int m = 0; m < 4; ++m)
__device__ __forceinline__ u32x4 pack8(const f32x4& v0, const f32x4& v1) { u32x4 w; w.x = cvt_pk_bf16(v0[0], v0[1]); w.y = cvt_pk_bf16(v0[2], v0[3]); w.z = cvt_pk_bf16(v1[0], v1[1]); w.w = cvt_pk_bf16(v1[2], v1[3]); return w; }
__device__ __forceinline__ void unpack8(const u32x4& w, f32x4& v0, f32x4& v1) { v0 = (f32x4){bflo(w.x), bfhi(w.x), bflo(w.y), bfhi(w.y)}; v1 = (f32x4){bflo(w.z), bfhi(w.z), bflo(w.w), bfhi(w.w)}; }
__device__ __forceinline__ float silu_mul(float g, float u) { return g * u * __builtin_amdgcn_rcpf(1.f + __expf(-g)); }

struct EpiProj {
    static constexpr bool PERM = true;
    bf16_t* O;
    __device__ __forceinline__ bool keep(const Unit&) const { return false; }
    __device__ __forceinline__ void operator()(f32x4 (&acc)[2][2][4][2], const Unit& u, int wr, int wc, int fr, int fq) const {
        const int row0 = u.pm * BM + wr * 64 + fr, col0 = u.pn * BM + wc * 32 + 8 * fq;
        const int pn = u.pn;
        const float sc = (pn < 2 || pn == 6 || pn == 7) ? QS64 : ((pn == 9 || pn == 10) ? QS128 : 1.f);
        EPI_FOR_AI_M { bf16_t* rowp = O + (size_t)(row0 + ai * HALF + m * 16) * IN_COLS + col0;
#pragma unroll
            for (int bj = 0; bj < 2; ++bj) *(u32x4*)(rowp + bj * HALF) = pack8(acc[ai][bj][m][0] * sc, acc[ai][bj][m][1] * sc); }
    }
};
struct EpiGate8 {
    static constexpr bool PERM = true;
    const PG8_LAS float* b_gate; u32x4* GT;
    __device__ __forceinline__ bool keep(const Unit&) const { return false; }
    __device__ __forceinline__ void operator()(f32x4 (&acc)[2][2][4][2], const Unit& u, int wr, int wc, int fr, int fq) const {
        const int col0 = u.pn * BM + wc * 32 + 8 * fq;
        f32x4 bv[2][2];
#pragma unroll
        for (int bj = 0; bj < 2; ++bj)
#pragma unroll
            for (int n = 0; n < 2; ++n) bv[bj][n] = *(const PG8_LAS f32x4*)(b_gate + col0 + bj * HALF + 4 * n);
        char* tile = (char*)(GT + ((size_t)(u.pm * 12 + u.pn) * 16) * 512);
        unsigned off = (unsigned)((wr * 4 + wc) * 64 + (fq * 16 + fr)) * 16u;
        EPI_FOR_AI_M {
#pragma unroll
            for (int bj = 0; bj < 2; ++bj) { f32x4 v0 = acc[ai][bj][m][0] * (-W8_INV * LOG2E) + bv[bj][0], v1 = acc[ai][bj][m][1] * (-W8_INV * LOG2E) + bv[bj][1];
#pragma unroll
                for (int j = 0; j < 4; ++j) { v0[j] = __builtin_amdgcn_rcpf(1.f + __builtin_amdgcn_exp2f(__builtin_amdgcn_fmed3f(v0[j], -30.f * LOG2E, 30.f * LOG2E))); v1[j] = __builtin_amdgcn_rcpf(1.f + __builtin_amdgcn_exp2f(__builtin_amdgcn_fmed3f(v1[j], -30.f * LOG2E, 30.f * LOG2E))); }
                *(u32x4*)(tile + off) = pack8(v0, v1); off += 512u * 16u; asm volatile("" : "+v"(off)); } }
    }
};
struct EpiBf16 {
    static constexpr bool PERM = true;
    bf16_t* O; int ldc; float sc;
    __device__ __forceinline__ bool keep(const Unit&) const { return false; }
    __device__ __forceinline__ void operator()(f32x4 (&acc)[2][2][4][2], const Unit& u, int wr, int wc, int fr, int fq) const {
        const int row0 = u.pm * BM + wr * 64 + fr, col0 = u.pn * BM + wc * 32 + 8 * fq;
        EPI_FOR_AI_M { bf16_t* rowp = O + (size_t)(row0 + ai * HALF + m * 16) * ldc + col0;
#pragma unroll
            for (int bj = 0; bj < 2; ++bj) *(u32x4*)(rowp + bj * HALF) = pack8(acc[ai][bj][m][0] * sc, acc[ai][bj][m][1] * sc); }
    }
};
struct EpiOutProj {
    static constexpr bool PERM = true;
    unsigned char* O; const u32x4* GT;
    __device__ __forceinline__ bool keep(const Unit& u) const { return u.aux != 2; }
    __device__ __forceinline__ void operator()(f32x4 (&acc)[2][2][4][2], const Unit& u, int wr, int wc, int fr, int fq) const {
        const int row0 = u.pm * BM + wr * 64 + fr, col0 = u.pn * BM + wc * 32 + 8 * fq; const int sub = u.aux;
        const u32x4* ga = GT + ((size_t)(u.pm * 12 + sub * 4 + u.pn) * 16) * 512 + (wr * 4 + wc) * 64 + (fq * 16 + fr);
        const u32x4* gb = ga + (sub != 2 ? (size_t)4 * 16 * 512 : 0);
#pragma unroll
        for (int ai = 0; ai < 2; ++ai) {
            u32x4 wa[4][2], wb[4][2];
#pragma unroll
            for (int m = 0; m < 4; ++m)
#pragma unroll
                for (int bj = 0; bj < 2; ++bj) { const int fi = ((ai * 4 + m) * 2 + bj) * 512; wa[m][bj] = ga[fi]; wb[m][bj] = gb[fi]; }
#pragma unroll
            for (int m = 0; m < 4; ++m) { const size_t row = (size_t)(row0 + ai * HALF + m * 16);
#pragma unroll
                for (int bj = 0; bj < 2; ++bj) {
                    f32x4 a0, a1; unpack8(wa[m][bj], a0, a1);
                    if (sub != 2) { f32x4 b0, b1; unpack8(wb[m][bj], b0, b1);
#pragma unroll
                        for (int j = 0; j < 4; ++j) { a0[j] *= __builtin_amdgcn_rcpf(b0[j]); a1[j] *= __builtin_amdgcn_rcpf(b1[j]); } }
                    acc[ai][bj][m][0] = acc[ai][bj][m][0] * a0; acc[ai][bj][m][1] = acc[ai][bj][m][1] * a1;
                    if (sub == 2) { constexpr float sc = M8_SCALE / (O8_SCALE * W8_SCALE); const f32x4 v0 = acc[ai][bj][m][0] * sc, v1 = acc[ai][bj][m][1] * sc;
                        u32x2 w; w.x = pack4_e4m3(v0[0], v0[1], v0[2], v0[3]); w.y = pack4_e4m3(v1[0], v1[1], v1[2], v1[3]); *(u32x2*)(O + row * D + col0 + bj * HALF) = w; } } }
        }
    }
};
struct EpiY {
    static constexpr bool PERM = true;
    bf16_t* Z; const bf16_t* XB;
    __device__ __forceinline__ bool keep(const Unit&) const { return false; }
    __device__ __forceinline__ void operator()(f32x4 (&acc)[2][2][4][2], const Unit& u, int wr, int wc, int fr, int fq) const {
        const int row0 = u.pm * BM + wr * 64 + fr, col0 = u.pn * BM + wc * 32 + 8 * fq;
        u32x4 xv[2][4][2];
#pragma unroll
        for (int ai = 0; ai < 2; ++ai)
#pragma unroll
            for (int m = 0; m < 4; ++m) { const size_t off = (size_t)(row0 + ai * HALF + m * 16) * D + col0;
#pragma unroll
                for (int bj = 0; bj < 2; ++bj) xv[ai][m][bj] = *(const u32x4*)(XB + off + bj * HALF); }
#pragma unroll
        for (int ai = 0; ai < 2; ++ai)
#pragma unroll
            for (int m = 0; m < 4; ++m) { const size_t off = (size_t)(row0 + ai * HALF + m * 16) * D + col0;
#pragma unroll
                for (int bj = 0; bj < 2; ++bj) { f32x4 x0, x1; unpack8(xv[ai][m][bj], x0, x1);
                    *(u32x4*)(Z + off + bj * HALF) = pack8(x0 * ALPHA + acc[ai][bj][m][0] * (1.f / (M8_SCALE * W8_SCALE)), x1 * ALPHA + acc[ai][bj][m][1] * (1.f / (M8_SCALE * W8_SCALE))); } }
    }
};
struct EpiRouter {
    static constexpr bool PERM = true;
    float* logits;
    __device__ __forceinline__ bool keep(const Unit&) const { return false; }
    __device__ __forceinline__ void operator()(f32x4 (&acc)[2][2][4][2], const Unit& u, int wr, int wc, int fr, int fq) const {
        const int row0 = u.pm * BM + wr * 64 + fr, c8 = wc * 32 + 8 * fq;
        EPI_FOR_AI_M { float* rowp = logits + (size_t)(row0 + ai * HALF + m * 16) * NE + c8;
#pragma unroll
            for (int bj = 0; bj < 2; ++bj) { *(f32x4*)(rowp + bj * HALF) = acc[ai][bj][m][0]; *(f32x4*)(rowp + bj * HALF + 4) = acc[ai][bj][m][1]; } }
    }
};
struct EpiShared8 {
    static constexpr bool PERM = true;
    unsigned char* HS;
    __device__ __forceinline__ bool keep(const Unit&) const { return false; }
    __device__ __forceinline__ void operator()(f32x4 (&acc)[2][2][4][2], const Unit& u, int wr, int wc, int fr, int fq) const {
        const int row0 = u.pm * BM + wr * 64 + fr, c8 = wc * 32 + 8 * fq;
        EPI_FOR_AI_M { f32x4 h0, h1;
#pragma unroll
            for (int j = 0; j < 4; ++j) { h0[j] = silu_mul(acc[ai][0][m][0][j] * W8_INV, acc[ai][1][m][0][j] * (W8_INV * H8_SCALE)); h1[j] = silu_mul(acc[ai][0][m][1][j] * W8_INV, acc[ai][1][m][1][j] * (W8_INV * H8_SCALE)); }
            u32x2 w; w.x = pack4_e4m3(h0[0], h0[1], h0[2], h0[3]); w.y = pack4_e4m3(h1[0], h1[1], h1[2], h1[3]);
            *(u32x2*)(HS + (size_t)(row0 + ai * HALF + m * 16) * EFF + u.pn * HALF + c8) = w; }
    }
};
struct EpiExpGU {
    static constexpr bool PERM = true;
    bf16_t* H;
    __device__ __forceinline__ bool keep(const Unit&) const { return false; }
    __device__ __forceinline__ void operator()(f32x4 (&acc)[2][2][4][2], const Unit& u, int wr, int wc, int fr, int fq) const {
        const int c8 = wc * 32 + 8 * fq;
        EPI_FOR_AI_M { const int rl = ai * HALF + wr * 64 + m * 16 + fr; f32x4 h0, h1;
#pragma unroll
            for (int j = 0; j < 4; ++j) { h0[j] = silu_mul(acc[ai][0][m][0][j], acc[ai][1][m][0][j]); h1[j] = silu_mul(acc[ai][0][m][1][j], acc[ai][1][m][1][j]); }
            if (rl < u.nr) *(u32x4*)(H + (size_t)(u.pm + rl) * EFF + u.pn * HALF + c8) = pack8(h0, h1); }
    }
};
struct EpiExpGU8 {
    static constexpr bool PERM = true;
    unsigned char* H;
    __device__ __forceinline__ bool keep(const Unit&) const { return false; }
    __device__ __forceinline__ void operator()(f32x4 (&acc)[2][2][4][2], const Unit& u, int wr, int wc, int fr, int fq) const {
        const int c8 = wc * 32 + 8 * fq;
        EPI_FOR_AI_M { const int rl = ai * HALF + wr * 64 + m * 16 + fr; f32x4 h0, h1;
#pragma unroll
            for (int j = 0; j < 4; ++j) { h0[j] = silu_mul(acc[ai][0][m][0][j] * W8_INV, acc[ai][1][m][0][j] * (W8_INV * H8_SCALE)); h1[j] = silu_mul(acc[ai][0][m][1][j] * W8_INV, acc[ai][1][m][1][j] * (W8_INV * H8_SCALE)); }
            if (rl < u.nr) { u32x2 w; w.x = pack4_e4m3(h0[0], h0[1], h0[2], h0[3]); w.y = pack4_e4m3(h1[0], h1[1], h1[2], h1[3]);
                *(u32x2*)(H + (size_t)(u.pm + rl) * EFF + u.pn * HALF + c8) = w; } }
    }
};
__device__ __forceinline__ unsigned pack4_fp8(const f32x4& v) {
    const float a = fminf(fmaxf(v[0] * YS_SCALE, -448.f), 448.f), b = fminf(fmaxf(v[1] * YS_SCALE, -448.f), 448.f), c = fminf(fmaxf(v[2] * YS_SCALE, -448.f), 448.f), d = fminf(fmaxf(v[3] * YS_SCALE, -448.f), 448.f);
    unsigned w = __builtin_amdgcn_cvt_pk_fp8_f32(a, b, 0u, false); return __builtin_amdgcn_cvt_pk_fp8_f32(c, d, w, true);
}
struct EpiExpDown {
    static constexpr bool PERM = true;
    unsigned char* Y; float sc;
    __device__ __forceinline__ bool keep(const Unit&) const { return false; }
    __device__ __forceinline__ void operator()(f32x4 (&acc)[2][2][4][2], const Unit& u, int wr, int wc, int fr, int fq) const {
        const int col0 = u.pn * BM + wc * 32 + 8 * fq;
        EPI_FOR_AI_M { const int rl = ai * HALF + wr * 64 + m * 16 + fr;
            if (rl < u.nr) { unsigned char* rowp = Y + (size_t)(u.pm + rl) * D + col0;
#pragma unroll
                for (int bj = 0; bj < 2; ++bj) { u32x2 w; w.x = pack4_fp8(acc[ai][bj][m][0] * sc); w.y = pack4_fp8(acc[ai][bj][m][1] * sc); *(u32x2*)(rowp + bj * HALF) = w; } } }
    }
};
struct ExpertOrder {
    const PG8_LAS int* offs; const PG8_LAS int* cnt; const PG8_LAS unsigned short* tmap;
    int nN, nwg, G, c; unsigned A; const int* rows; unsigned arow; unsigned Bb, bexp, bstep;
    __device__ __forceinline__ bool next(int i, Unit& u) const {
        const long L = (long)i * G + c; if (L >= nwg) return false;
        int wgid = (int)L; { const int q = nwg / NXCD, r = nwg % NXCD, xcd = wgid % NXCD, off = wgid / NXCD; wgid = (xcd < r ? xcd * (q + 1) : r * (q + 1) + (xcd - r) * q) + off; }
        const int tile = wgid / nN; u.pn = wgid % nN;
        const int tm = __builtin_amdgcn_readfirstlane((int)tmap[tile]); const int e = tm >> 7, ti = tm & 127;
        const int ce = __builtin_amdgcn_readfirstlane(cnt[e]), oe = __builtin_amdgcn_readfirstlane(offs[e]);
        u.aux = e; u.pm = oe + 256 * ti; u.nr = (ce - 256 * ti) < 256 ? (ce - 256 * ti) : 256;
        u.A = rows ? A : A + (unsigned)u.pm * arow; u.B = Bb + (unsigned)u.aux * bexp + (unsigned)u.pn * bstep; return true;
    }
    __device__ __forceinline__ int row_index(const Unit& u, int r) const { return rows[u.pm + r]; }
};
__device__ __forceinline__ int build_tile_map(const unsigned* counts, PG8_LAS int* tab, int tid) {
    PG8_LAS int* offs = tab; PG8_LAS int* cnt = tab + 256; PG8_LAS unsigned short* tmap = (PG8_LAS unsigned short*)(tab + 512); PG8_LAS int* tot = tab + 512 + 640;
    if (tid < 256) cnt[tid] = (int)__hip_atomic_load(&counts[tid], __ATOMIC_RELAXED, __HIP_MEMORY_SCOPE_AGENT);
    __syncthreads();
    if (tid < 256) { int o = 0, t0 = 0; for (int j = 0; j < tid; ++j) { o += cnt[j]; t0 += (cnt[j] + 255) >> 8; }
        offs[tid] = o; const int nt = (cnt[tid] + 255) >> 8;
        for (int i = 0; i < nt; ++i) tmap[t0 + i] = (unsigned short)((tid << 7) | i);
        if (tid == 255) tot[0] = t0 + nt; }
    __syncthreads();
    return tot[0];
}

__device__ __forceinline__ void down_phase(PG8_LAS unsigned char* lds, unsigned char* wsbase, const PG8_LAS int* offs, const PG8_LAS int* cnt, const PG8_LAS int* srt, const int G, const int c, const unsigned Abase, const unsigned Bbase, const unsigned Ybase, const unsigned dump0, const float sc, const int wave, const int probe  ) {
    const __amdgpu_buffer_rsrc_t rsrc = __builtin_amdgcn_make_buffer_rsrc((void*)wsbase, 0, 0x7fffffff, 0x00020000);
    const int tid = otid(wave), wid = wave, lane = tid & 63, wr = wid >> 2, wc = wid & 3, fr = lane & 15, fq = lane >> 4;
    constexpr unsigned ROWB = EFF;
    unsigned voffA[2];
#pragma unroll
    for (int i = 0; i < 2; ++i) { int R, C; stage_rc(tid * 16 + i * 8192, R, C); voffA[i] = (unsigned)R * ROWB + (unsigned)C * 2u; }
    const unsigned ldsw = (unsigned)wid * 1024u, ldsb = (unsigned)(size_t)lds;
    const int aoff8 = lds_byte(wr * 64 + fr, fq * 16);
#define DN_LOAD(ldsoff, goff, voff) do { _Pragma("unroll") for (int _i = 0; _i < 2; ++_i) \
        asm volatile("s_mov_b32 m0, %0\n\ts_nop 0\n\tbuffer_load_dwordx4 %1, %2, %3 offen lds" :: "s"(ldsb + (unsigned)(ldsoff) + ldsw + (unsigned)(_i * 8192)), "v"((voff)[_i]), "s"(rsrc), "s"((unsigned)(goff)) : "m0", "memory"); } while (0)
#define DN_STAGE_A(st) do { if (probe == 3) break; const int _s = (st) < nst ? (st) : nst - 1; const unsigned _g = arow0 + (unsigned)_s * (128u * ROWB); const unsigned _l = (unsigned)((st) & 3) * 32768u; \
        DN_LOAD(_l, _g, voffA); DN_LOAD(_l + 16384u, _g + 128u, voffA); } while (0)
#define DN_WAIT(n) asm volatile("s_waitcnt vmcnt(" #n ")" ::: "memory")
#define DN_BAR __builtin_amdgcn_s_barrier()
    for (int it = 0;; ++it) {
        const int L = it * G + c; if (L >= NE * 4) break;
        int e, pn;
        if (G == 256) { const int g = (c & 7) + 8 * (c >> 5); pn = (c >> 3) & 3; e = __builtin_amdgcn_readfirstlane(srt[it * 64 + ((it & 1) ? 63 - g : g)]); }
        else { const int x = L & 7, j = L >> 3; e = ((j >> 2) << 3) | x; pn = j & 3; }
        const int ce = __builtin_amdgcn_readfirstlane(cnt[e]), oe = __builtin_amdgcn_readfirstlane(offs[e]);
        if (ce <= 0) continue;
        const int nst = (ce + 127) >> 7;
        const unsigned arow0 = Abase + (unsigned)oe * ROWB;
        const unsigned b0 = Bbase + (unsigned)e * (unsigned)(D * EFF) + (unsigned)pn * (256u * ROWB);
        unsigned voffB[2]; int boff8;
        { const int t2 = otid(wave), l2 = t2 & 63;
#pragma unroll
          for (int i = 0; i < 2; ++i) { int R, C; stage_rc(t2 * 16 + i * 8192, R, C); const int Rb = (R >> 5) * 64 + 16 * ((R & 15) >> 2) + 4 * ((R >> 4) & 1) + (R & 3); voffB[i] = (unsigned)Rb * ROWB + (unsigned)C * 2u; }
          boff8 = lds_byte(wc * 32 + (l2 & 15), (l2 >> 4) * 16); }
#pragma unroll
        for (int b = 0; b < 2; ++b)
#pragma unroll
            for (int h = 0; h < 2; ++h) DN_LOAD(65536u + (unsigned)(b * 2 + h) * 16384u, b0 + (unsigned)h * (8u * ROWB) + (unsigned)b * 128u, voffB);
        DN_STAGE_A(0); DN_STAGE_A(1);
        DN_WAIT(8); DN_BAR;
        i32x8 Bf[2][2][2];
#pragma unroll
        for (int b = 0; b < 2; ++b)
#pragma unroll
            for (int bj = 0; bj < 2; ++bj)
#pragma unroll
                for (int n = 0; n < 2; ++n) Bf[b][bj][n] = *(const PG8_LAS i32x8_a16*)(lds + 65536 + (b * 2 + bj) * 16384 + boff8 + n * 2048);
        asm volatile("s_waitcnt lgkmcnt(0)" ::: "memory");
#pragma unroll
        for (int b = 0; b < 2; ++b)
#pragma unroll
            for (int bj = 0; bj < 2; ++bj)
#pragma unroll
                for (int n = 0; n < 2; ++n) asm volatile("" : "+v"(Bf[b][bj][n]));
        DN_BAR;
        DN_STAGE_A(2); DN_STAGE_A(3);
        f32x4 acc[2][4][2];
#pragma unroll
        for (int bj = 0; bj < 2; ++bj)
#pragma unroll
            for (int m = 0; m < 4; ++m)
#pragma unroll
                for (int n = 0; n < 2; ++n) acc[bj][m][n] = (f32x4){0.f, 0.f, 0.f, 0.f};
#define DN_MFMA(st) do { const int _q = (st) & 3; const f32x4 _z = {0.f, 0.f, 0.f, 0.f}; if (probe == 2) { _Pragma("unroll") for (int bj = 0; bj < 2; ++bj) _Pragma("unroll") for (int m = 0; m < 4; ++m) _Pragma("unroll") for (int n = 0; n < 2; ++n) acc[bj][m][n] = _z; break; } \
        { i32x8 At[4]; \
          _Pragma("unroll") for (int m = 0; m < 4; ++m) At[m] = *(const PG8_LAS i32x8_a16*)(lds + _q * 32768 + aoff8 + m * 2048); \
          __builtin_amdgcn_s_setprio(1); \
          _Pragma("unroll") for (int bj = 0; bj < 2; ++bj) _Pragma("unroll") for (int m = 0; m < 4; ++m) _Pragma("unroll") for (int n = 0; n < 2; ++n) \
              acc[bj][m][n] = __builtin_amdgcn_mfma_scale_f32_16x16x128_f8f6f4(Bf[0][bj][n], At[m], _z, 0, 0, 0, 0x7F7F7F7F, 0, 0x7F7F7F7F);     \
          __builtin_amdgcn_s_setprio(0); __builtin_amdgcn_sched_barrier(0); } \
        { i32x8 At[4]; \
          _Pragma("unroll") for (int m = 0; m < 4; ++m) At[m] = *(const PG8_LAS i32x8_a16*)(lds + _q * 32768 + 16384 + aoff8 + m * 2048); \
          __builtin_amdgcn_s_setprio(1); \
          _Pragma("unroll") for (int bj = 0; bj < 2; ++bj) _Pragma("unroll") for (int m = 0; m < 4; ++m) _Pragma("unroll") for (int n = 0; n < 2; ++n) \
              acc[bj][m][n] = __builtin_amdgcn_mfma_scale_f32_16x16x128_f8f6f4(Bf[1][bj][n], At[m], acc[bj][m][n], 0, 0, 0, 0x7F7F7F7F, 0, 0x7F7F7F7F); \
          __builtin_amdgcn_s_setprio(0); __builtin_amdgcn_sched_barrier(0); } } while (0)
#define DN_EPI(st) do { const int _l = lane_id(), _fr = _l & 15, _fq = _l >> 4;     \
        const int _r0 = (st) * 128 + wr * 64 + _fr; const unsigned _y0 = Ybase + (unsigned)(oe + _r0) * (unsigned)D + (unsigned)(pn * 256 + wc * 64 + 16 * _fq); const unsigned dump = dump0 + (unsigned)(wid * 64 + _l) * 16u; \
        _Pragma("unroll") for (int m = 0; m < 4; ++m) { const bool _ok = (_r0 + 16 * m) < ce && probe != 1; u32x4 w; \
            { const f32x4 v0 = acc[0][m][0] * sc, v1 = acc[0][m][1] * sc, v2 = acc[1][m][0] * sc, v3 = acc[1][m][1] * sc; \
              w.x = pack4_e4m3(v0[0], v0[1], v0[2], v0[3]); w.y = pack4_e4m3(v1[0], v1[1], v1[2], v1[3]); w.z = pack4_e4m3(v2[0], v2[1], v2[2], v2[3]); w.w = pack4_e4m3(v3[0], v3[1], v3[2], v3[3]); } \
            const unsigned _o = _ok ? _y0 + (unsigned)(16 * m) * (unsigned)D : dump; \
            __builtin_amdgcn_raw_buffer_store_b128(w, rsrc, (int)_o, 0, 0); } } while (0)
#define DN_STEP_HEAD(s) do { if ((s) >= 4) DN_WAIT(20); else if ((s) == 3) DN_WAIT(16); else if ((s) == 2) DN_WAIT(12); else if ((s) == 1) DN_WAIT(8); else DN_WAIT(12);     \
            DN_BAR; \
            if ((s) >= 1) DN_STAGE_A((s) + 3);                           } while (0)
        if (wr == 0) {
            for (int s = 0; s < nst; ++s) { DN_STEP_HEAD(s); DN_MFMA(s); DN_BAR; DN_EPI(s); }
        } else {
            for (int s = 0; s < nst; ++s) { DN_STEP_HEAD(s); if (s >= 1) { DN_EPI(s - 1); } DN_BAR; DN_MFMA(s); }
            DN_EPI(nst - 1);
        }
#undef DN_STEP_HEAD
        DN_WAIT(0); DN_BAR;
    }
#undef DN_LOAD
#undef DN_STAGE_A
#undef DN_WAIT
#undef DN_BAR
#undef DN_MFMA
#undef DN_EPI
}
}
namespace att {
#define ALAS __attribute__((address_space(3)))
typedef short s16x4 __attribute__((ext_vector_type(4)));
constexpr int KSLOT = 16384, VSLOT = 16384, LDS_K = 0, LDS_V = 2 * KSLOT, LDS_FLAG = 4 * KSLOT;
enum { SB = 0, SWA = 1, MEM = 2 };
__device__ __forceinline__ int crow(int r, int hi) { return (r & 3) + 8 * (r >> 2) + 4 * hi; }
__device__ __forceinline__ unsigned cvtpk(float lo, float hi) { typedef float f2 __attribute__((ext_vector_type(2))); typedef __bf16 b2 __attribute__((ext_vector_type(2))); f2 v = {lo, hi}; b2 b = __builtin_convertvector(v, b2); return __builtin_bit_cast(unsigned, b); }
__device__ __forceinline__ float xhalf(float v) { return __shfl_xor(v, 32); }
__device__ __forceinline__ s16x4 vtr(const ALAS char* p) { typedef short v4i16_t __attribute__((ext_vector_type(4))); return __builtin_bit_cast(s16x4, __builtin_amdgcn_ds_read_tr16_b64_v4i16((ALAS v4i16_t*)p)); }

__device__ __forceinline__ void att_bar() { asm volatile("s_waitcnt lgkmcnt(0)" ::: "memory"); __builtin_amdgcn_s_barrier(); asm volatile("" ::: "memory"); }
template <int HD> struct Stage { u32x4 k[HD / 64], v[HD / 64]; };
template <int HD> __device__ __forceinline__ void tile_load(Stage<HD>& s, const bf16* Kb, const bf16* Vb, int pitch, int kv0, int wid, int lane) {
#pragma unroll
    for (int i = 0; i < HD / 64; ++i) { const int p = wid + 8 * i;
        s.k[i] = *(const u32x4*)(Kb + (size_t)(kv0 + lane) * pitch + p * 8);
        s.v[i] = *(const u32x4*)(Vb + (size_t)(kv0 + 16 * (p & 3) + (lane >> 2)) * pitch + (p >> 2) * 32 + (lane & 3) * 8); }
}
template <int HD> __device__ __forceinline__ void tile_store(const Stage<HD>& s, ALAS char* lds, int slot, int wid, int lane) {
#pragma unroll
    for (int i = 0; i < HD / 64; ++i) { const int p = wid + 8 * i;
        *(ALAS u32x4*)(lds + LDS_K + slot * KSLOT + p * 1024 + lane * 16) = s.k[i];
        *(ALAS u32x4*)(lds + LDS_V + slot * VSLOT + p * 1024 + lane * 16) = s.v[i]; }
}
template <int HD> __device__ __forceinline__ void qkt(f32x16& p0, f32x16& p1, const ALAS char* Kslot, const bf16x8* qr, int r32, int hi) {
    const ALAS char* kb = Kslot + hi * 1024 + r32 * 16;
#pragma unroll
    for (int r = 0; r < 16; ++r) { p0[r] = 0.f; p1[r] = 0.f; }
#pragma unroll
    for (int h0 = 0; h0 < HD / 16; h0 += 4) {
        bf16x8 kf[8];
#pragma unroll
        for (int d = 0; d < 4; ++d) { kf[2 * d] = *(const ALAS bf16x8*)(kb + (h0 + d) * 2048); kf[2 * d + 1] = *(const ALAS bf16x8*)(kb + (h0 + d) * 2048 + 512); }
        __builtin_amdgcn_sched_barrier(0);
#pragma unroll
        for (int d = 0; d < 4; ++d) { p0 = __builtin_amdgcn_mfma_f32_32x32x16_bf16(kf[2 * d], qr[h0 + d], p0, 0, 0, 0); p1 = __builtin_amdgcn_mfma_f32_32x32x16_bf16(kf[2 * d + 1], qr[h0 + d], p1, 0, 0, 0); }
        __builtin_amdgcn_sched_barrier(0);
    }
}
template <int HD> __device__ __forceinline__ void pvT(f32x16* oT, const ALAS char* Vslot, const u32x4* pw, int lane) {
    const int hi = lane >> 5;
    const ALAS char* vb = Vslot + ((lane >> 4) & 1) * 32 + (lane & 3) * 8 + (4 * hi + ((lane & 15) >> 2)) * 64;
#pragma unroll
    for (int dd = 0; dd < HD / 32; dd += 2) {
        s16x4 lo[2][4], h4[2][4];
#pragma unroll
        for (int e = 0; e < 2; ++e)
#pragma unroll
            for (int ks = 0; ks < 4; ++ks) { lo[e][ks] = vtr(vb + (dd + e) * 4096 + ks * 1024); h4[e][ks] = vtr(vb + (dd + e) * 4096 + ks * 1024 + 512); }
        __builtin_amdgcn_sched_barrier(0);
#pragma unroll
        for (int ks = 0; ks < 4; ++ks)
#pragma unroll
            for (int e = 0; e < 2; ++e) {
                const bf16x8 vf = (bf16x8){lo[e][ks][0], lo[e][ks][1], lo[e][ks][2], lo[e][ks][3], h4[e][ks][0], h4[e][ks][1], h4[e][ks][2], h4[e][ks][3]};
                oT[dd + e] = __builtin_amdgcn_mfma_f32_32x32x16_bf16(vf, __builtin_bit_cast(bf16x8, pw[ks]), oT[dd + e], 0, 0, 0); }
        __builtin_amdgcn_sched_barrier(0);
    }
}
__device__ __forceinline__ void pack_p(u32x4* pw, const f32x16& p0, const f32x16& p1) {
#pragma unroll
    for (int i = 0; i < 4; ++i) { pw[0][i] = cvtpk(p0[2 * i], p0[2 * i + 1]); pw[1][i] = cvtpk(p0[8 + 2 * i], p0[9 + 2 * i]); pw[2][i] = cvtpk(p1[2 * i], p1[2 * i + 1]); pw[3][i] = cvtpk(p1[8 + 2 * i], p1[9 + 2 * i]); }
}
__device__ __forceinline__ void sb_tile(f32x16& p0, f32x16& p1, float& Pc, bool masked, int qpos, int kv0, int hi) {
    float gm[32];
#pragma unroll
    for (int r = 0; r < 32; ++r) { const float z = fminf(r < 16 ? p0[r] : p1[r - 16], 100.f);
        const float e = __builtin_amdgcn_exp2f(z); float g = __builtin_amdgcn_rcpf(1.f + e), bt = e * g;
        if (masked) { const int kv = kv0 + crow(r & 15, hi) + (r >> 4) * 32; const bool ok = kv < qpos; g = ok ? g : 1.f; bt = ok ? bt : 0.f; }
        gm[r] = g; if (r < 16) p0[r] = bt; else p1[r - 16] = bt; }
    float suf[9]; suf[8] = 1.f;
#pragma unroll
    for (int g = 7; g >= 0; --g) suf[g] = suf[g + 1] * ((gm[4 * g] * gm[4 * g + 1]) * (gm[4 * g + 2] * gm[4 * g + 3]));
    float psuf[9]; psuf[8] = 1.f;
#pragma unroll
    for (int g = 0; g < 8; ++g) psuf[g] = xhalf(suf[g]);
#pragma unroll
    for (int g = 0; g < 8; ++g) {
        float run = Pc * suf[g + 1] * (hi ? psuf[g + 1] : psuf[g]);
#pragma unroll
        for (int i = 3; i >= 0; --i) { const int r = 4 * g + i;
            if (r < 16) p0[r] *= run; else p1[r - 16] *= run;
            run *= gm[r]; } }
    Pc *= suf[0] * psuf[0];
}

template <int MODE, int ND> __device__ __forceinline__ void soft_tile_(f32x16& p0, f32x16& p1, float& m, float& l, f32x16 (&oT)[ND], float slope, int qpos, int kv0, int hi) {
    float rm = -1e30f;
    if (MODE == SWA) {
#pragma unroll
        for (int r = 0; r < 32; ++r) { const int kv = kv0 + crow(r & 15, hi) + (r >> 4) * 32; const int dist = qpos - kv; const bool valid = dist >= 0 && dist < 128;
            const float z = (r < 16 ? p0[r] : p1[r - 16]) - slope * (float)dist; const float zz = valid ? z : -1e30f;
            if (r < 16) p0[r] = zz; else p1[r - 16] = zz; rm = fmaxf(rm, zz); }
    } else {
#pragma unroll
        for (int r = 0; r < 16; ++r) rm = fmaxf(rm, fmaxf(p0[r], p1[r]));
    }
    rm = fmaxf(rm, xhalf(rm));
    const float mn = fmaxf(m, rm), f = __builtin_amdgcn_exp2f(m - mn); m = mn;
    float ps = 0.f;
#pragma unroll
    for (int r = 0; r < 16; ++r) { p0[r] = __builtin_amdgcn_exp2f(p0[r] - mn); p1[r] = __builtin_amdgcn_exp2f(p1[r] - mn); ps += p0[r] + p1[r]; }
    ps += xhalf(ps);
    l = l * f + ps;
#pragma unroll
    for (int d0 = 0; d0 < ND; ++d0)
#pragma unroll
        for (int r = 0; r < 16; ++r) oT[d0][r] *= f;
}
template <int MODE> __device__ __forceinline__ void soft_tile(f32x16& p0, f32x16& p1, float& m, float& l, f32x16 (&oT)[2], float slope, int qpos, int kv0, int hi) { soft_tile_<MODE, 2>(p0, p1, m, l, oT, slope, qpos, kv0, hi); }
template <int MODE> __device__ __forceinline__ void soft_tile(f32x16& p0, f32x16& p1, float& m, float& l, f32x16 (&oT)[4], float slope, int qpos, int kv0, int hi) { soft_tile_<MODE, 4>(p0, p1, m, l, oT, slope, qpos, kv0, hi); }

struct Params { const bf16* projb; const bf16* mkvb; const float* sinks; unsigned char* osb; unsigned char* osw; unsigned char* om; };

template <int MODE> __device__ __forceinline__ void unit(ALAS char* lds, const Params& P, int b, int h, int qb, const int wid) {
    constexpr int HD = (MODE == MEM) ? 128 : 64;
    const int tid = otid(wid), lane = tid & 63, r32 = lane & 31, hi = lane >> 5;
    const int hq = (MODE == SWA) ? 4 * h + (wid >> 1) : h;
    const int q0 = (MODE == SWA) ? qb * 64 : qb * 256, qw0 = (MODE == SWA) ? q0 + 32 * (wid & 1) : q0 + 32 * wid, qpos = qw0 + r32;
    const bf16* Qb; const bf16* Kb; const bf16* Vb; unsigned char* Ob; int kpitch;
    if (MODE == SB)       { Qb = P.projb + (size_t)b * SEQ * IN_COLS + OFF_QSB + h * 64; Kb = P.projb + (size_t)b * SEQ * IN_COLS + OFF_KSB + h * 64; Vb = P.projb + (size_t)b * SEQ * IN_COLS + OFF_VSB + h * 64; Ob = P.osb + (size_t)b * SEQ * 512 + h * 64; kpitch = IN_COLS; }
    else if (MODE == SWA) { Qb = P.projb + (size_t)b * SEQ * IN_COLS + OFF_QSW + hq * 64; Kb = P.projb + (size_t)b * SEQ * IN_COLS + OFF_KSW + h * 64; Vb = P.projb + (size_t)b * SEQ * IN_COLS + OFF_VSW + h * 64; Ob = P.osw + (size_t)b * SEQ * 512 + hq * 64; kpitch = IN_COLS; }
    else                  { Qb = P.projb + (size_t)b * SEQ * IN_COLS + OFF_QM + h * 128; Kb = P.mkvb + (size_t)b * MEM_LEN * 1024 + h * 128; Vb = P.mkvb + (size_t)b * MEM_LEN * 1024 + 512 + h * 128; Ob = P.om + (size_t)b * SEQ * 512 + h * 128; kpitch = 1024; }
    int jlo, jhi;
    if (MODE == SB) { jlo = 0; jhi = 4 * qb + 3; } else if (MODE == SWA) { jlo = qb - 2; if (jlo < 0) jlo = 0; jhi = qb; } else { jlo = 0; jhi = 3; }
    const int ntile = jhi - jlo + 1, dj = (MODE == SB) ? -1 : 1, jfirst = (MODE == SB) ? jhi : jlo;
    Stage<HD> stA, stB;
    tile_load<HD>(stA, Kb, Vb, kpitch, jfirst * 64, wid, lane);
    tile_load<HD>(stB, Kb, Vb, kpitch, (jfirst + (ntile > 1 ? dj : 0)) * 64, wid, lane);
    bf16x8 qr[HD / 16];
#pragma unroll
    for (int d0 = 0; d0 < HD / 16; ++d0) qr[d0] = *(const bf16x8*)(Qb + (size_t)qpos * IN_COLS + d0 * 16 + hi * 8);
    f32x16 oT[HD / 32];
#pragma unroll
    for (int d0 = 0; d0 < HD / 32; ++d0)
#pragma unroll
        for (int r = 0; r < 16; ++r) oT[d0][r] = 0.f;
    float C = 1.f;
    float m = (MODE == SWA) ? P.sinks[hq] * LOG2E : -1e30f, l = (MODE == SWA) ? 1.f : 0.f;
    const float slope = (MODE == SWA) ? exp2f(-(float)(hq + 1)) * LOG2E : 0.f;
    tile_store<HD>(stA, lds, 0, wid, lane);
#pragma unroll
    for (int d0 = 0; d0 < HD / 16; ++d0) asm volatile("" : "+v"(qr[d0]));
    att_bar();
    bool stop = false;
    ALAS unsigned* dflag = (ALAS unsigned*)(lds + LDS_FLAG + 64);
#define ATT_STEP(it, SLOT, ST_LOAD, ST_STORE) do { \
        const int j = jfirst + (it) * dj, kv0 = j * 64; \
        tile_load<HD>(ST_LOAD, Kb, Vb, kpitch, ((it) + 2 < ntile ? j + 2 * dj : j) * 64, wid, lane);     \
        bool active = true; \
        if (MODE == SB) active = (kv0 <= qw0 + 30) && !__all(C == 0.f);     \
        else if (MODE == SWA) active = (kv0 <= qw0 + 31) && (kv0 + 63 >= qw0 - 127); \
        if (active) { \
            f32x16 p0, p1; \
            qkt<HD>(p0, p1, lds + LDS_K + (SLOT) * KSLOT, qr, r32, hi); \
            if (MODE == SB) { sb_tile(p0, p1, C, kv0 + 63 >= qw0, qpos, kv0, hi); } \
            else { soft_tile<MODE>(p0, p1, m, l, oT, slope, qpos, kv0, hi); } \
            u32x4 pw[4]; pack_p(pw, p0, p1); \
            pvT<HD>(oT, lds + LDS_V + (SLOT) * VSLOT, pw, lane); \
        } \
        tile_store<HD>(ST_STORE, lds, (SLOT) ^ 1, wid, lane); \
        if (MODE == SB) { const int wdone = __all(C == 0.f) ? 1 : 0; if (lane == 0) dflag[((it) & 1) * 8 + wid] = (unsigned)wdone; \
                          att_bar(); \
                          const ALAS u32x4* df = (const ALAS u32x4*)(dflag + ((it) & 1) * 8); const u32x4 f0 = df[0], f1 = df[1]; \
                          if ((f0.x & f0.y & f0.z & f0.w & f1.x & f1.y & f1.z & f1.w) != 0u) stop = true; } \
        else att_bar(); \
    } while (0)
    for (int it = 0; it < ntile && !stop; it += 2) {
        ATT_STEP(it, 0, stA, stB);
        if (stop || it + 1 >= ntile) break;
        ATT_STEP(it + 1, 1, stB, stA);
    }
#undef ATT_STEP
    const float inv = (MODE == SB) ? O8_SCALE : O8_SCALE / l;
    unsigned char* orow = Ob + (size_t)qpos * 512 + 32 * hi;
#pragma unroll
    for (int dp = 0; dp < HD / 64; ++dp) { u32x4 w0, w1; unsigned pk[8];
#pragma unroll
        for (int g = 0; g < 4; ++g) {
            const unsigned P_ = pack4_e4m3(oT[2 * dp][4 * g] * inv, oT[2 * dp][4 * g + 1] * inv, oT[2 * dp][4 * g + 2] * inv, oT[2 * dp][4 * g + 3] * inv);
            const unsigned Q_ = pack4_e4m3(oT[2 * dp + 1][4 * g] * inv, oT[2 * dp + 1][4 * g + 1] * inv, oT[2 * dp + 1][4 * g + 2] * inv, oT[2 * dp + 1][4 * g + 3] * inv);
            const auto sw = __builtin_amdgcn_permlane32_swap(P_, Q_, false, false);
            pk[2 * g] = sw[0]; pk[2 * g + 1] = sw[1]; }
        w0.x = pk[0]; w0.y = pk[1]; w0.z = pk[2]; w0.w = pk[3]; w1.x = pk[4]; w1.y = pk[5]; w1.z = pk[6]; w1.w = pk[7];
        *(u32x4*)(orow + 64 * dp) = w0; *(u32x4*)(orow + 64 * dp + 16) = w1; }
}

constexpr int NUNITS = 2560;
__device__ __forceinline__ void phase(ALAS char* lds, const Params& P, unsigned* queue, int ulo, int uhi, const int wave) {
    volatile ALAS int* flag = (volatile ALAS int*)(lds + LDS_FLAG);
    if (is_t0(wave)) { flag[0] = (int)atomicAdd(queue, 1u); }
    __syncthreads();
    int u = ulo + flag[0];
    for (int k = 0;; ++k) {
        if (u >= uhi) break;
        int tnext = 0; if (is_t0(wave)) tnext = (int)atomicAdd(queue, 1u);
        if (u < 512) { const int qb = u >> 5, bh = u & 31; unit<MEM>(lds, P, bh >> 2, bh & 3, qb, wave); }
        else if (u < 1536) { const int v = u - 512, qb = 15 - (v >> 6), bh = v & 63; unit<SB>(lds, P, bh >> 3, bh & 7, qb, wave); }
        else { const int v = u - 1536, qb = v >> 4, bh = v & 15; unit<SWA>(lds, P, bh >> 1, bh & 1, qb, wave); }
        if (is_t0(wave)) flag[(k + 1) & 1] = tnext;
        __syncthreads();
        u = ulo + flag[(k + 1) & 1];
    }
}
}
constexpr int NWAVES = 8;
constexpr int RING_BYTES = 131072, LDSCTL_OFF = RING_BYTES, MISC_OFF = LDSCTL_OFF + 320, BIAS_OFF = RING_BYTES + 1024  , LDS_BYTES = 147456;
constexpr int NPHASE = 12;
#ifndef CONV_CONTIG
#define CONV_CONTIG 0
#endif
#ifndef NCONV_WG
#define NCONV_WG 88
#endif
constexpr int NCONV = NCONV_WG;
#define GAS __attribute__((address_space(1)))
#define LAS __attribute__((address_space(3)))

#define XB_TMO      128
#define XB_XCNT(j)  (256  + 64 * (j))
#define XB_XSUB(j)  (1280 + 64 * (j))
#define XB_XGEN(j)  (2304 + 64 * (j))
#define XB_TOP      3328
#define XB_TOPGEN   3392
#define XCD_BAR_WORDS 3456
#define XB_SPIN_CAP (1u << 18)
__device__ __forceinline__ unsigned xb_ld(unsigned* p)              { return __hip_atomic_load(p, __ATOMIC_RELAXED, __HIP_MEMORY_SCOPE_AGENT); }
__device__ __forceinline__ unsigned xb_add(unsigned* p, unsigned v) { return __hip_atomic_fetch_add(p, v, __ATOMIC_RELAXED, __HIP_MEMORY_SCOPE_AGENT); }
__device__ __forceinline__ unsigned xb_xcc_id() { return (unsigned)__builtin_amdgcn_s_getreg((3 << 11) | 20) & 0xFu; }
#define XB_SPIN(cond, bar) do { unsigned _sp = 0; while (cond) { __builtin_amdgcn_s_sleep(1); \
    if ((++_sp & 255u) == 0u) { if (xb_ld(&(bar)[XB_TMO])) break; if (_sp > XB_SPIN_CAP) { atomicAdd(&(bar)[XB_TMO], 1u); break; } } } } while (0)
struct XcdBarrier { unsigned* bar; unsigned x; volatile LAS unsigned* st; int wave; };
__device__ __forceinline__ XcdBarrier xcd_barrier_post(unsigned* bar, volatile LAS unsigned* st, int wave) {
    XcdBarrier b; b.bar = bar; b.x = xb_xcc_id(); b.st = st; b.wave = wave;
    if (is_t0(wave)) (void)xb_add(&bar[XB_XCNT(b.x)], 1u);
    return b;
}
__device__ __forceinline__ void xcd_barrier_complete(unsigned* bar, unsigned x, unsigned& nloc, unsigned& nx) {
    const unsigned G = gridDim.x * gridDim.y * gridDim.z;
    unsigned sum, cnt, mine, sp = 0u;
    for (;;) {
        sum = 0u; cnt = 0u; mine = 0u;
#pragma unroll
        for (unsigned j = 0; j < 16; ++j) { const unsigned c = xb_ld(&bar[XB_XCNT(j)]); sum += c; cnt += (c > 0u) ? 1u : 0u; mine = (j == x) ? c : mine; }
        if (sum == G) break;
        __builtin_amdgcn_s_sleep(1);
        if ((++sp & 255u) == 0u) { if (xb_ld(&bar[XB_TMO])) break; if (sp > XB_SPIN_CAP) { atomicAdd(&bar[XB_TMO], 1u); break; } }
    }
    nloc = mine > 0u ? mine : 1u; nx = cnt > 0u ? cnt : 1u;
}
__device__ __forceinline__ void xcd_barrier(const XcdBarrier& b) {
    asm volatile("s_waitcnt vmcnt(0)" ::: "memory");
    __syncthreads();
    if (is_t0(b.wave)) {
        unsigned* bar = b.bar;
        __builtin_amdgcn_s_waitcnt(0);
        unsigned nloc = b.st[0], nx = b.st[1];
        if (nloc == 0u) { xcd_barrier_complete(bar, b.x, nloc, nx); b.st[0] = nloc; b.st[1] = nx; }
        const unsigned old = xb_add(&bar[XB_XSUB(b.x)], 1u);
        const unsigned gen = old / nloc;
        if (old + 1u == (gen + 1u) * nloc) {
            __builtin_amdgcn_fence(__ATOMIC_RELEASE, "agent");
            asm volatile("s_waitcnt vmcnt(0)" ::: "memory");
            const unsigned og = xb_add(&bar[XB_TOP], 1u);
            const unsigned tg = og / nx;
            if (og + 1u == (tg + 1u) * nx) xb_add(&bar[XB_TOPGEN], 1u);
            else XB_SPIN(xb_ld(&bar[XB_TOPGEN]) == tg, bar);
            __builtin_amdgcn_fence(__ATOMIC_ACQUIRE, "agent");
            xb_add(&bar[XB_XGEN(b.x)], 1u);
            asm volatile("s_waitcnt vmcnt(0)" ::: "memory");
        } else {
            XB_SPIN(xb_ld(&bar[XB_XGEN(b.x)]) == gen, bar);
            __builtin_amdgcn_fence(__ATOMIC_ACQUIRE, "agent");
            asm volatile("s_waitcnt vmcnt(0)" ::: "memory");
        }
    }
    __syncthreads();
}

struct TrItem { f32x4 v[8]; bf16* dst; int K; unsigned char* dst8; };
__device__ __forceinline__ void tr_issue(TrItem& t, const float* W, int K, int N, bf16* WT, int dst_row0, int k0, int n0, int lane, unsigned char* WT8 = nullptr) {
    const float* wp = W + (size_t)(k0 + (lane >> 3)) * N + n0 + 4 * (lane & 7);
#pragma unroll
    for (int i = 0; i < 8; ++i) t.v[i] = __builtin_nontemporal_load((const f32x4*)(wp + (size_t)(8 * i) * N));
    t.dst = WT + (size_t)dst_row0 * K + k0; t.K = K; t.dst8 = WT8 ? WT8 + (size_t)dst_row0 * K + k0 : nullptr;
}
__device__ __forceinline__ void tr_finish(const TrItem& t, LAS float* scr, int lane) {
#pragma unroll
    for (int i = 0; i < 8; ++i) { LAS float* p = scr + (8 * i + (lane >> 3)) * 33 + 4 * (lane & 7); p[0] = t.v[i][0]; p[1] = t.v[i][1]; p[2] = t.v[i][2]; p[3] = t.v[i][3]; }
    asm volatile("s_waitcnt lgkmcnt(0)" ::: "memory");
    const int c = lane & 7;
    if (t.dst8) {
#pragma unroll
        for (int j = 0; j < 4; ++j) { const int n = (lane >> 3) + 8 * j; const LAS float* s = scr + (8 * c) * 33 + n;
            u32x2 o; o.x = pack4_e4m3(s[0 * 33] * W8_SCALE, s[1 * 33] * W8_SCALE, s[2 * 33] * W8_SCALE, s[3 * 33] * W8_SCALE); o.y = pack4_e4m3(s[4 * 33] * W8_SCALE, s[5 * 33] * W8_SCALE, s[6 * 33] * W8_SCALE, s[7 * 33] * W8_SCALE);
            __builtin_nontemporal_store(o, (u32x2*)(t.dst8 + (size_t)n * t.K + 8 * c)); }
    } else {
#pragma unroll
    for (int j = 0; j < 4; ++j) { const int n = (lane >> 3) + 8 * j; const LAS float* s = scr + (8 * c) * 33 + n;
        u32x4 o; o.x = pk2(s[0 * 33], s[1 * 33]); o.y = pk2(s[2 * 33], s[3 * 33]); o.z = pk2(s[4 * 33], s[5 * 33]); o.w = pk2(s[6 * 33], s[7 * 33]);
        __builtin_nontemporal_store(o, (u32x4*)(t.dst + (size_t)n * t.K + 8 * c)); }
    }
    asm volatile("s_waitcnt lgkmcnt(0)" ::: "memory");
}
__device__ __forceinline__ void p0_transpose_item(const float* W, int K, int N, bf16* WT, int dst_row0, LAS float* scr, int k0, int n0, int lane, unsigned char* WT8 = nullptr) {
    TrItem t; tr_issue(t, W, K, N, WT, dst_row0, k0, n0, lane, WT8); tr_finish(t, scr, lane);
}
__device__ __forceinline__ int map_gu(int n0) { return n0 < EFF ? 256 * (n0 >> 7) + (n0 & 127) : 256 * ((n0 - EFF) >> 7) + 128 + ((n0 - EFF) & 127); }

struct Args {
    const float *x, *mem, *w_in, *b_gate, *w_mem_kv, *sinks, *w_o_sb, *w_o_swa, *w_o_mem, *w_out, *ln1_g, *ln1_b, *w_router, *router_bias, *w_e_gu, *w_e_down, *w_s_gu, *w_s_down, *ln2_g, *ln2_b;
    float* out; unsigned char* ws; int ph_lo, ph_hi, li, pad;
};

__global__ void __launch_bounds__(NWAVES * 64, 2) mega_fwd(Args a) {
    extern __shared__ __attribute__((aligned(16))) unsigned char lds_raw[];
    LAS unsigned char* lds = (LAS unsigned char*)lds_raw;
    volatile LAS unsigned* MISC = (volatile LAS unsigned*)(lds + MISC_OFF);
    const int wave = __builtin_amdgcn_readfirstlane((int)threadIdx.x >> 6);
    const int G = gridDim.x, bx = blockIdx.x;
    const int vcu = (G % 8 == 0) ? (bx % 8) * (G / 8) + bx / 8 : bx;
    const int gw = vcu * NWAVES + wave, NGW = G * NWAVES;
    unsigned char* ws = a.ws;
    unsigned* ctl = (unsigned*)(ws + WS_CTL);
    for (int u = otid(wave); u < (LDS_BYTES - LDSCTL_OFF) / 4; u += NWAVES * 64) ((LAS unsigned*)(lds + LDSCTL_OFF))[u] = 0u;
    __syncthreads();
    XcdBarrier bar = xcd_barrier_post(ctl + CW_BAR + a.li * XCD_BAR_WORDS, MISC + 8, wave);
    const int lo = a.ph_lo, hi = a.ph_hi;
#define IN(k) (lo <= (k) && (k) < hi)
#define SEAM(k) do { if (IN(k) && IN((k) + 1)) xcd_barrier(bar); } while (0)
#define PH_BEGIN(k) if (IN(k)) { const int tid = otid(wave), lane = tid & 63; (void)tid; (void)lane;
#define PH_END(k) } SEAM(k);
    bf16* WIN_T = (bf16*)(ws + WS_WIN_T); bf16* WMKV_T = (bf16*)(ws + WS_WMKV_T); bf16* WOSB_T = (bf16*)(ws + WS_WOSB_T); bf16* WOSW_T = (bf16*)(ws + WS_WOSW_T); bf16* WOM_T = (bf16*)(ws + WS_WOM_T);
    bf16* WOUT_T = (bf16*)(ws + WS_WOUT_T); bf16* WRS_T = (bf16*)(ws + WS_WRS_T); bf16* WSD_T = (bf16*)(ws + WS_WSD_T); bf16* WEGU_T = (bf16*)(ws + WS_WEGU_T); bf16* WED_T = (bf16*)(ws + WS_WED_T);
    bf16* XB = (bf16*)(ws + WS_XB); bf16* MEMB = (bf16*)(ws + WS_MEMB); bf16* MKVB = (bf16*)(ws + WS_MKVB); bf16* PROJB = (bf16*)(ws + WS_PROJB);
    bf16* OSB = (bf16*)(ws + WS_OSB); bf16* OSW = (bf16*)(ws + WS_OSW); bf16* OM = (bf16*)(ws + WS_OM); bf16* MERGED = (bf16*)(ws + WS_MERGED);
    bf16* Z = (bf16*)(ws + WS_Z); bf16* X1B = (bf16*)(ws + WS_X1B); float* LOGITS = (float*)(ws + WS_LOGITS); bf16* HS = (bf16*)(ws + WS_HS); bf16* SHOUT = (bf16*)(ws + WS_SHOUT);
    int* IDX = (int*)(ws + WS_ROUTE + RT_IDX); float* WGT = (float*)(ws + WS_ROUTE + RT_WGT); int* POS = (int*)(ws + WS_ROUTE + RT_POS); int* STOK = (int*)(ws + WS_ROUTE + RT_STOK);
    int* TILES = (int*)(ws + WS_ROUTE + RT_TILES); int* TILES64 = (int*)(ws + WS_ROUTE + RT_TILES64);
    unsigned char* XB8 = ws + WS_XB8; unsigned char* X1B8 = ws + WS_X1B8; unsigned char* WG8_T = ws + WS_WG8_T;
    bf16* HBUF = (bf16*)(ws + WS_HBUF); unsigned char* YS = (unsigned char*)(ws + WS_YS);

    PH_BEGIN(0)
        LAS float* scr = (LAS float*)(lds + wave * 16384);
        constexpr int I_IN = 16 * 184, I_MKV = 16 * 32, I_O = 8 * 32, I_OUT = 16 * 32, I_SGU = 16 * 16, I_R = 16 * 8, I_SD = 4 * 32, I_EGU = 16 * 16, I_ED = 4 * 32;
        constexpr int SMALL = I_IN + I_MKV + 3 * I_O + I_OUT + I_SGU + I_R + I_SD, NITEMS = SMALL;
        for (int it = gw; it < SMALL; it += NGW) {
            int r = it;
            if (r < I_IN) { const int nb = r % 184, kb = r / 184;
                if (nb < 88) p0_transpose_item(a.w_in, D, IN_COLS, WIN_T, 32 * nb, scr, 64 * kb, 32 * nb, lane);
                else p0_transpose_item(a.w_in, D, IN_COLS, WIN_T, 32 * (nb - 88), scr, 64 * kb, 32 * nb, lane, WG8_T);
                continue; } r -= I_IN;
            if (r < I_MKV) { p0_transpose_item(a.w_mem_kv, D, 1024, WMKV_T, 32 * (r % 32), scr, 64 * (r / 32), 32 * (r % 32), lane); continue; } r -= I_MKV;
            if (r < I_O) { p0_transpose_item(a.w_o_sb, 512, D, WOSB_T, 32 * (r % 32), scr, 64 * (r / 32), 32 * (r % 32), lane, (unsigned char*)WOSB_T); continue; } r -= I_O;
            if (r < I_O) { p0_transpose_item(a.w_o_swa, 512, D, WOSW_T, 32 * (r % 32), scr, 64 * (r / 32), 32 * (r % 32), lane, (unsigned char*)WOSW_T); continue; } r -= I_O;
            if (r < I_O) { p0_transpose_item(a.w_o_mem, 512, D, WOM_T, 32 * (r % 32), scr, 64 * (r / 32), 32 * (r % 32), lane, (unsigned char*)WOM_T); continue; } r -= I_O;
            if (r < I_OUT) { p0_transpose_item(a.w_out, D, D, WOUT_T, 32 * (r % 32), scr, 64 * (r / 32), 32 * (r % 32), lane, (unsigned char*)WOUT_T); continue; } r -= I_OUT;
            if (r < I_SGU) { p0_transpose_item(a.w_s_gu, D, 512, WRS_T, map_gu(32 * (r % 16)), scr, 64 * (r / 16), 32 * (r % 16), lane, (unsigned char*)WRS_T); continue; } r -= I_SGU;
            if (r < I_R) { p0_transpose_item(a.w_router, D, NE, WRS_T, 512 + 32 * (r % 8), scr, 64 * (r / 8), 32 * (r % 8), lane); continue; } r -= I_R;
            p0_transpose_item(a.w_s_down, EFF, D, WSD_T, 32 * (r % 32), scr, 64 * (r / 32), 32 * (r % 32), lane, (unsigned char*)WSD_T);
        }
        thin::cvt_rows(a.x, XB, XB8, T, gw, NGW, lane);
        thin::cvt_rows(a.mem, MEMB, nullptr, MROWS, gw, NGW, lane);
    PH_END(0)
    PH_BEGIN(1)
        const int GG = G - NCONV;
        if (bx >= GG) {
            LAS float* scr = (LAS float*)(lds + wave * 16384);
            constexpr int I_EGU = 16 * 16, I_ED = 4 * 32;
            const int cw = (bx - GG) * NWAVES + wave, ncw = NCONV * NWAVES;
            constexpr int NIT = NE * (I_EGU + I_ED);
#define EXP_ISSUE(t, r_) do { const int ri_ = (r_) < NIT ? (r_) : rlast;     \
                const bool gu = ri_ < NE * I_EGU; const int r2 = gu ? ri_ : ri_ - NE * I_EGU; const int per = gu ? I_EGU : I_ED, nbs = gu ? 16 : 32; \
                const int e = r2 / per, q = r2 % per, kb = q / nbs, nb = q % nbs; \
                const float* W = gu ? a.w_e_gu + (size_t)e * D * 512 : a.w_e_down + (size_t)e * EFF * D; \
                unsigned char* W8 = gu ? (unsigned char*)WEGU_T + (size_t)e * 512 * D : (unsigned char*)WED_T + (size_t)e * D * EFF; \
                tr_issue(t, W, gu ? D : EFF, gu ? 512 : D, WEGU_T, gu ? map_gu(32 * nb) : 32 * nb, 64 * kb, 32 * nb, lane, W8); } while (0)
            TrItem tA, tB, tC;
            const int nmine = (NIT - cw + ncw - 1) / ncw, rlast = cw + (nmine - 1) * ncw;
            int r = cw;
            EXP_ISSUE(tA, r); EXP_ISSUE(tB, r + ncw);
            for (; r < NIT; r += 3 * ncw) {
                EXP_ISSUE(tC, r + 2 * ncw); tr_finish(tA, scr, lane);
                EXP_ISSUE(tA, r + 3 * ncw); tr_finish(tB, scr, lane);
                EXP_ISSUE(tB, r + 4 * ncw); tr_finish(tC, scr, lane);
            }
#undef EXP_ISSUE
        } else {
        LAS float* bias_lds = (LAS float*)(lds + BIAS_OFF);
        for (int i = tid; i < 3 * D; i += NWAVES * 64) bias_lds[i] = a.b_gate[i] * -LOG2E;
        __syncthreads();
        { pg8::GridOrder S; S.init(T, OFF_GATE, D, GG, bx, 1); S.A0 = (unsigned)WS_XB; S.B0 = (unsigned)WS_WIN_T;
          pg8::EpiProj E{PROJB};
          pg8::gemm_phase<pg8::EpiProj, pg8::GridOrder, false>(lds, ws, D, S, E, wave); }
        { pg8::GridOrder S; S.init(T, 3 * D, D / 2, GG, bx, 1); S.A0 = (unsigned)WS_XB8; S.B0 = (unsigned)WS_WG8_T;
          pg8::EpiGate8 E{bias_lds, (u32x4*)(ws + WS_GT)};
          pg8::gemm_phase<pg8::EpiGate8, pg8::GridOrder, false, false, true>(lds, ws, D / 2, S, E, wave); }
        { pg8::GridOrder S; S.init(MROWS, 1024, D, GG, GG - 1 - bx, 1); S.A0 = (unsigned)WS_MEMB; S.B0 = (unsigned)WS_WMKV_T;
          pg8::EpiBf16 E{MKVB, 1024, 1.f};
          pg8::gemm_phase<pg8::EpiBf16, pg8::GridOrder, false>(lds, ws, D, S, E, wave); }
        }
    PH_END(1)
    PH_BEGIN(2)
        const att::Params P{PROJB, MKVB, a.sinks, (unsigned char*)OSB, (unsigned char*)OSW, (unsigned char*)OM};
        att::phase((LAS char*)lds, P, ctl + CW_QUEUE + 64 * (a.li & 15), a.pad == 1 ? 512 : (a.pad == 2 ? 1536 : 0), a.pad == 3 ? 512 : (a.pad == 1 ? 1536 : att::NUNITS), wave);
    PH_END(2)
    PH_BEGIN(3)
        pg8::GridOrder S; S.init(T, D, 512 / 2, G, bx, 3);
        S.A0 = (unsigned)WS_OSB; S.B0 = (unsigned)WS_WOSB_T; S.asub = (unsigned)(WS_OSW - WS_OSB); S.bsub = (unsigned)(WS_WOSW_T - WS_WOSB_T);
        pg8::EpiOutProj E{(unsigned char*)MERGED, (const u32x4*)(ws + WS_GT)};
        pg8::gemm_phase<pg8::EpiOutProj, pg8::GridOrder, false, false, true>(lds, ws, 512 / 2, S, E, wave);
    PH_END(3)
    PH_BEGIN(4)
        pg8::GridOrder S; S.init(T, D, D / 2, G, bx, 1); S.A0 = (unsigned)WS_MERGED; S.B0 = (unsigned)WS_WOUT_T;
        pg8::EpiY E{Z, XB};
        pg8::gemm_phase<pg8::EpiY, pg8::GridOrder, false, false, true>(lds, ws, D / 2, S, E, wave);
    PH_END(4)
    PH_BEGIN(5) thin::ln1_rows(Z, a.ln1_g, a.ln1_b, X1B, X1B8, gw, NGW, lane); PH_END(5)
    PH_BEGIN(6)
        const bool split = (G % 16 == 0); const int Gs = split ? G / 2 : G, cs = split ? (((bx >> 4) << 3) | (bx & 7)) : bx, side = (bx >> 3) & 1;
        if (!split || side == 0) { pg8::GridOrder S; S.init(T, NE, D, Gs, cs, 1); S.A0 = (unsigned)WS_X1B; S.B0 = (unsigned)(WS_WRS_T + (size_t)512 * D * 2);
            pg8::EpiRouter E{LOGITS};
            pg8::gemm_phase<pg8::EpiRouter, pg8::GridOrder, false>(lds, ws, D, S, E, wave); }
        if (!split || side == 1) { pg8::GridOrder S; S.init(T, 2 * EFF, D / 2, Gs, cs, 1); S.A0 = (unsigned)WS_X1B8; S.B0 = (unsigned)WS_WRS_T;
            pg8::EpiShared8 E{(unsigned char*)HS};
            pg8::gemm_phase<pg8::EpiShared8, pg8::GridOrder, false, false, true>(lds, ws, D / 2, S, E, wave); }
    PH_END(6)
    PH_BEGIN(7) thin::route(LOGITS, a.router_bias, IDX, WGT, ctl + CW_COUNTS, (LAS int*)lds, bx, G, tid); PH_END(7)
    PH_BEGIN(8) thin::scan_scatter(ctl + CW_COUNTS, ctl + CW_CURSOR, IDX, POS, STOK, TILES, TILES64, (LAS int*)lds, bx, G, tid); PH_END(8)
    PH_BEGIN(9)
        { LAS int* tab = (LAS int*)(lds + BIAS_OFF);
          const int ntiles = __builtin_amdgcn_readfirstlane(pg8::build_tile_map(ctl + CW_COUNTS, tab, tid));
          pg8::ExpertOrder S; S.offs = tab; S.cnt = tab + 256; S.tmap = (const LAS unsigned short*)(tab + 512); S.nN = 2; S.nwg = ntiles * 2; S.G = G; S.c = bx; S.A = (unsigned)WS_X1B8; S.rows = STOK; S.arow = 0; S.Bb = (unsigned)WS_WEGU_T; S.bexp = (unsigned)(512 * D); S.bstep = (unsigned)(256 * D);
          pg8::EpiExpGU8 E{(unsigned char*)HBUF};
          pg8::gemm_phase<pg8::EpiExpGU8, pg8::ExpertOrder, true, false, true>(lds, ws, D / 2, S, E, wave); }
        { pg8::GridOrder S; S.init(T, D, EFF / 2, G, bx, 1); S.A0 = (unsigned)WS_HS; S.B0 = (unsigned)WS_WSD_T;
          pg8::EpiBf16 E{SHOUT, D, 1.f / (W8_SCALE * H8_SCALE)};
          int Kh = EFF / 2; asm volatile("" : "+s"(Kh));
          pg8::gemm_phase<pg8::EpiBf16, pg8::GridOrder, false, false, true>(lds, ws, Kh, S, E, wave); }
    PH_END(9)
    PH_BEGIN(10)
        LAS int* tab = (LAS int*)(lds + BIAS_OFF);
        (void)pg8::build_tile_map(ctl + CW_COUNTS, tab, tid);
        LAS int* srt = tab + 1280;
        if (tid < NE) { const int ce = tab[256 + tid]; int rk = 0; for (int j = 0; j < NE; ++j) { const int cj = tab[256 + j]; rk += (cj > ce || (cj == ce && j < tid)) ? 1 : 0; } srt[rk] = tid; }
        __syncthreads();
        pg8::down_phase(lds, ws, tab, tab + 256, srt, G, bx, (unsigned)WS_HBUF, (unsigned)WS_WED_T, (unsigned)WS_YS, (unsigned)(WS_CTL + 768 * 1024), YS_SCALE / (W8_SCALE * H8_SCALE), wave, HYBRID ? a.pad : 0);
    PH_END(10)
    PH_BEGIN(11) thin::final_rows(X1B, SHOUT, YS, POS, WGT, a.ln2_g, a.ln2_b, a.out, gw, NGW, lane); PH_END(11)
#undef IN
#undef SEAM
#undef PH_BEGIN
#undef PH_END
}
extern "C" void kernel_launch(void* const* d_in, const int* in_sizes, int n_in, void* d_out, int out_size, void* d_ws, size_t ws_size, hipStream_t stream) {
    static int grid = 0;
    if (grid == 0) {
        if (n_in != 20 || in_sizes[0] != T * D || out_size != T * D || ws_size < WS_END) { fprintf(stderr, "kernel_launch: unexpected problem shape / workspace (%d inputs, ws %zu)\n", n_in, ws_size); grid = -1; return; }
        int dev = 0, cus = 0;
        if (hipGetDevice(&dev) != hipSuccess || hipDeviceGetAttribute(&cus, hipDeviceAttributeMultiprocessorCount, dev) != hipSuccess) { grid = -1; return; }
        if (hipFuncSetAttribute((const void*)mega_fwd, hipFuncAttributeMaxDynamicSharedMemorySize, LDS_BYTES) != hipSuccess) { fprintf(stderr, "kernel_launch: hipFuncSetAttribute failed\n"); grid = -1; return; }
        (void)hipGetLastError();
        grid = cus;
    }
    if (grid < 0) return;
    (void)hipMemsetAsync((char*)d_ws + WS_CTL, 0, CTL_ZERO_BYTES, stream);
    Args a{};
    const float** f = (const float**)&a;
    for (int i = 0; i < 20; ++i) f[i] = (const float*)d_in[i];
    a.out = (float*)d_out; a.ws = (unsigned char*)d_ws;
#if HYBRID
#ifndef PROBE_ATT_MODE
#define PROBE_ATT_MODE 0
#endif
    unsigned char* ws = (unsigned char*)d_ws;
    bf16* XB = (bf16*)(ws + WS_XB); bf16* MEMB = (bf16*)(ws + WS_MEMB); bf16* MKVB = (bf16*)(ws + WS_MKVB); bf16* PROJB = (bf16*)(ws + WS_PROJB);
    bf16* OSB = (bf16*)(ws + WS_OSB); bf16* OSW = (bf16*)(ws + WS_OSW); bf16* OM = (bf16*)(ws + WS_OM); bf16* MERGED = (bf16*)(ws + WS_MERGED);
    bf16* Z = (bf16*)(ws + WS_Z); bf16* X1B = (bf16*)(ws + WS_X1B); float* LOGITS = (float*)(ws + WS_LOGITS); bf16* HS = (bf16*)(ws + WS_HS); bf16* SHOUT = (bf16*)(ws + WS_SHOUT);
    int* STOK = (int*)(ws + WS_ROUTE + RT_STOK); int* TILES64 = (int*)(ws + WS_ROUTE + RT_TILES64);
    bf16* HBUF = (bf16*)(ws + WS_HBUF); bf16* YS = (bf16*)(ws + WS_YS);
    float* SCR = (float*)(ws + WS_YS);
    static const int opt[NPHASE] = HYBRID_OPT;
#ifdef PROBE_REPS
    static const int reps[NPHASE] = PROBE_REPS;
#else
    static const int reps[NPHASE] = {1, 1, 1, 1, 1, 1, 1, 1, 1, 1, 1, 1};
#endif
    int li = 0;
    for (int p = 0; p < NPHASE; ++p) {
        if (opt[p]) { for (int r = 0; r < reps[p]; ++r) { a.ph_lo = p; a.ph_hi = p + 1; a.li = (li++) & 15; a.pad = (r + 1 < reps[p]) ? PROBE_ATT_MODE : 0;     hipLaunchKernelGGL(mega_fwd, dim3(grid), dim3(NWAVES * 64), LDS_BYTES, stream, a); }
#ifdef ATT_DIFF_TEST
        if (p == 2 && opt[p]) {
            bf16* nsb = (bf16*)(ws + WS_YS); bf16* nsw = nsb + (size_t)T * 512; bf16* nm = nsw + (size_t)T * 512;
            nv::k_sb_attn<<<BATCH * 8 * (SEQ / 64), 64, 0, stream>>>(PROJB, nsb);
            nv::k_swa_attn<<<BATCH * 8 * (SEQ / 64), 64, 0, stream>>>(PROJB, a.sinks, nsw);
            nv::k_mem_attn<<<BATCH * 4 * 2 * (SEQ / 64), 64, 0, stream>>>(PROJB, MKVB, nm);
            unsigned* cw = (unsigned*)(ws + WS_CTL);
            nv::k_maxdiff<<<1024, 256, 0, stream>>>(OSB, nsb, (size_t)T * 512, cw + (ATT_DIFF_TEST == 1 ? 900 : 910));
            nv::k_maxdiff<<<1024, 256, 0, stream>>>(OSW, nsw, (size_t)T * 512, cw + (ATT_DIFF_TEST == 2 ? 900 : 911));
            nv::k_maxdiff<<<1024, 256, 0, stream>>>(OM, nm, (size_t)T * 512, cw + (ATT_DIFF_TEST == 3 ? 900 : 912));
        }
        if (p == NPHASE - 1) nv::k_scale_out<<<1024, 256, 0, stream>>>((float*)d_out, (size_t)T * D, (const unsigned*)(ws + WS_CTL) + 900);
#endif
            continue; }
        switch (p) {
        case 1:
            nv::k_gemm<nv::M_PROJ><<<dim3(IN_COLS / 64, T / 64), 256, 0, stream>>>(XB, D, a.w_in, IN_COLS, PROJB, IN_COLS, D, nullptr, 0, a.b_gate, nullptr);
            nv::k_gemm<nv::M_BF16><<<dim3(1024 / 64, MROWS / 64), 256, 0, stream>>>(MEMB, D, a.w_mem_kv, 1024, MKVB, 1024, D, nullptr, 0, nullptr, nullptr);
            break;
        case 2:
            nv::k_sb_attn<<<BATCH * 8 * (SEQ / 64), 64, 0, stream>>>(PROJB, OSB);
            nv::k_swa_attn<<<BATCH * 8 * (SEQ / 64), 64, 0, stream>>>(PROJB, a.sinks, OSW);
            nv::k_mem_attn<<<BATCH * 4 * 2 * (SEQ / 64), 64, 0, stream>>>(PROJB, MKVB, OM);
            break;
        case 3:
            nv::k_gemm<nv::M_GSET><<<dim3(D / 64, T / 64), 256, 0, stream>>>(OSB, 512, a.w_o_sb, D, nullptr, 0, 512, PROJB + OFF_GATE, IN_COLS, nullptr, SCR);
            nv::k_gemm<nv::M_GADD><<<dim3(D / 64, T / 64), 256, 0, stream>>>(OSW, 512, a.w_o_swa, D, nullptr, 0, 512, PROJB + OFF_GATE + D, IN_COLS, nullptr, SCR);
            nv::k_gemm<nv::M_GFIN><<<dim3(D / 64, T / 64), 256, 0, stream>>>(OM, 512, a.w_o_mem, D, MERGED, D, 512, PROJB + OFF_GATE + 2 * D, IN_COLS, nullptr, SCR);
            break;
        case 4:
            nv::k_gemm<nv::M_Y><<<dim3(D / 64, T / 64), 256, 0, stream>>>(MERGED, D, a.w_out, D, Z, D, D, a.x, D, nullptr, nullptr);
            break;
        case 6:
            nv::k_gemm<nv::M_F32><<<dim3(NE / 64, T / 64), 256, 0, stream>>>(X1B, D, a.w_router, NE, LOGITS, NE, D, nullptr, 0, nullptr, nullptr);
            nv::k_gu<<<dim3(EFF / 64, T / 64), 256, 0, stream>>>(X1B, nullptr, nullptr, a.w_s_gu, 0, HS);
            break;
        case 9:
            nv::k_gu<<<dim3(EFF / 64, MAXT64), 256, 0, stream>>>(X1B, STOK, TILES64, a.w_e_gu, (size_t)D * 2 * EFF, HBUF);
            nv::k_down<false><<<dim3(D / 64, T / 64), 256, 0, stream>>>(HS, nullptr, a.w_s_down, 0, SHOUT);
            break;
        case 10:
            nv::k_down<true><<<dim3(D / 64, MAXT64), 256, 0, stream>>>(HBUF, TILES64, a.w_e_down, (size_t)EFF * D, YS);
            break;
        default: break;
        }
    }
#else
    a.ph_lo = 0; a.ph_hi = NPHASE; a.li = 0;
    hipLaunchKernelGGL(mega_fwd, dim3(grid), dim3(NWAVES * 64), LDS_BYTES, stream, a);
#endif
}
```

```cpp
#define HYBRID 0
#include <hip/hip_runtime.h>
#include <stdint.h>
#include <math.h>
#include <cstdio>

constexpr int D = 1024, BATCH = 8, SEQ = 4096, T = BATCH * SEQ;
constexpr int MEM_LEN = 256, MROWS = BATCH * MEM_LEN;
constexpr int IN_COLS = 5888;
constexpr int OFF_QSB = 0, OFF_KSB = 512, OFF_VSB = 1024, OFF_QSW = 1536, OFF_KSW = 2048, OFF_VSW = 2176, OFF_QM = 2304, OFF_GATE = 2816;
constexpr int NE = 256, TOPK = 8, EFF = 256;
constexpr float LN_EPS = 1e-5f;
constexpr float ALPHA = 1.189207115002721f;
constexpr int NSLOT = T * TOPK;
constexpr float LOG2E = 1.4426950408889634f;
constexpr float QS64 = 0.125f * LOG2E;
constexpr float QS128 = 0.08838834764831845f * LOG2E;

constexpr float W8_SCALE = 64.f, W8_INV = 1.f / 64.f;
constexpr float O8_SCALE = 16.f, M8_SCALE = 16.f;
constexpr float H8_SCALE = 16.f;
constexpr float YS_SCALE = 16.f, YS_INV = 1.f / 16.f;
constexpr size_t MiB = 1u << 20;
constexpr size_t WS_CTL = 0, CTL_ZERO_BYTES = 1 * MiB;
constexpr size_t WS_WIN_T = 2 * MiB, WS_WMKV_T = 14 * MiB, WS_WOSB_T = 16 * MiB, WS_WOSW_T = 17 * MiB, WS_WOM_T = 18 * MiB, WS_WOUT_T = 19 * MiB, WS_WRS_T = 21 * MiB, WS_WSD_T = 23 * MiB;
constexpr size_t WS_WEGU_T = 24 * MiB, WS_WED_T = 280 * MiB;
constexpr size_t WS_XB = 408 * MiB, WS_MEMB = 472 * MiB, WS_MKVB = 476 * MiB, WS_PROJB = 480 * MiB;
constexpr size_t WS_OSB = 848 * MiB, WS_OSW = 880 * MiB, WS_OM = 912 * MiB, WS_MERGED = 944 * MiB, WS_Z = 1008 * MiB, WS_X1B = 1136 * MiB, WS_LOGITS = 1200 * MiB, WS_HS = 1232 * MiB, WS_SHOUT = 1248 * MiB;
constexpr size_t WS_XB8 = 1920 * MiB, WS_X1B8 = 1952 * MiB, WS_WG8_T = 1984 * MiB;
constexpr size_t WS_GT = 1728 * MiB;
constexpr size_t WS_ROUTE = 1312 * MiB, WS_HBUF = 1328 * MiB, WS_YS = 1460 * MiB, WS_END = 1988 * MiB;
constexpr size_t RT_IDX = 0, RT_WGT = 1 * MiB, RT_POS = 2 * MiB, RT_STOK = 3 * MiB  , RT_TILES = 5 * MiB  , RT_TILES64 = 6 * MiB  ;
constexpr int MAXT256 = NSLOT / 256 + NE;
constexpr int MAXT64 = NSLOT / 64 + NE;
constexpr int CW_COUNTS = 1024, CW_CURSOR = 1280, CW_QUEUE = 1536  , CW_BAR = 4096;

typedef unsigned short bf16;
typedef short bf16x8 __attribute__((ext_vector_type(8)));
typedef float f32x4 __attribute__((ext_vector_type(4)));
typedef float f32x16 __attribute__((ext_vector_type(16)));
typedef unsigned u32x4 __attribute__((ext_vector_type(4)));
typedef unsigned u32x2 __attribute__((ext_vector_type(2)));

__device__ __forceinline__ unsigned f2bf(float f) { unsigned u = __builtin_bit_cast(unsigned, f); return (u + 0x7fffu + ((u >> 16) & 1u)) >> 16; }
__device__ __forceinline__ unsigned pk2(float lo, float hi) { return f2bf(lo) | (f2bf(hi) << 16); }
__device__ __forceinline__ float bf2f(unsigned b) { return __builtin_bit_cast(float, b << 16); }
__device__ __forceinline__ float bflo(unsigned w) { return __builtin_bit_cast(float, w << 16); }
__device__ __forceinline__ float bfhi(unsigned w) { return __builtin_bit_cast(float, w & 0xffff0000u); }
__device__ __forceinline__ unsigned pack4_e4m3(float a, float b, float c, float d) {
    a = __builtin_amdgcn_fmed3f(a, -448.f, 448.f); b = __builtin_amdgcn_fmed3f(b, -448.f, 448.f); c = __builtin_amdgcn_fmed3f(c, -448.f, 448.f); d = __builtin_amdgcn_fmed3f(d, -448.f, 448.f);
    const unsigned w = __builtin_amdgcn_cvt_pk_fp8_f32(a, b, 0u, false); return __builtin_amdgcn_cvt_pk_fp8_f32(c, d, w, true);
}
__device__ __forceinline__ float wave_sum(float v) {
#pragma unroll
    for (int o = 1; o < 64; o <<= 1) v += __shfl_xor(v, o);
    return v;
}
__device__ __forceinline__ float sigmoidf_(float z) { return 1.f / (1.f + __expf(-z)); }
__device__ __forceinline__ float gate_sig(float z) { z = fminf(fmaxf(z, -30.f), 30.f); return __builtin_amdgcn_rcpf(1.f + __expf(-z)); }

__device__ __forceinline__ int lane_id() { int l; asm volatile("v_mbcnt_lo_u32_b32 %0, -1, 0\n\tv_mbcnt_hi_u32_b32 %0, -1, %0" : "=v"(l)); return l; }
__device__ __forceinline__ int otid(int wave) { int t = (wave << 6) | lane_id(); asm volatile("" : "+v"(t)); return t; }
__device__ __forceinline__ bool is_t0(int wave) { return wave == 0 && lane_id() == 0; }
namespace thin {
#define TLAS __attribute__((address_space(3)))
__device__ __forceinline__ void cvt_rows(const float* __restrict__ src, bf16* __restrict__ dst, unsigned char* __restrict__ dst8  , int rows, int gw, int ngw, int lane) {
    f32x4 cur[4], nxt[4];
    if (gw < rows) {
#pragma unroll
        for (int j = 0; j < 4; ++j) cur[j] = __builtin_nontemporal_load((const f32x4*)(src + (size_t)gw * D) + lane + 64 * j);
    }
    for (int r = gw; r < rows; r += ngw) {
        const int rn = (r + ngw < rows) ? r + ngw : r;
#pragma unroll
        for (int j = 0; j < 4; ++j) nxt[j] = __builtin_nontemporal_load((const f32x4*)(src + (size_t)rn * D) + lane + 64 * j);
        u32x2* d = (u32x2*)(dst + (size_t)r * D) + lane;
#pragma unroll
        for (int j = 0; j < 4; ++j) { u32x2 o; o.x = pk2(cur[j].x, cur[j].y); o.y = pk2(cur[j].z, cur[j].w); d[64 * j] = o; }
        if (dst8) { unsigned* d8 = (unsigned*)(dst8 + (size_t)r * D) + lane;
#pragma unroll
            for (int j = 0; j < 4; ++j) d8[64 * j] = pack4_e4m3(cur[j].x, cur[j].y, cur[j].z, cur[j].w); }
#pragma unroll
        for (int j = 0; j < 4; ++j) cur[j] = nxt[j];
    }
}
__device__ __forceinline__ void ln1_rows(const bf16* __restrict__ Z, const float* __restrict__ g, const float* __restrict__ bta, bf16* __restrict__ XB, unsigned char* __restrict__ XB8, int gw, int ngw, int lane) {
    u32x4 r0[2], r1[2], r2[2];
    const int ra = gw < T ? gw : T - 1, rb = gw + ngw < T ? gw + ngw : T - 1;
#pragma unroll
    for (int j = 0; j < 2; ++j) { r0[j] = __builtin_nontemporal_load((const u32x4*)(Z + (size_t)ra * D) + lane + 64 * j); r1[j] = __builtin_nontemporal_load((const u32x4*)(Z + (size_t)rb * D) + lane + 64 * j); }
    f32x4 gg[4], bb[4];
#pragma unroll
    for (int j = 0; j < 2; ++j) { gg[2 * j] = ((const f32x4*)g)[2 * lane + 128 * j]; gg[2 * j + 1] = ((const f32x4*)g)[2 * lane + 128 * j + 1]; bb[2 * j] = ((const f32x4*)bta)[2 * lane + 128 * j]; bb[2 * j + 1] = ((const f32x4*)bta)[2 * lane + 128 * j + 1]; }
    for (int r = gw; r < T; r += ngw) {
        const int rn = (r + 2 * ngw < T) ? r + 2 * ngw : r;
#pragma unroll
        for (int j = 0; j < 2; ++j) r2[j] = __builtin_nontemporal_load((const u32x4*)(Z + (size_t)rn * D) + lane + 64 * j);
        f32x4 v[4]; float s = 0.f;
#pragma unroll
        for (int j = 0; j < 2; ++j) { const u32x4 z = r0[j]; v[2 * j] = (f32x4){bflo(z.x), bfhi(z.x), bflo(z.y), bfhi(z.y)}; v[2 * j + 1] = (f32x4){bflo(z.z), bfhi(z.z), bflo(z.w), bfhi(z.w)}; }
#pragma unroll
        for (int j = 0; j < 4; ++j) s += (v[j].x + v[j].y) + (v[j].z + v[j].w);
        const float mean = wave_sum(s) * (1.f / D); float s2 = 0.f;
#pragma unroll
        for (int j = 0; j < 4; ++j) { v[j] = v[j] - mean; s2 += (v[j].x * v[j].x + v[j].y * v[j].y) + (v[j].z * v[j].z + v[j].w * v[j].w); }
        const float rstd = rsqrtf(wave_sum(s2) * (1.f / D) + LN_EPS);
        u32x4* xb = (u32x4*)(XB + (size_t)r * D) + lane;
        u32x2* x8 = (u32x2*)(XB8 + (size_t)r * D) + lane;
#pragma unroll
        for (int j = 0; j < 2; ++j) { const f32x4 o0 = v[2 * j] * rstd * gg[2 * j] + bb[2 * j], o1 = v[2 * j + 1] * rstd * gg[2 * j + 1] + bb[2 * j + 1];
            u32x4 w; w.x = pk2(o0.x, o0.y); w.y = pk2(o0.z, o0.w); w.z = pk2(o1.x, o1.y); w.w = pk2(o1.z, o1.w); xb[64 * j] = w;
            u32x2 q; q.x = pack4_e4m3(o0.x, o0.y, o0.z, o0.w); q.y = pack4_e4m3(o1.x, o1.y, o1.z, o1.w); x8[64 * j] = q; }
#pragma unroll
        for (int j = 0; j < 2; ++j) { r0[j] = r1[j]; r1[j] = r2[j]; }
    }
}
__device__ __forceinline__ void route(const float* __restrict__ logits, const float* __restrict__ rbias, int* __restrict__ idx, float* __restrict__ wgt, unsigned* __restrict__ counts,
                                      TLAS int* hist  , int wg, int nwg, int tid) {
    const int lane = tid & 63, wave = tid >> 6;
    if (tid < NE) hist[tid] = 0;
    __syncthreads();
    const int per = (T + nwg - 1) / nwg;
    const f32x4 rb = ((const f32x4*)rbias)[lane];
    constexpr int NT = 2;
    for (int i = wave * NT; i < per; i += 8 * NT) {
        int tok[NT]; bool live[NT]; f32x4 lg[NT];
#pragma unroll
        for (int u = 0; u < NT; ++u) { tok[u] = wg * per + i + u; live[u] = (i + u < per) && tok[u] < T; lg[u] = ((const f32x4*)(logits + (size_t)(live[u] ? tok[u] : wg * per) * NE))[lane]; }
        float s[NT][4], c[NT][4];
#pragma unroll
        for (int u = 0; u < NT; ++u)
#pragma unroll
            for (int j = 0; j < 4; ++j) { s[u][j] = sigmoidf_(lg[u][j]); c[u][j] = s[u][j] + rb[j]; }
        float m1[NT], m2[NT];
#pragma unroll
        for (int u = 0; u < NT; ++u) { const float a = fmaxf(c[u][0], c[u][1]), b = fminf(c[u][0], c[u][1]), d = fmaxf(c[u][2], c[u][3]), e = fminf(c[u][2], c[u][3]); m1[u] = fmaxf(a, d); m2[u] = fmaxf(fminf(a, d), fmaxf(b, e)); }
#pragma unroll
        for (int off = 1; off < 8; off <<= 1)
#pragma unroll
            for (int u = 0; u < NT; ++u) { const float o1 = __shfl_xor(m1[u], off), o2 = __shfl_xor(m2[u], off); const float n1 = fmaxf(m1[u], o1), n2 = fmaxf(fminf(m1[u], o1), fmaxf(m2[u], o2)); m1[u] = n1; m2[u] = n2; }
        const int g = lane >> 3;
        float gs[NT]; int rank[NT];
#pragma unroll
        for (int u = 0; u < NT; ++u) { gs[u] = m1[u] + m2[u]; rank[u] = 0; }
#pragma unroll
        for (int j = 0; j < 8; ++j)
#pragma unroll
            for (int u = 0; u < NT; ++u) { const float gj = __shfl(gs[u], 8 * j); rank[u] += (gj > gs[u] || (gj == gs[u] && j < g)) ? 1 : 0; }
#pragma unroll
        for (int u = 0; u < NT; ++u) if (rank[u] >= 4) { c[u][0] = -INFINITY; c[u][1] = -INFINITY; c[u][2] = -INFINITY; c[u][3] = -INFINITY; }
        int myidx[NT]; float mysc[NT], ssum[NT];
#pragma unroll
        for (int u = 0; u < NT; ++u) { myidx[u] = 0; mysc[u] = 0.f; ssum[u] = 0.f; }
#pragma unroll
        for (int k = 0; k < 8; ++k) {
            float bv[NT]; int be[NT];
#pragma unroll
            for (int u = 0; u < NT; ++u) { bv[u] = c[u][0]; int bi = 0;
#pragma unroll
                for (int j = 1; j < 4; ++j) if (c[u][j] > bv[u]) { bv[u] = c[u][j]; bi = j; }
                be[u] = 4 * lane + bi; }
#pragma unroll
            for (int off = 1; off < 64; off <<= 1)
#pragma unroll
                for (int u = 0; u < NT; ++u) { const float ov = __shfl_xor(bv[u], off); const int oe = __shfl_xor(be[u], off); const bool take = ov > bv[u] || (ov == bv[u] && oe < be[u]); bv[u] = take ? ov : bv[u]; be[u] = take ? oe : be[u]; }
#pragma unroll
            for (int u = 0; u < NT; ++u) { const int wj = be[u] & 3, wl = be[u] >> 2;
                const float sloc = wj == 0 ? s[u][0] : (wj == 1 ? s[u][1] : (wj == 2 ? s[u][2] : s[u][3]));
                const float ssel = __shfl(sloc, wl);
                ssum[u] += ssel; if (lane == k) { myidx[u] = be[u]; mysc[u] = ssel; }
#pragma unroll
                for (int j = 0; j < 4; ++j) c[u][j] = (lane == wl && j == wj) ? -INFINITY : c[u][j]; }
        }
#pragma unroll
        for (int u = 0; u < NT; ++u)
            if (live[u] && lane < 8) { idx[tok[u] * 8 + lane] = myidx[u]; wgt[tok[u] * 8 + lane] = mysc[u] / ssum[u] * 2.5f; __hip_atomic_fetch_add(&hist[myidx[u]], 1, __ATOMIC_RELAXED, __HIP_MEMORY_SCOPE_WORKGROUP); }
    }
    __syncthreads();
    if (tid < NE && hist[tid] > 0) atomicAdd(&counts[tid], (unsigned)hist[tid]);
}
__device__ __forceinline__ void scan_scatter(const unsigned* __restrict__ counts, unsigned* __restrict__ cursor, const int* __restrict__ idx, int* __restrict__ pos_of, int* __restrict__ sorted_tok,
                                             int* __restrict__ tiles256, int* __restrict__ tiles64, TLAS int* lds, int wg, int nwg, int tid) {
    TLAS int* cnt = lds; TLAS int* offs = lds + 256; TLAS int* lcnt = lds + 512; TLAS int* base = lds + 768;
    if (tid < NE) { cnt[tid] = (int)__hip_atomic_load(&counts[tid], __ATOMIC_RELAXED, __HIP_MEMORY_SCOPE_AGENT); lcnt[tid] = 0; }
    __syncthreads();
    if (tid < NE) { int o = 0; for (int j = 0; j < tid; ++j) o += cnt[j]; offs[tid] = o; }
    __syncthreads();
    const int per = NSLOT / nwg;
    int myr[4], mye[4];
#pragma unroll
    for (int i = 0; i < 4; ++i) { const int li = tid + 512 * i; mye[i] = -1; myr[i] = 0;
        if (li < per) { const int e = idx[wg * per + li]; mye[i] = e; myr[i] = __hip_atomic_fetch_add(&lcnt[e], 1, __ATOMIC_RELAXED, __HIP_MEMORY_SCOPE_WORKGROUP); } }
    __syncthreads();
    if (tid < NE) { const int c = lcnt[tid]; base[tid] = offs[tid] + (c > 0 ? (int)atomicAdd(&cursor[tid], (unsigned)c) : 0); }
    __syncthreads();
#pragma unroll
    for (int i = 0; i < 4; ++i) { const int li = tid + 512 * i;
        if (li < per) { const int slot = wg * per + li; const int p = base[mye[i]] + myr[i]; pos_of[slot] = p; sorted_tok[p] = slot >> 3; } }
    if (wg == 0) {
        if (tid < 256) sorted_tok[NSLOT + tid] = 0;
        if (HYBRID && tid < NE) { const int c = cnt[tid], off = offs[tid];
            int t256 = 0, t64 = 0; for (int j = 0; j < tid; ++j) { t256 += (cnt[j] + 255) >> 8; t64 += (cnt[j] + 63) >> 6; }
            const int n256 = (c + 255) >> 8, n64 = (c + 63) >> 6;
            for (int i = 0; i < n256; ++i) { tiles256[t256 + i] = tid; tiles256[MAXT256 + t256 + i] = off + 256 * i; tiles256[2 * MAXT256 + t256 + i] = (c - 256 * i) < 256 ? (c - 256 * i) : 256; }
            for (int i = 0; i < n64; ++i) { tiles64[t64 + i] = tid; tiles64[MAXT64 + t64 + i] = off + 64 * i; tiles64[2 * MAXT64 + t64 + i] = (c - 64 * i) < 64 ? (c - 64 * i) : 64; }
            if (tid == NE - 1) { tiles256[3 * MAXT256] = t256 + n256; tiles64[3 * MAXT64] = t64 + n64; } }
    }
    __syncthreads();
}
__device__ __forceinline__ void final_rows(const bf16* __restrict__ X1, const bf16* __restrict__ SH, const unsigned char* __restrict__ YS, const int* __restrict__ pos_of, const float* __restrict__ wgt,
                                           const float* __restrict__ g, const float* __restrict__ bta, float* __restrict__ out, int gw, int ngw, int lane) {
    typedef float f2_ __attribute__((ext_vector_type(2)));
    f32x4 gg[4], bb[4];
#pragma unroll
    for (int j = 0; j < 4; ++j) { gg[j] = ((const f32x4*)g)[lane + 64 * j]; bb[j] = ((const f32x4*)bta)[lane + 64 * j]; }
    const int l8 = lane & 7;
    unsigned slot_cur = 0u, slot_nxt = 0u;
    if (gw < T) slot_cur = (lane & 8) ? __float_as_uint(wgt[gw * 8 + l8]) : (unsigned)pos_of[gw * 8 + l8];
    for (int row = gw; row < T; row += ngw) {
        const int rn = (row + ngw < T) ? row + ngw : row;
        slot_nxt = (lane & 8) ? __float_as_uint(wgt[rn * 8 + l8]) : (unsigned)pos_of[rn * 8 + l8];
        unsigned yv[8][4];
#pragma unroll
        for (int k = 0; k < 8; ++k) { const int p = __builtin_amdgcn_readlane((int)slot_cur, k);
#pragma unroll
            for (int j = 0; j < 4; ++j) yv[k][j] = __builtin_nontemporal_load((const unsigned*)(YS + (size_t)p * D) + lane + 64 * j); }
        f32x4 v[4];
#pragma unroll
        for (int j = 0; j < 4; ++j) { const u32x2 a = ((const u32x2*)(X1 + (size_t)row * D))[lane + 64 * j]; const u32x2 s = ((const u32x2*)(SH + (size_t)row * D))[lane + 64 * j];
            v[j].x = ALPHA * bflo(a.x) + bflo(s.x); v[j].y = ALPHA * bfhi(a.x) + bfhi(s.x); v[j].z = ALPHA * bflo(a.y) + bflo(s.y); v[j].w = ALPHA * bfhi(a.y) + bfhi(s.y); }
#pragma unroll
        for (int k = 0; k < 8; ++k) { const float w = __uint_as_float((unsigned)__builtin_amdgcn_readlane((int)slot_cur, 8 + k)) * YS_INV;
#pragma unroll
            for (int j = 0; j < 4; ++j) { const f2_ lo = __builtin_amdgcn_cvt_pk_f32_fp8(yv[k][j], false), hi = __builtin_amdgcn_cvt_pk_f32_fp8(yv[k][j], true);
                v[j].x += w * lo.x; v[j].y += w * lo.y; v[j].z += w * hi.x; v[j].w += w * hi.y; } }
        float s = 0.f;
#pragma unroll
        for (int j = 0; j < 4; ++j) s += (v[j].x + v[j].y) + (v[j].z + v[j].w);
        const float mean = wave_sum(s) * (1.f / D); float s2 = 0.f;
#pragma unroll
        for (int j = 0; j < 4; ++j) { v[j] = v[j] - mean; s2 += (v[j].x * v[j].x + v[j].y * v[j].y) + (v[j].z * v[j].z + v[j].w * v[j].w); }
        const float rstd = rsqrtf(wave_sum(s2) * (1.f / D) + LN_EPS);
#pragma unroll
        for (int j = 0; j < 4; ++j) __builtin_nontemporal_store(v[j] * rstd * gg[j] + bb[j], (f32x4*)(out + (size_t)row * D) + lane + 64 * j);
        slot_cur = slot_nxt;
    }
}
}
namespace pg8 {
#define PG8_LAS __attribute__((address_space(3)))
typedef unsigned short bf16_t;
typedef short bf16x8 __attribute__((ext_vector_type(8)));
typedef float f32x4 __attribute__((ext_vector_type(4)));
typedef float f32x2 __attribute__((ext_vector_type(2)));
typedef unsigned u32x4 __attribute__((ext_vector_type(4)));
typedef unsigned u32x2 __attribute__((ext_vector_type(2)));
constexpr int BM = 256, BK = 64, HALF = 128, HTB = HALF * BK * 2  , STAGE_BYTES = 8 * HTB, NXCD = 8, WGM = 8;

__host__ __device__ __forceinline__ int lds_byte(int r, int c) { const int st = (r >> 4) * 2 + (c >> 5), rr = r & 15, cc = c & 31, ob = rr * 64 + cc * 2; return st * 1024 + (ob ^ (((ob >> 9) & 1) << 5)); }
__host__ __device__ __forceinline__ void stage_rc(int b, int& R, int& C) { const int st = b / 1024, sb = b % 1024, swz = sb ^ (((sb >> 9) & 1) << 5); R = (st >> 1) * 16 + swz / 64; C = (st & 1) * 32 + (swz % 64) / 2; }
__host__ __device__ __forceinline__ int perm32(int rho) { const int n = rho >> 4, i = rho & 15; return 8 * (i >> 2) + 4 * n + (i & 3); }

struct Unit { unsigned A; unsigned B; int pm, pn, aux, nr; };

__device__ __forceinline__ unsigned cvt_pk_bf16(float lo, float hi) { typedef __bf16 bf16x2_t __attribute__((ext_vector_type(2))); f32x2 v = {lo, hi}; bf16x2_t b = __builtin_convertvector(v, bf16x2_t); return __builtin_bit_cast(unsigned, b); }

typedef int i32x8 __attribute__((ext_vector_type(8)));
typedef i32x8 i32x8_a16 __attribute__((aligned(16)));
template <class Epi, class Sched, bool GATHER, bool GATHER_NR = false, bool F8 = false>
__device__ __forceinline__ void gemm_phase(PG8_LAS unsigned char* lds, const unsigned char* wsbase, const int K, const Sched& S, Epi& E, const int wave) {
    const __amdgpu_buffer_rsrc_t rsrc = __builtin_amdgcn_make_buffer_rsrc((void*)wsbase, 0, 0x7fffffff, 0x00020000);
    const int tid_ = otid(wave);
    const int tid = tid_, wid = wave, lane = tid & 63, wr = wid >> 2, wc = wid & 3, fr = lane & 15, fq = lane >> 4;
    const int nt = K / BK;
    unsigned voffA[2], voffB[2];
#pragma unroll
    for (int i = 0; i < 2; ++i) { int R, C; stage_rc(tid * 16 + i * 8192, R, C); const int Rb = Epi::PERM ? ((R & ~31) + perm32(R & 31)) : R;
        voffA[i] = (unsigned)(R * K + C) * 2u; voffB[i] = (unsigned)(Rb * K + C) * 2u; }
    const unsigned kstep = (unsigned)(BK * 2);
    const unsigned hstep = (unsigned)HALF * (unsigned)K * 2u;
    const unsigned ldsw = (unsigned)wid * 1024u, ldsb = (unsigned)(size_t)lds;
    const int aoff = lds_byte(wr * 64 + fr, fq * 8), boff = lds_byte(wc * 32 + fr, fq * 8);
#define PG8_SA(b, h) (((b) * 2 + (h)) * HTB)
#define PG8_SB(b, h) ((4 + (b) * 2 + (h)) * HTB)
#define PG8_STAGE(bufoff, gbase, voff) do { _Pragma("unroll") for (int _i = 0; _i < 2; ++_i) \
        asm volatile("s_mov_b32 m0, %0\n\ts_nop 0\n\tbuffer_load_dwordx4 %1, %2, %3 offen lds" :: "s"(ldsb + (unsigned)(bufoff) + ldsw + (unsigned)(_i * 8192)), "v"((voff)[_i]), "s"(rsrc), "s"((unsigned)(gbase)) : "m0", "memory"); } while (0)
#define PG8_STAGE_A(bufoff, p, h, g) do { if (GATHER) PG8_STAGE(bufoff, p, (g)[h]); else PG8_STAGE(bufoff, (p) + (h) * hstep, voffA); } while (0)
    const int aoff8 = lds_byte(wr * 64 + fr, fq * 16), boff8 = lds_byte(wc * 32 + fr, fq * 16);
#define PG8_LDA8(dst, b, h) do { _Pragma("unroll") for (int m = 0; m < 4; ++m) dst[m] = *(const PG8_LAS i32x8_a16*)(lds + PG8_SA(b, h) + aoff8 + m * 2048); } while (0)
#define PG8_LDB8(dst, b, h) do { _Pragma("unroll") for (int n = 0; n < 2; ++n) dst[n] = *(const PG8_LAS i32x8_a16*)(lds + PG8_SB(b, h) + boff8 + n * 2048); } while (0)
#define PG8_MMA8(ai, bj, At, Bt) do { __builtin_amdgcn_s_setprio(1); _Pragma("unroll") for (int m = 0; m < 4; ++m) _Pragma("unroll") for (int n = 0; n < 2; ++n) \
        acc[ai][bj][m][n] = __builtin_amdgcn_mfma_scale_f32_16x16x128_f8f6f4(Bt[n], At[m], acc[ai][bj][m][n], 0, 0, 0, 0x7F7F7F7F, 0, 0x7F7F7F7F); __builtin_amdgcn_s_setprio(0); } while (0)
#define PG8_LDA(dst, b, h) do { _Pragma("unroll") for (int m = 0; m < 4; ++m) _Pragma("unroll") for (int k = 0; k < 2; ++k) dst[m][k] = *(const PG8_LAS bf16x8*)(lds + PG8_SA(b, h) + aoff + m * 2048 + k * 1024); } while (0)
#define PG8_LDB(dst, b, h) do { _Pragma("unroll") for (int n = 0; n < 2; ++n) _Pragma("unroll") for (int k = 0; k < 2; ++k) dst[n][k] = *(const PG8_LAS bf16x8*)(lds + PG8_SB(b, h) + boff + n * 2048 + k * 1024); } while (0)
#define PG8_MMA(ai, bj, At, Bt) do { __builtin_amdgcn_s_setprio(1); _Pragma("unroll") for (int m = 0; m < 4; ++m) _Pragma("unroll") for (int n = 0; n < 2; ++n) _Pragma("unroll") for (int k = 0; k < 2; ++k) \
        acc[ai][bj][m][n] = __builtin_amdgcn_mfma_f32_16x16x32_bf16(Bt[n][k], At[m][k], acc[ai][bj][m][n], 0, 0, 0); __builtin_amdgcn_s_setprio(0); } while (0)
#define PG8_WAIT_V(n) asm volatile("s_waitcnt vmcnt(" #n ")" ::: "memory")
#define PG8_WAIT_L(n) asm volatile("s_waitcnt lgkmcnt(" #n ")" ::: "memory")
#define PG8_BAR __builtin_amdgcn_s_barrier()
#define PG8_SCHED __builtin_amdgcn_sched_barrier(0)
#define PG8_GOFF(dst, u) do { if (GATHER) { _Pragma("unroll") for (int _i = 0; _i < 2; ++_i) { int _R, _C; stage_rc(tid * 16 + _i * 8192, _R, _C); _Pragma("unroll") for (int _h = 0; _h < 2; ++_h) \
        dst[_h][_i] = (unsigned)(S.row_index((u), _R + _h * HALF) * K + _C) * 2u; } } } while (0)
    Unit cur, nxt; int ui = 0;
    if (!S.next(0, cur)) return;
    f32x4 acc[2][2][4][2];
#pragma unroll
    for (int a = 0; a < 2; ++a)
#pragma unroll
        for (int b = 0; b < 2; ++b)
#pragma unroll
            for (int m = 0; m < 4; ++m)
#pragma unroll
                for (int n = 0; n < 2; ++n) acc[a][b][m][n] = (f32x4){0.f, 0.f, 0.f, 0.f};
    bf16x8 At[4][2], B0[2][2], B1[2][2];
    i32x8 At8[4], B08[2], B18[2];
    unsigned curG[2][2] = {{0u, 0u}, {0u, 0u}}, nxtG[2][2] = {{0u, 0u}, {0u, 0u}};
    unsigned cA = cur.A, cB = cur.B;
    PG8_GOFF(curG, cur);
    PG8_STAGE(PG8_SB(0, 0), cB, voffB); PG8_STAGE(PG8_SB(0, 1), cB + hstep, voffB); PG8_STAGE_A(PG8_SA(0, 0), cA, 0, curG); PG8_STAGE_A(PG8_SA(0, 1), cA, 1, curG);
    if (wr == 1) PG8_BAR;
    PG8_WAIT_V(2); PG8_BAR;
    PG8_STAGE(PG8_SB(1, 0), cB + kstep, voffB); PG8_STAGE_A(PG8_SA(1, 0), cA + kstep, 0, curG); PG8_STAGE(PG8_SB(1, 1), cB + hstep + kstep, voffB);
    PG8_WAIT_V(6); PG8_BAR;
    for (;;) {
        const bool has_next = S.next(ui + 1, nxt);
        const unsigned nA = has_next ? nxt.A : cA, nB = has_next ? nxt.B : cB;
        if (GATHER) { if (has_next) PG8_GOFF(nxtG, nxt); else { _Pragma("unroll") for (int _h = 0; _h < 2; ++_h) _Pragma("unroll") for (int _i = 0; _i < 2; ++_i) nxtG[_h][_i] = curG[_h][_i]; } }
#pragma unroll 1
        for (int t = 0; t < nt; t += 2) {
            const bool last = (t == nt - 2);
            const unsigned a1 = cA + (unsigned)(t + 1) * kstep;
            const unsigned a2 = last ? nA : cA + (unsigned)(t + 2) * kstep, b2 = last ? nB : cB + (unsigned)(t + 2) * kstep;
            const unsigned a3 = a2 + kstep, b3 = b2 + kstep;
            if (F8) { PG8_LDB8(B08, 0, 0); PG8_LDB8(B18, 0, 1); PG8_SCHED; PG8_LDA8(At8, 0, 0); } else { PG8_LDB(B0, 0, 0); PG8_LDB(B1, 0, 1); PG8_SCHED; PG8_LDA(At, 0, 0); } PG8_STAGE_A(PG8_SA(1, 1), a1, 1, curG);
            if (GATHER) { if (last) { _Pragma("unroll") for (int _h = 0; _h < 2; ++_h) _Pragma("unroll") for (int _i = 0; _i < 2; ++_i) curG[_h][_i] = nxtG[_h][_i]; } }
            PG8_WAIT_V(8); PG8_WAIT_L(0); PG8_BAR; if (F8) { PG8_MMA8(0, 0, At8, B08); PG8_MMA8(0, 1, At8, B18); } else { PG8_MMA(0, 0, At, B0); PG8_MMA(0, 1, At, B1); } PG8_BAR; PG8_SCHED;
            if (F8) PG8_LDA8(At8, 0, 1); else PG8_LDA(At, 0, 1); PG8_STAGE(PG8_SB(0, 0), b2, voffB); PG8_STAGE(PG8_SB(0, 1), b2 + hstep, voffB); PG8_STAGE_A(PG8_SA(0, 0), a2, 0, curG);
            PG8_WAIT_V(8); PG8_WAIT_L(0); PG8_BAR; if (!GATHER_NR || cur.nr > HALF) { if (F8) { PG8_MMA8(1, 0, At8, B08); PG8_MMA8(1, 1, At8, B18); } else { PG8_MMA(1, 0, At, B0); PG8_MMA(1, 1, At, B1); } } PG8_BAR; PG8_SCHED;
            if (F8) { PG8_LDB8(B08, 1, 0); PG8_LDB8(B18, 1, 1); PG8_SCHED; PG8_LDA8(At8, 1, 0); } else { PG8_LDB(B0, 1, 0); PG8_LDB(B1, 1, 1); PG8_SCHED; PG8_LDA(At, 1, 0); } PG8_STAGE_A(PG8_SA(0, 1), a2, 1, curG);
            PG8_WAIT_V(8); PG8_WAIT_L(0); PG8_BAR; if (F8) { PG8_MMA8(0, 0, At8, B08); PG8_MMA8(0, 1, At8, B18); } else { PG8_MMA(0, 0, At, B0); PG8_MMA(0, 1, At, B1); } PG8_BAR; PG8_SCHED;
            if (F8) PG8_LDA8(At8, 1, 1); else PG8_LDA(At, 1, 1); PG8_STAGE(PG8_SB(1, 0), b3, voffB); PG8_STAGE(PG8_SB(1, 1), b3 + hstep, voffB); PG8_STAGE_A(PG8_SA(1, 0), a3, 0, curG);
            PG8_WAIT_V(8); PG8_WAIT_L(0); PG8_BAR; if (!GATHER_NR || cur.nr > HALF) { if (F8) { PG8_MMA8(1, 0, At8, B08); PG8_MMA8(1, 1, At8, B18); } else { PG8_MMA(1, 0, At, B0); PG8_MMA(1, 1, At, B1); } } PG8_BAR; PG8_SCHED;
        }
        if (wr == 0) PG8_BAR;
        { const int l2 = lane_id();
          E(acc, cur, wr, wc, l2 & 15, l2 >> 4); }
        if (!has_next) break;
        if (!E.keep(cur)) {
#pragma unroll
        for (int a = 0; a < 2; ++a)
#pragma unroll
            for (int b = 0; b < 2; ++b)
#pragma unroll
                for (int m = 0; m < 4; ++m)
#pragma unroll
                    for (int n = 0; n < 2; ++n) acc[a][b][m][n] = (f32x4){0.f, 0.f, 0.f, 0.f};
        }
        cur = nxt; cA = nA; cB = nB; ++ui;
        if (wr == 1) PG8_BAR;
    }
    PG8_WAIT_V(0);
    PG8_BAR;
#undef PG8_SA
#undef PG8_SB
#undef PG8_STAGE
#undef PG8_STAGE_A
#undef PG8_LDA
#undef PG8_LDA8
#undef PG8_LDB8
#undef PG8_MMA8
#undef PG8_LDB
#undef PG8_MMA
#undef PG8_WAIT_V
#undef PG8_WAIT_L
#undef PG8_BAR
#undef PG8_SCHED
#undef PG8_GOFF
}

struct GridOrder {
    unsigned A0, B0, asub, bsub; int nsub, nM, nN, nwg, G, c; unsigned astep, bstep;
    __device__ __forceinline__ void init(int M, int N, int K, int G_, int c_, int nsub_) { nM = M / BM; nN = N / BM; nwg = nM * nN; G = G_; c = c_; nsub = nsub_; astep = (unsigned)BM * (unsigned)K * 2u; bstep = astep; asub = 0; bsub = 0; }
    __device__ __forceinline__ bool next(int i, Unit& u) const {
        const int sub = i % nsub; const long L = (long)(i / nsub) * G + c; if (L >= nwg) return false;
        int wgid = (int)L; { const int q = nwg / NXCD, r = nwg % NXCD, xcd = wgid % NXCD, off = wgid / NXCD; wgid = (xcd < r ? xcd * (q + 1) : r * (q + 1) + (xcd - r) * q) + off; }
        const int nig = WGM * nN, gid = wgid / nig, fm = gid * WGM, gsz = (nM - fm) < WGM ? (nM - fm) : WGM;
        u.pm = fm + ((wgid % nig) % gsz); u.pn = (wgid % nig) / gsz; u.aux = sub; u.nr = BM;
        const unsigned a_ = A0 + (unsigned)sub * asub, b_ = B0 + (unsigned)sub * bsub;
        u.A = a_ + (unsigned)u.pm * astep; u.B = b_ + (unsigned)u.pn * bstep; return true;
    }
    __device__ __forceinline__ int row_index(const Unit&, int r) const { return r; }
};
}
namespace pg8 {
#define EPI_FOR_AI_M _Pragma("unroll") for (int ai = 0; ai < 2; ++ai) _Pragma("unroll") for (int m = 0; m < 4; ++m)
__device__ __forceinline__ u32x4 pack8(const f32x4& v0, const f32x4& v1) { u32x4 w; w.x = cvt_pk_bf16(v0[0], v0[1]); w.y = cvt_pk_bf16(v0[2], v0[3]); w.z = cvt_pk_bf16(v1[0], v1[1]); w.w = cvt_pk_bf16(v1[2], v1[3]); return w; }
__device__ __forceinline__ void unpack8(const u32x4& w, f32x4& v0, f32x4& v1) { v0 = (f32x4){bflo(w.x), bfhi(w.x), bflo(w.y), bfhi(w.y)}; v1 = (f32x4){bflo(w.z), bfhi(w.z), bflo(w.w), bfhi(w.w)}; }
__device__ __forceinline__ float silu_mul(float g, float u) { return g * u * __builtin_amdgcn_rcpf(1.f + __expf(-g)); }

struct EpiProj {
    static constexpr bool PERM = true;
    bf16_t* O;
    __device__ __forceinline__ bool keep(const Unit&) const { return false; }
    __device__ __forceinline__ void operator()(f32x4 (&acc)[2][2][4][2], const Unit& u, int wr, int wc, int fr, int fq) const {
        const int row0 = u.pm * BM + wr * 64 + fr, col0 = u.pn * BM + wc * 32 + 8 * fq;
        const int pn = u.pn;
        const float sc = (pn < 2 || pn == 6 || pn == 7) ? QS64 : ((pn == 9 || pn == 10) ? QS128 : 1.f);
        EPI_FOR_AI_M { bf16_t* rowp = O + (size_t)(row0 + ai * HALF + m * 16) * IN_COLS + col0;
#pragma unroll
            for (int bj = 0; bj < 2; ++bj) *(u32x4*)(rowp + bj * HALF) = pack8(acc[ai][bj][m][0] * sc, acc[ai][bj][m][1] * sc); }
    }
};
struct EpiGate8 {
    static constexpr bool PERM = true;
    const PG8_LAS float* b_gate; u32x4* GT;
    __device__ __forceinline__ bool keep(const Unit&) const { return false; }
    __device__ __forceinline__ void operator()(f32x4 (&acc)[2][2][4][2], const Unit& u, int wr, int wc, int fr, int fq) const {
        const int col0 = u.pn * BM + wc * 32 + 8 * fq;
        f32x4 bv[2][2];
#pragma unroll
        for (int bj = 0; bj < 2; ++bj)
#pragma unroll
            for (int n = 0; n < 2; ++n) bv[bj][n] = *(const PG8_LAS f32x4*)(b_gate + col0 + bj * HALF + 4 * n);
        char* tile = (char*)(GT + ((size_t)(u.pm * 12 + u.pn) * 16) * 512);
        unsigned off = (unsigned)((wr * 4 + wc) * 64 + (fq * 16 + fr)) * 16u;
        EPI_FOR_AI_M {
#pragma unroll
            for (int bj = 0; bj < 2; ++bj) { f32x4 v0 = acc[ai][bj][m][0] * (-W8_INV * LOG2E) + bv[bj][0], v1 = acc[ai][bj][m][1] * (-W8_INV * LOG2E) + bv[bj][1];
#pragma unroll
                for (int j = 0; j < 4; ++j) { v0[j] = __builtin_amdgcn_rcpf(1.f + __builtin_amdgcn_exp2f(__builtin_amdgcn_fmed3f(v0[j], -30.f * LOG2E, 30.f * LOG2E))); v1[j] = __builtin_amdgcn_rcpf(1.f + __builtin_amdgcn_exp2f(__builtin_amdgcn_fmed3f(v1[j], -30.f * LOG2E, 30.f * LOG2E))); }
                *(u32x4*)(tile + off) = pack8(v0, v1); off += 512u * 16u; asm volatile("" : "+v"(off)); } }
    }
};
struct EpiBf16 {
    static constexpr bool PERM = true;
    bf16_t* O; int ldc; float sc;
    __device__ __forceinline__ bool keep(const Unit&) const { return false; }
    __device__ __forceinline__ void operator()(f32x4 (&acc)[2][2][4][2], const Unit& u, int wr, int wc, int fr, int fq) const {
        const int row0 = u.pm * BM + wr * 64 + fr, col0 = u.pn * BM + wc * 32 + 8 * fq;
        EPI_FOR_AI_M { bf16_t* rowp = O + (size_t)(row0 + ai * HALF + m * 16) * ldc + col0;
#pragma unroll
            for (int bj = 0; bj < 2; ++bj) *(u32x4*)(rowp + bj * HALF) = pack8(acc[ai][bj][m][0] * sc, acc[ai][bj][m][1] * sc); }
    }
};
struct EpiOutProj {
    static constexpr bool PERM = true;
    unsigned char* O; const u32x4* GT;
    __device__ __forceinline__ bool keep(const Unit& u) const { return u.aux != 2; }
    __device__ __forceinline__ void operator()(f32x4 (&acc)[2][2][4][2], const Unit& u, int wr, int wc, int fr, int fq) const {
        const int row0 = u.pm * BM + wr * 64 + fr, col0 = u.pn * BM + wc * 32 + 8 * fq; const int sub = u.aux;
        const u32x4* ga = GT + ((size_t)(u.pm * 12 + sub * 4 + u.pn) * 16) * 512 + (wr * 4 + wc) * 64 + (fq * 16 + fr);
        const u32x4* gb = ga + (sub != 2 ? (size_t)4 * 16 * 512 : 0);
#pragma unroll
        for (int ai = 0; ai < 2; ++ai) {
            u32x4 wa[4][2], wb[4][2];
#pragma unroll
            for (int m = 0; m < 4; ++m)
#pragma unroll
                for (int bj = 0; bj < 2; ++bj) { const int fi = ((ai * 4 + m) * 2 + bj) * 512; wa[m][bj] = ga[fi]; wb[m][bj] = gb[fi]; }
#pragma unroll
            for (int m = 0; m < 4; ++m) { const size_t row = (size_t)(row0 + ai * HALF + m * 16);
#pragma unroll
                for (int bj = 0; bj < 2; ++bj) {
                    f32x4 a0, a1; unpack8(wa[m][bj], a0, a1);
                    if (sub != 2) { f32x4 b0, b1; unpack8(wb[m][bj], b0, b1);
#pragma unroll
                        for (int j = 0; j < 4; ++j) { a0[j] *= __builtin_amdgcn_rcpf(b0[j]); a1[j] *= __builtin_amdgcn_rcpf(b1[j]); } }
                    acc[ai][bj][m][0] = acc[ai][bj][m][0] * a0; acc[ai][bj][m][1] = acc[ai][bj][m][1] * a1;
                    if (sub == 2) { constexpr float sc = M8_SCALE / (O8_SCALE * W8_SCALE); const f32x4 v0 = acc[ai][bj][m][0] * sc, v1 = acc[ai][bj][m][1] * sc;
                        u32x2 w; w.x = pack4_e4m3(v0[0], v0[1], v0[2], v0[3]); w.y = pack4_e4m3(v1[0], v1[1], v1[2], v1[3]); *(u32x2*)(O + row * D + col0 + bj * HALF) = w; } } }
        }
    }
};
struct EpiY {
    static constexpr bool PERM = true;
    bf16_t* Z; const bf16_t* XB;
    __device__ __forceinline__ bool keep(const Unit&) const { return false; }
    __device__ __forceinline__ void operator()(f32x4 (&acc)[2][2][4][2], const Unit& u, int wr, int wc, int fr, int fq) const {
        const int row0 = u.pm * BM + wr * 64 + fr, col0 = u.pn * BM + wc * 32 + 8 * fq;
        u32x4 xv[2][4][2];
#pragma unroll
        for (int ai = 0; ai < 2; ++ai)
#pragma unroll
            for (int m = 0; m < 4; ++m) { const size_t off = (size_t)(row0 + ai * HALF + m * 16) * D + col0;
#pragma unroll
                for (int bj = 0; bj < 2; ++bj) xv[ai][m][bj] = *(const u32x4*)(XB + off + bj * HALF); }
#pragma unroll
        for (int ai = 0; ai < 2; ++ai)
#pragma unroll
            for (int m = 0; m < 4; ++m) { const size_t off = (size_t)(row0 + ai * HALF + m * 16) * D + col0;
#pragma unroll
                for (int bj = 0; bj < 2; ++bj) { f32x4 x0, x1; unpack8(xv[ai][m][bj], x0, x1);
                    *(u32x4*)(Z + off + bj * HALF) = pack8(x0 * ALPHA + acc[ai][bj][m][0] * (1.f / (M8_SCALE * W8_SCALE)), x1 * ALPHA + acc[ai][bj][m][1] * (1.f / (M8_SCALE * W8_SCALE))); } }
    }
};
struct EpiRouter {
    static constexpr bool PERM = true;
    float* logits;
    __device__ __forceinline__ bool keep(const Unit&) const { return false; }
    __device__ __forceinline__ void operator()(f32x4 (&acc)[2][2][4][2], const Unit& u, int wr, int wc, int fr, int fq) const {
        const int row0 = u.pm * BM + wr * 64 + fr, c8 = wc * 32 + 8 * fq;
        EPI_FOR_AI_M { float* rowp = logits + (size_t)(row0 + ai * HALF + m * 16) * NE + c8;
#pragma unroll
            for (int bj = 0; bj < 2; ++bj) { *(f32x4*)(rowp + bj * HALF) = acc[ai][bj][m][0]; *(f32x4*)(rowp + bj * HALF + 4) = acc[ai][bj][m][1]; } }
    }
};
struct EpiShared8 {
    static constexpr bool PERM = true;
    unsigned char* HS;
    __device__ __forceinline__ bool keep(const Unit&) const { return false; }
    __device__ __forceinline__ void operator()(f32x4 (&acc)[2][2][4][2], const Unit& u, int wr, int wc, int fr, int fq) const {
        const int row0 = u.pm * BM + wr * 64 + fr, c8 = wc * 32 + 8 * fq;
        EPI_FOR_AI_M { f32x4 h0, h1;
#pragma unroll
            for (int j = 0; j < 4; ++j) { h0[j] = silu_mul(acc[ai][0][m][0][j] * W8_INV, acc[ai][1][m][0][j] * (W8_INV * H8_SCALE)); h1[j] = silu_mul(acc[ai][0][m][1][j] * W8_INV, acc[ai][1][m][1][j] * (W8_INV * H8_SCALE)); }
            u32x2 w; w.x = pack4_e4m3(h0[0], h0[1], h0[2], h0[3]); w.y = pack4_e4m3(h1[0], h1[1], h1[2], h1[3]);
            *(u32x2*)(HS + (size_t)(row0 + ai * HALF + m * 16) * EFF + u.pn * HALF + c8) = w; }
    }
};
struct EpiExpGU {
    static constexpr bool PERM = true;
    bf16_t* H;
    __device__ __forceinline__ bool keep(const Unit&) const { return false; }
    __device__ __forceinline__ void operator()(f32x4 (&acc)[2][2][4][2], const Unit& u, int wr, int wc, int fr, int fq) const {
        const int c8 = wc * 32 + 8 * fq;
        EPI_FOR_AI_M { const int rl = ai * HALF + wr * 64 + m * 16 + fr; f32x4 h0, h1;
#pragma unroll
            for (int j = 0; j < 4; ++j) { h0[j] = silu_mul(acc[ai][0][m][0][j], acc[ai][1][m][0][j]); h1[j] = silu_mul(acc[ai][0][m][1][j], acc[ai][1][m][1][j]); }
            if (rl < u.nr) *(u32x4*)(H + (size_t)(u.pm + rl) * EFF + u.pn * HALF + c8) = pack8(h0, h1); }
    }
};
struct EpiExpGU8 {
    static constexpr bool PERM = true;
    unsigned char* H;
    __device__ __forceinline__ bool keep(const Unit&) const { return false; }
    __device__ __forceinline__ void operator()(f32x4 (&acc)[2][2][4][2], const Unit& u, int wr, int wc, int fr, int fq) const {
        const int c8 = wc * 32 + 8 * fq;
        EPI_FOR_AI_M { const int rl = ai * HALF + wr * 64 + m * 16 + fr; f32x4 h0, h1;
#pragma unroll
            for (int j = 0; j < 4; ++j) { h0[j] = silu_mul(acc[ai][0][m][0][j] * W8_INV, acc[ai][1][m][0][j] * (W8_INV * H8_SCALE)); h1[j] = silu_mul(acc[ai][0][m][1][j] * W8_INV, acc[ai][1][m][1][j] * (W8_INV * H8_SCALE)); }
            if (rl < u.nr) { u32x2 w; w.x = pack4_e4m3(h0[0], h0[1], h0[2], h0[3]); w.y = pack4_e4m3(h1[0], h1[1], h1[2], h1[3]);
                *(u32x2*)(H + (size_t)(u.pm + rl) * EFF + u.pn * HALF + c8) = w; } }
    }
};
__device__ __forceinline__ unsigned pack4_fp8(const f32x4& v) {
    const float a = fminf(fmaxf(v[0] * YS_SCALE, -448.f), 448.f), b = fminf(fmaxf(v[1] * YS_SCALE, -448.f), 448.f), c = fminf(fmaxf(v[2] * YS_SCALE, -448.f), 448.f), d = fminf(fmaxf(v[3] * YS_SCALE, -448.f), 448.f);
    unsigned w = __builtin_amdgcn_cvt_pk_fp8_f32(a, b, 0u, false); return __builtin_amdgcn_cvt_pk_fp8_f32(c, d, w, true);
}
struct EpiExpDown {
    static constexpr bool PERM = true;
    unsigned char* Y; float sc;
    __device__ __forceinline__ bool keep(const Unit&) const { return false; }
    __device__ __forceinline__ void operator()(f32x4 (&acc)[2][2][4][2], const Unit& u, int wr, int wc, int fr, int fq) const {
        const int col0 = u.pn * BM + wc * 32 + 8 * fq;
        EPI_FOR_AI_M { const int rl = ai * HALF + wr * 64 + m * 16 + fr;
            if (rl < u.nr) { unsigned char* rowp = Y + (size_t)(u.pm + rl) * D + col0;
#pragma unroll
                for (int bj = 0; bj < 2; ++bj) { u32x2 w; w.x = pack4_fp8(acc[ai][bj][m][0] * sc); w.y = pack4_fp8(acc[ai][bj][m][1] * sc); *(u32x2*)(rowp + bj * HALF) = w; } } }
    }
};
struct ExpertOrder {
    const PG8_LAS int* offs; const PG8_LAS int* cnt; const PG8_LAS unsigned short* tmap;
    int nN, nwg, G, c; unsigned A; const int* rows; unsigned arow; unsigned Bb, bexp, bstep;
    __device__ __forceinline__ bool next(int i, Unit& u) const {
        const long L = (long)i * G + c; if (L >= nwg) return false;
        int wgid = (int)L; { const int q = nwg / NXCD, r = nwg % NXCD, xcd = wgid % NXCD, off = wgid / NXCD; wgid = (xcd < r ? xcd * (q + 1) : r * (q + 1) + (xcd - r) * q) + off; }
        const int tile = wgid / nN; u.pn = wgid % nN;
        const int tm = __builtin_amdgcn_readfirstlane((int)tmap[tile]); const int e = tm >> 7, ti = tm & 127;
        const int ce = __builtin_amdgcn_readfirstlane(cnt[e]), oe = __builtin_amdgcn_readfirstlane(offs[e]);
        u.aux = e; u.pm = oe + 256 * ti; u.nr = (ce - 256 * ti) < 256 ? (ce - 256 * ti) : 256;
        u.A = rows ? A : A + (unsigned)u.pm * arow; u.B = Bb + (unsigned)u.aux * bexp + (unsigned)u.pn * bstep; return true;
    }
    __device__ __forceinline__ int row_index(const Unit& u, int r) const { return rows[u.pm + r]; }
};
__device__ __forceinline__ int build_tile_map(const unsigned* counts, PG8_LAS int* tab, int tid) {
    PG8_LAS int* offs = tab; PG8_LAS int* cnt = tab + 256; PG8_LAS unsigned short* tmap = (PG8_LAS unsigned short*)(tab + 512); PG8_LAS int* tot = tab + 512 + 640;
    if (tid < 256) cnt[tid] = (int)__hip_atomic_load(&counts[tid], __ATOMIC_RELAXED, __HIP_MEMORY_SCOPE_AGENT);
    __syncthreads();
    if (tid < 256) { int o = 0, t0 = 0; for (int j = 0; j < tid; ++j) { o += cnt[j]; t0 += (cnt[j] + 255) >> 8; }
        offs[tid] = o; const int nt = (cnt[tid] + 255) >> 8;
        for (int i = 0; i < nt; ++i) tmap[t0 + i] = (unsigned short)((tid << 7) | i);
        if (tid == 255) tot[0] = t0 + nt; }
    __syncthreads();
    return tot[0];
}

__device__ __forceinline__ void down_phase(PG8_LAS unsigned char* lds, unsigned char* wsbase, const PG8_LAS int* offs, const PG8_LAS int* cnt, const PG8_LAS int* srt, const int G, const int c, const unsigned Abase, const unsigned Bbase, const unsigned Ybase, const unsigned dump0, const float sc, const int wave, const int probe  ) {
    const __amdgpu_buffer_rsrc_t rsrc = __builtin_amdgcn_make_buffer_rsrc((void*)wsbase, 0, 0x7fffffff, 0x00020000);
    const int tid = otid(wave), wid = wave, lane = tid & 63, wr = wid >> 2, wc = wid & 3, fr = lane & 15, fq = lane >> 4;
    constexpr unsigned ROWB = EFF;
    unsigned voffA[2];
#pragma unroll
    for (int i = 0; i < 2; ++i) { int R, C; stage_rc(tid * 16 + i * 8192, R, C); voffA[i] = (unsigned)R * ROWB + (unsigned)C * 2u; }
    const unsigned ldsw = (unsigned)wid * 1024u, ldsb = (unsigned)(size_t)lds;
    const int aoff8 = lds_byte(wr * 64 + fr, fq * 16);
#define DN_LOAD(ldsoff, goff, voff) do { _Pragma("unroll") for (int _i = 0; _i < 2; ++_i) \
        asm volatile("s_mov_b32 m0, %0\n\ts_nop 0\n\tbuffer_load_dwordx4 %1, %2, %3 offen lds" :: "s"(ldsb + (unsigned)(ldsoff) + ldsw + (unsigned)(_i * 8192)), "v"((voff)[_i]), "s"(rsrc), "s"((unsigned)(goff)) : "m0", "memory"); } while (0)
#define DN_STAGE_A(st) do { if (probe == 3) break; const int _s = (st) < nst ? (st) : nst - 1; const unsigned _g = arow0 + (unsigned)_s * (128u * ROWB); const unsigned _l = (unsigned)((st) & 3) * 32768u; \
        DN_LOAD(_l, _g, voffA); DN_LOAD(_l + 16384u, _g + 128u, voffA); } while (0)
#define DN_WAIT(n) asm volatile("s_waitcnt vmcnt(" #n ")" ::: "memory")
#define DN_BAR __builtin_amdgcn_s_barrier()
    for (int it = 0;; ++it) {
        const int L = it * G + c; if (L >= NE * 4) break;
        int e, pn;
        if (G == 256) { const int g = (c & 7) + 8 * (c >> 5); pn = (c >> 3) & 3; e = __builtin_amdgcn_readfirstlane(srt[it * 64 + ((it & 1) ? 63 - g : g)]); }
        else { const int x = L & 7, j = L >> 3; e = ((j >> 2) << 3) | x; pn = j & 3; }
        const int ce = __builtin_amdgcn_readfirstlane(cnt[e]), oe = __builtin_amdgcn_readfirstlane(offs[e]);
        if (ce <= 0) continue;
        const int nst = (ce + 127) >> 7;
        const unsigned arow0 = Abase + (unsigned)oe * ROWB;
        const unsigned b0 = Bbase + (unsigned)e * (unsigned)(D * EFF) + (unsigned)pn * (256u * ROWB);
        unsigned voffB[2]; int boff8;
        { const int t2 = otid(wave), l2 = t2 & 63;
#pragma unroll
          for (int i = 0; i < 2; ++i) { int R, C; stage_rc(t2 * 16 + i * 8192, R, C); const int Rb = (R >> 5) * 64 + 16 * ((R & 15) >> 2) + 4 * ((R >> 4) & 1) + (R & 3); voffB[i] = (unsigned)Rb * ROWB + (unsigned)C * 2u; }
          boff8 = lds_byte(wc * 32 + (l2 & 15), (l2 >> 4) * 16); }
#pragma unroll
        for (int b = 0; b < 2; ++b)
#pragma unroll
            for (int h = 0; h < 2; ++h) DN_LOAD(65536u + (unsigned)(b * 2 + h) * 16384u, b0 + (unsigned)h * (8u * ROWB) + (unsigned)b * 128u, voffB);
        DN_STAGE_A(0); DN_STAGE_A(1);
        DN_WAIT(8); DN_BAR;
        i32x8 Bf[2][2][2];
#pragma unroll
        for (int b = 0; b < 2; ++b)
#pragma unroll
            for (int bj = 0; bj < 2; ++bj)
#pragma unroll
                for (int n = 0; n < 2; ++n) Bf[b][bj][n] = *(const PG8_LAS i32x8_a16*)(lds + 65536 + (b * 2 + bj) * 16384 + boff8 + n * 2048);
        asm volatile("s_waitcnt lgkmcnt(0)" ::: "memory");
#pragma unroll
        for (int b = 0; b < 2; ++b)
#pragma unroll
            for (int bj = 0; bj < 2; ++bj)
#pragma unroll
                for (int n = 0; n < 2; ++n) asm volatile("" : "+v"(Bf[b][bj][n]));
        DN_BAR;
        DN_STAGE_A(2); DN_STAGE_A(3);
        f32x4 acc[2][4][2];
#pragma unroll
        for (int bj = 0; bj < 2; ++bj)
#pragma unroll
            for (int m = 0; m < 4; ++m)
#pragma unroll
                for (int n = 0; n < 2; ++n) acc[bj][m][n] = (f32x4){0.f, 0.f, 0.f, 0.f};
#define DN_MFMA(st) do { const int _q = (st) & 3; const f32x4 _z = {0.f, 0.f, 0.f, 0.f}; if (probe == 2) { _Pragma("unroll") for (int bj = 0; bj < 2; ++bj) _Pragma("unroll") for (int m = 0; m < 4; ++m) _Pragma("unroll") for (int n = 0; n < 2; ++n) acc[bj][m][n] = _z; break; } \
        { i32x8 At[4]; \
          _Pragma("unroll") for (int m = 0; m < 4; ++m) At[m] = *(const PG8_LAS i32x8_a16*)(lds + _q * 32768 + aoff8 + m * 2048); \
          __builtin_amdgcn_s_setprio(1); \
          _Pragma("unroll") for (int bj = 0; bj < 2; ++bj) _Pragma("unroll") for (int m = 0; m < 4; ++m) _Pragma("unroll") for (int n = 0; n < 2; ++n) \
              acc[bj][m][n] = __builtin_amdgcn_mfma_scale_f32_16x16x128_f8f6f4(Bf[0][bj][n], At[m], _z, 0, 0, 0, 0x7F7F7F7F, 0, 0x7F7F7F7F);     \
          __builtin_amdgcn_s_setprio(0); __builtin_amdgcn_sched_barrier(0); } \
        { i32x8 At[4]; \
          _Pragma("unroll") for (int m = 0; m < 4; ++m) At[m] = *(const PG8_LAS i32x8_a16*)(lds + _q * 32768 + 16384 + aoff8 + m * 2048); \
          __builtin_amdgcn_s_setprio(1); \
          _Pragma("unroll") for (int bj = 0; bj < 2; ++bj) _Pragma("unroll") for (int m = 0; m < 4; ++m) _Pragma("unroll") for (int n = 0; n < 2; ++n) \
              acc[bj][m][n] = __builtin_amdgcn_mfma_scale_f32_16x16x128_f8f6f4(Bf[1][bj][n], At[m], acc[bj][m][n], 0, 0, 0, 0x7F7F7F7F, 0, 0x7F7F7F7F); \
          __builtin_amdgcn_s_setprio(0); __builtin_amdgcn_sched_barrier(0); } } while (0)
#define DN_EPI(st) do { const int _l = lane_id(), _fr = _l & 15, _fq = _l >> 4;     \
        const int _r0 = (st) * 128 + wr * 64 + _fr; const unsigned _y0 = Ybase + (unsigned)(oe + _r0) * (unsigned)D + (unsigned)(pn * 256 + wc * 64 + 16 * _fq); const unsigned dump = dump0 + (unsigned)(wid * 64 + _l) * 16u; \
        _Pragma("unroll") for (int m = 0; m < 4; ++m) { const bool _ok = (_r0 + 16 * m) < ce && probe != 1; u32x4 w; \
            { const f32x4 v0 = acc[0][m][0] * sc, v1 = acc[0][m][1] * sc, v2 = acc[1][m][0] * sc, v3 = acc[1][m][1] * sc; \
              w.x = pack4_e4m3(v0[0], v0[1], v0[2], v0[3]); w.y = pack4_e4m3(v1[0], v1[1], v1[2], v1[3]); w.z = pack4_e4m3(v2[0], v2[1], v2[2], v2[3]); w.w = pack4_e4m3(v3[0], v3[1], v3[2], v3[3]); } \
            const unsigned _o = _ok ? _y0 + (unsigned)(16 * m) * (unsigned)D : dump; \
            __builtin_amdgcn_raw_buffer_store_b128(w, rsrc, (int)_o, 0, 0); } } while (0)
#define DN_STEP_HEAD(s) do { if ((s) >= 4) DN_WAIT(20); else if ((s) == 3) DN_WAIT(16); else if ((s) == 2) DN_WAIT(12); else if ((s) == 1) DN_WAIT(8); else DN_WAIT(12);     \
            DN_BAR; \
            if ((s) >= 1) DN_STAGE_A((s) + 3);                           } while (0)
        if (wr == 0) {
            for (int s = 0; s < nst; ++s) { DN_STEP_HEAD(s); DN_MFMA(s); DN_BAR; DN_EPI(s); }
        } else {
            for (int s = 0; s < nst; ++s) { DN_STEP_HEAD(s); if (s >= 1) { DN_EPI(s - 1); } DN_BAR; DN_MFMA(s); }
            DN_EPI(nst - 1);
        }
#undef DN_STEP_HEAD
        DN_WAIT(0); DN_BAR;
    }
#undef DN_LOAD
#undef DN_STAGE_A
#undef DN_WAIT
#undef DN_BAR
#undef DN_MFMA
#undef DN_EPI
}
}
namespace att {
#define ALAS __attribute__((address_space(3)))
typedef short s16x4 __attribute__((ext_vector_type(4)));
constexpr int KSLOT = 16384, VSLOT = 16384, LDS_K = 0, LDS_V = 2 * KSLOT, LDS_FLAG = 4 * KSLOT;
enum { SB = 0, SWA = 1, MEM = 2 };
__device__ __forceinline__ int crow(int r, int hi) { return (r & 3) + 8 * (r >> 2) + 4 * hi; }
__device__ __forceinline__ unsigned cvtpk(float lo, float hi) { typedef float f2 __attribute__((ext_vector_type(2))); typedef __bf16 b2 __attribute__((ext_vector_type(2))); f2 v = {lo, hi}; b2 b = __builtin_convertvector(v, b2); return __builtin_bit_cast(unsigned, b); }
__device__ __forceinline__ float xhalf(float v) { return __shfl_xor(v, 32); }
__device__ __forceinline__ s16x4 vtr(const ALAS char* p) { typedef short v4i16_t __attribute__((ext_vector_type(4))); return __builtin_bit_cast(s16x4, __builtin_amdgcn_ds_read_tr16_b64_v4i16((ALAS v4i16_t*)p)); }

__device__ __forceinline__ void att_bar() { asm volatile("s_waitcnt lgkmcnt(0)" ::: "memory"); __builtin_amdgcn_s_barrier(); asm volatile("" ::: "memory"); }
template <int HD> struct Stage { u32x4 k[HD / 64], v[HD / 64]; };
template <int HD> __device__ __forceinline__ void tile_load(Stage<HD>& s, const bf16* Kb, const bf16* Vb, int pitch, int kv0, int wid, int lane) {
#pragma unroll
    for (int i = 0; i < HD / 64; ++i) { const int p = wid + 8 * i;
        s.k[i] = *(const u32x4*)(Kb + (size_t)(kv0 + lane) * pitch + p * 8);
        s.v[i] = *(const u32x4*)(Vb + (size_t)(kv0 + 16 * (p & 3) + (lane >> 2)) * pitch + (p >> 2) * 32 + (lane & 3) * 8); }
}
template <int HD> __device__ __forceinline__ void tile_store(const Stage<HD>& s, ALAS char* lds, int slot, int wid, int lane) {
#pragma unroll
    for (int i = 0; i < HD / 64; ++i) { const int p = wid + 8 * i;
        *(ALAS u32x4*)(lds + LDS_K + slot * KSLOT + p * 1024 + lane * 16) = s.k[i];
        *(ALAS u32x4*)(lds + LDS_V + slot * VSLOT + p * 1024 + lane * 16) = s.v[i]; }
}
template <int HD> __device__ __forceinline__ void qkt(f32x16& p0, f32x16& p1, const ALAS char* Kslot, const bf16x8* qr, int r32, int hi) {
    const ALAS char* kb = Kslot + hi * 1024 + r32 * 16;
#pragma unroll
    for (int r = 0; r < 16; ++r) { p0[r] = 0.f; p1[r] = 0.f; }
#pragma unroll
    for (int h0 = 0; h0 < HD / 16; h0 += 4) {
        bf16x8 kf[8];
#pragma unroll
        for (int d = 0; d < 4; ++d) { kf[2 * d] = *(const ALAS bf16x8*)(kb + (h0 + d) * 2048); kf[2 * d + 1] = *(const ALAS bf16x8*)(kb + (h0 + d) * 2048 + 512); }
        __builtin_amdgcn_sched_barrier(0);
#pragma unroll
        for (int d = 0; d < 4; ++d) { p0 = __builtin_amdgcn_mfma_f32_32x32x16_bf16(kf[2 * d], qr[h0 + d], p0, 0, 0, 0); p1 = __builtin_amdgcn_mfma_f32_32x32x16_bf16(kf[2 * d + 1], qr[h0 + d], p1, 0, 0, 0); }
        __builtin_amdgcn_sched_barrier(0);
    }
}
template <int HD> __device__ __forceinline__ void pvT(f32x16* oT, const ALAS char* Vslot, const u32x4* pw, int lane) {
    const int hi = lane >> 5;
    const ALAS char* vb = Vslot + ((lane >> 4) & 1) * 32 + (lane & 3) * 8 + (4 * hi + ((lane & 15) >> 2)) * 64;
#pragma unroll
    for (int dd = 0; dd < HD / 32; dd += 2) {
        s16x4 lo[2][4], h4[2][4];
#pragma unroll
        for (int e = 0; e < 2; ++e)
#pragma unroll
            for (int ks = 0; ks < 4; ++ks) { lo[e][ks] = vtr(vb + (dd + e) * 4096 + ks * 1024); h4[e][ks] = vtr(vb + (dd + e) * 4096 + ks * 1024 + 512); }
        __builtin_amdgcn_sched_barrier(0);
#pragma unroll
        for (int ks = 0; ks < 4; ++ks)
#pragma unroll
            for (int e = 0; e < 2; ++e) {
                const bf16x8 vf = (bf16x8){lo[e][ks][0], lo[e][ks][1], lo[e][ks][2], lo[e][ks][3], h4[e][ks][0], h4[e][ks][1], h4[e][ks][2], h4[e][ks][3]};
                oT[dd + e] = __builtin_amdgcn_mfma_f32_32x32x16_bf16(vf, __builtin_bit_cast(bf16x8, pw[ks]), oT[dd + e], 0, 0, 0); }
        __builtin_amdgcn_sched_barrier(0);
    }
}
__device__ __forceinline__ void pack_p(u32x4* pw, const f32x16& p0, const f32x16& p1) {
#pragma unroll
    for (int i = 0; i < 4; ++i) { pw[0][i] = cvtpk(p0[2 * i], p0[2 * i + 1]); pw[1][i] = cvtpk(p0[8 + 2 * i], p0[9 + 2 * i]); pw[2][i] = cvtpk(p1[2 * i], p1[2 * i + 1]); pw[3][i] = cvtpk(p1[8 + 2 * i], p1[9 + 2 * i]); }
}
__device__ __forceinline__ void sb_tile(f32x16& p0, f32x16& p1, float& Pc, bool masked, int qpos, int kv0, int hi) {
    float gm[32];
#pragma unroll
    for (int r = 0; r < 32; ++r) { const float z = fminf(r < 16 ? p0[r] : p1[r - 16], 100.f);
        const float e = __builtin_amdgcn_exp2f(z); float g = __builtin_amdgcn_rcpf(1.f + e), bt = e * g;
        if (masked) { const int kv = kv0 + crow(r & 15, hi) + (r >> 4) * 32; const bool ok = kv < qpos; g = ok ? g : 1.f; bt = ok ? bt : 0.f; }
        gm[r] = g; if (r < 16) p0[r] = bt; else p1[r - 16] = bt; }
    float suf[9]; suf[8] = 1.f;
#pragma unroll
    for (int g = 7; g >= 0; --g) suf[g] = suf[g + 1] * ((gm[4 * g] * gm[4 * g + 1]) * (gm[4 * g + 2] * gm[4 * g + 3]));
    float psuf[9]; psuf[8] = 1.f;
#pragma unroll
    for (int g = 0; g < 8; ++g) psuf[g] = xhalf(suf[g]);
#pragma unroll
    for (int g = 0; g < 8; ++g) {
        float run = Pc * suf[g + 1] * (hi ? psuf[g + 1] : psuf[g]);
#pragma unroll
        for (int i = 3; i >= 0; --i) { const int r = 4 * g + i;
            if (r < 16) p0[r] *= run; else p1[r - 16] *= run;
            run *= gm[r]; } }
    Pc *= suf[0] * psuf[0];
}

template <int MODE, int ND> __device__ __forceinline__ void soft_tile_(f32x16& p0, f32x16& p1, float& m, float& l, f32x16 (&oT)[ND], float slope, int qpos, int kv0, int hi) {
    float rm = -1e30f;
    if (MODE == SWA) {
#pragma unroll
        for (int r = 0; r < 32; ++r) { const int kv = kv0 + crow(r & 15, hi) + (r >> 4) * 32; const int dist = qpos - kv; const bool valid = dist >= 0 && dist < 128;
            const float z = (r < 16 ? p0[r] : p1[r - 16]) - slope * (float)dist; const float zz = valid ? z : -1e30f;
            if (r < 16) p0[r] = zz; else p1[r - 16] = zz; rm = fmaxf(rm, zz); }
    } else {
#pragma unroll
        for (int r = 0; r < 16; ++r) rm = fmaxf(rm, fmaxf(p0[r], p1[r]));
    }
    rm = fmaxf(rm, xhalf(rm));
    const float mn = fmaxf(m, rm), f = __builtin_amdgcn_exp2f(m - mn); m = mn;
    float ps = 0.f;
#pragma unroll
    for (int r = 0; r < 16; ++r) { p0[r] = __builtin_amdgcn_exp2f(p0[r] - mn); p1[r] = __builtin_amdgcn_exp2f(p1[r] - mn); ps += p0[r] + p1[r]; }
    ps += xhalf(ps);
    l = l * f + ps;
#pragma unroll
    for (int d0 = 0; d0 < ND; ++d0)
#pragma unroll
        for (int r = 0; r < 16; ++r) oT[d0][r] *= f;
}
template <int MODE> __device__ __forceinline__ void soft_tile(f32x16& p0, f32x16& p1, float& m, float& l, f32x16 (&oT)[2], float slope, int qpos, int kv0, int hi) { soft_tile_<MODE, 2>(p0, p1, m, l, oT, slope, qpos, kv0, hi); }
template <int MODE> __device__ __forceinline__ void soft_tile(f32x16& p0, f32x16& p1, float& m, float& l, f32x16 (&oT)[4], float slope, int qpos, int kv0, int hi) { soft_tile_<MODE, 4>(p0, p1, m, l, oT, slope, qpos, kv0, hi); }

struct Params { const bf16* projb; const bf16* mkvb; const float* sinks; unsigned char* osb; unsigned char* osw; unsigned char* om; };

template <int MODE> __device__ __forceinline__ void unit(ALAS char* lds, const Params& P, int b, int h, int qb, const int wid) {
    constexpr int HD = (MODE == MEM) ? 128 : 64;
    const int tid = otid(wid), lane = tid & 63, r32 = lane & 31, hi = lane >> 5;
    const int hq = (MODE == SWA) ? 4 * h + (wid >> 1) : h;
    const int q0 = (MODE == SWA) ? qb * 64 : qb * 256, qw0 = (MODE == SWA) ? q0 + 32 * (wid & 1) : q0 + 32 * wid, qpos = qw0 + r32;
    const bf16* Qb; const bf16* Kb; const bf16* Vb; unsigned char* Ob; int kpitch;
    if (MODE == SB)       { Qb = P.projb + (size_t)b * SEQ * IN_COLS + OFF_QSB + h * 64; Kb = P.projb + (size_t)b * SEQ * IN_COLS + OFF_KSB + h * 64; Vb = P.projb + (size_t)b * SEQ * IN_COLS + OFF_VSB + h * 64; Ob = P.osb + (size_t)b * SEQ * 512 + h * 64; kpitch = IN_COLS; }
    else if (MODE == SWA) { Qb = P.projb + (size_t)b * SEQ * IN_COLS + OFF_QSW + hq * 64; Kb = P.projb + (size_t)b * SEQ * IN_COLS + OFF_KSW + h * 64; Vb = P.projb + (size_t)b * SEQ * IN_COLS + OFF_VSW + h * 64; Ob = P.osw + (size_t)b * SEQ * 512 + hq * 64; kpitch = IN_COLS; }
    else                  { Qb = P.projb + (size_t)b * SEQ * IN_COLS + OFF_QM + h * 128; Kb = P.mkvb + (size_t)b * MEM_LEN * 1024 + h * 128; Vb = P.mkvb + (size_t)b * MEM_LEN * 1024 + 512 + h * 128; Ob = P.om + (size_t)b * SEQ * 512 + h * 128; kpitch = 1024; }
    int jlo, jhi;
    if (MODE == SB) { jlo = 0; jhi = 4 * qb + 3; } else if (MODE == SWA) { jlo = qb - 2; if (jlo < 0) jlo = 0; jhi = qb; } else { jlo = 0; jhi = 3; }
    const int ntile = jhi - jlo + 1, dj = (MODE == SB) ? -1 : 1, jfirst = (MODE == SB) ? jhi : jlo;
    Stage<HD> stA, stB;
    tile_load<HD>(stA, Kb, Vb, kpitch, jfirst * 64, wid, lane);
    tile_load<HD>(stB, Kb, Vb, kpitch, (jfirst + (ntile > 1 ? dj : 0)) * 64, wid, lane);
    bf16x8 qr[HD / 16];
#pragma unroll
    for (int d0 = 0; d0 < HD / 16; ++d0) qr[d0] = *(const bf16x8*)(Qb + (size_t)qpos * IN_COLS + d0 * 16 + hi * 8);
    f32x16 oT[HD / 32];
#pragma unroll
    for (int d0 = 0; d0 < HD / 32; ++d0)
#pragma unroll
        for (int r = 0; r < 16; ++r) oT[d0][r] = 0.f;
    float C = 1.f;
    float m = (MODE == SWA) ? P.sinks[hq] * LOG2E : -1e30f, l = (MODE == SWA) ? 1.f : 0.f;
    const float slope = (MODE == SWA) ? exp2f(-(float)(hq + 1)) * LOG2E : 0.f;
    tile_store<HD>(stA, lds, 0, wid, lane);
#pragma unroll
    for (int d0 = 0; d0 < HD / 16; ++d0) asm volatile("" : "+v"(qr[d0]));
    att_bar();
    bool stop = false;
    ALAS unsigned* dflag = (ALAS unsigned*)(lds + LDS_FLAG + 64);
#define ATT_STEP(it, SLOT, ST_LOAD, ST_STORE) do { \
        const int j = jfirst + (it) * dj, kv0 = j * 64; \
        tile_load<HD>(ST_LOAD, Kb, Vb, kpitch, ((it) + 2 < ntile ? j + 2 * dj : j) * 64, wid, lane);     \
        bool active = true; \
        if (MODE == SB) active = (kv0 <= qw0 + 30) && !__all(C == 0.f);     \
        else if (MODE == SWA) active = (kv0 <= qw0 + 31) && (kv0 + 63 >= qw0 - 127); \
        if (active) { \
            f32x16 p0, p1; \
            qkt<HD>(p0, p1, lds + LDS_K + (SLOT) * KSLOT, qr, r32, hi); \
            if (MODE == SB) { sb_tile(p0, p1, C, kv0 + 63 >= qw0, qpos, kv0, hi); } \
            else { soft_tile<MODE>(p0, p1, m, l, oT, slope, qpos, kv0, hi); } \
            u32x4 pw[4]; pack_p(pw, p0, p1); \
            pvT<HD>(oT, lds + LDS_V + (SLOT) * VSLOT, pw, lane); \
        } \
        tile_store<HD>(ST_STORE, lds, (SLOT) ^ 1, wid, lane); \
        if (MODE == SB) { const int wdone = __all(C == 0.f) ? 1 : 0; if (lane == 0) dflag[((it) & 1) * 8 + wid] = (unsigned)wdone; \
                          att_bar(); \
                          const ALAS u32x4* df = (const ALAS u32x4*)(dflag + ((it) & 1) * 8); const u32x4 f0 = df[0], f1 = df[1]; \
                          if ((f0.x & f0.y & f0.z & f0.w & f1.x & f1.y & f1.z & f1.w) != 0u) stop = true; } \
        else att_bar(); \
    } while (0)
    for (int it = 0; it < ntile && !stop; it += 2) {
        ATT_STEP(it, 0, stA, stB);
        if (stop || it + 1 >= ntile) break;
        ATT_STEP(it + 1, 1, stB, stA);
    }
#undef ATT_STEP
    const float inv = (MODE == SB) ? O8_SCALE : O8_SCALE / l;
    unsigned char* orow = Ob + (size_t)qpos * 512 + 32 * hi;
#pragma unroll
    for (int dp = 0; dp < HD / 64; ++dp) { u32x4 w0, w1; unsigned pk[8];
#pragma unroll
        for (int g = 0; g < 4; ++g) {
            const unsigned P_ = pack4_e4m3(oT[2 * dp][4 * g] * inv, oT[2 * dp][4 * g + 1] * inv, oT[2 * dp][4 * g + 2] * inv, oT[2 * dp][4 * g + 3] * inv);
            const unsigned Q_ = pack4_e4m3(oT[2 * dp + 1][4 * g] * inv, oT[2 * dp + 1][4 * g + 1] * inv, oT[2 * dp + 1][4 * g + 2] * inv, oT[2 * dp + 1][4 * g + 3] * inv);
            const auto sw = __builtin_amdgcn_permlane32_swap(P_, Q_, false, false);
            pk[2 * g] = sw[0]; pk[2 * g + 1] = sw[1]; }
        w0.x = pk[0]; w0.y = pk[1]; w0.z = pk[2]; w0.w = pk[3]; w1.x = pk[4]; w1.y = pk[5]; w1.z = pk[6]; w1.w = pk[7];
        *(u32x4*)(orow + 64 * dp) = w0; *(u32x4*)(orow + 64 * dp + 16) = w1; }
}

constexpr int NUNITS = 2560;
__device__ __forceinline__ void phase(ALAS char* lds, const Params& P, unsigned* queue, int ulo, int uhi, const int wave) {
    volatile ALAS int* flag = (volatile ALAS int*)(lds + LDS_FLAG);
    if (is_t0(wave)) { flag[0] = (int)atomicAdd(queue, 1u); }
    __syncthreads();
    int u = ulo + flag[0];
    for (int k = 0;; ++k) {
        if (u >= uhi) break;
        int tnext = 0; if (is_t0(wave)) tnext = (int)atomicAdd(queue, 1u);
        if (u < 512) { const int qb = u >> 5, bh = u & 31; unit<MEM>(lds, P, bh >> 2, bh & 3, qb, wave); }
        else if (u < 1536) { const int v = u - 512, qb = 15 - (v >> 6), bh = v & 63; unit<SB>(lds, P, bh >> 3, bh & 7, qb, wave); }
        else { const int v = u - 1536, qb = v >> 4, bh = v & 15; unit<SWA>(lds, P, bh >> 1, bh & 1, qb, wave); }
        if (is_t0(wave)) flag[(k + 1) & 1] = tnext;
        __syncthreads();
        u = ulo + flag[(k + 1) & 1];
    }
}
}
constexpr int NWAVES = 8;
constexpr int RING_BYTES = 131072, LDSCTL_OFF = RING_BYTES, MISC_OFF = LDSCTL_OFF + 320, BIAS_OFF = RING_BYTES + 1024  , LDS_BYTES = 147456;
constexpr int NPHASE = 12;
#ifndef CONV_CONTIG
#define CONV_CONTIG 0
#endif
#ifndef NCONV_WG
#define NCONV_WG 88
#endif
constexpr int NCONV = NCONV_WG;
#define GAS __attribute__((address_space(1)))
#define LAS __attribute__((address_space(3)))

#define XB_TMO      128
#define XB_XCNT(j)  (256  + 64 * (j))
#define XB_XSUB(j)  (1280 + 64 * (j))
#define XB_XGEN(j)  (2304 + 64 * (j))
#define XB_TOP      3328
#define XB_TOPGEN   3392
#define XCD_BAR_WORDS 3456
#define XB_SPIN_CAP (1u << 18)
__device__ __forceinline__ unsigned xb_ld(unsigned* p)              { return __hip_atomic_load(p, __ATOMIC_RELAXED, __HIP_MEMORY_SCOPE_AGENT); }
__device__ __forceinline__ unsigned xb_add(unsigned* p, unsigned v) { return __hip_atomic_fetch_add(p, v, __ATOMIC_RELAXED, __HIP_MEMORY_SCOPE_AGENT); }
__device__ __forceinline__ unsigned xb_xcc_id() { return (unsigned)__builtin_amdgcn_s_getreg((3 << 11) | 20) & 0xFu; }
#define XB_SPIN(cond, bar) do { unsigned _sp = 0; while (cond) { __builtin_amdgcn_s_sleep(1); \
    if ((++_sp & 255u) == 0u) { if (xb_ld(&(bar)[XB_TMO])) break; if (_sp > XB_SPIN_CAP) { atomicAdd(&(bar)[XB_TMO], 1u); break; } } } } while (0)
struct XcdBarrier { unsigned* bar; unsigned x; volatile LAS unsigned* st; int wave; };
__device__ __forceinline__ XcdBarrier xcd_barrier_post(unsigned* bar, volatile LAS unsigned* st, int wave) {
    XcdBarrier b; b.bar = bar; b.x = xb_xcc_id(); b.st = st; b.wave = wave;
    if (is_t0(wave)) (void)xb_add(&bar[XB_XCNT(b.x)], 1u);
    return b;
}
__device__ __forceinline__ void xcd_barrier_complete(unsigned* bar, unsigned x, unsigned& nloc, unsigned& nx) {
    const unsigned G = gridDim.x * gridDim.y * gridDim.z;
    unsigned sum, cnt, mine, sp = 0u;
    for (;;) {
        sum = 0u; cnt = 0u; mine = 0u;
#pragma unroll
        for (unsigned j = 0; j < 16; ++j) { const unsigned c = xb_ld(&bar[XB_XCNT(j)]); sum += c; cnt += (c > 0u) ? 1u : 0u; mine = (j == x) ? c : mine; }
        if (sum == G) break;
        __builtin_amdgcn_s_sleep(1);
        if ((++sp & 255u) == 0u) { if (xb_ld(&bar[XB_TMO])) break; if (sp > XB_SPIN_CAP) { atomicAdd(&bar[XB_TMO], 1u); break; } }
    }
    nloc = mine > 0u ? mine : 1u; nx = cnt > 0u ? cnt : 1u;
}
__device__ __forceinline__ void xcd_barrier(const XcdBarrier& b) {
    asm volatile("s_waitcnt vmcnt(0)" ::: "memory");
    __syncthreads();
    if (is_t0(b.wave)) {
        unsigned* bar = b.bar;
        __builtin_amdgcn_s_waitcnt(0);
        unsigned nloc = b.st[0], nx = b.st[1];
        if (nloc == 0u) { xcd_barrier_complete(bar, b.x, nloc, nx); b.st[0] = nloc; b.st[1] = nx; }
        const unsigned old = xb_add(&bar[XB_XSUB(b.x)], 1u);
        const unsigned gen = old / nloc;
        if (old + 1u == (gen + 1u) * nloc) {
            __builtin_amdgcn_fence(__ATOMIC_RELEASE, "agent");
            asm volatile("s_waitcnt vmcnt(0)" ::: "memory");
            const unsigned og = xb_add(&bar[XB_TOP], 1u);
            const unsigned tg = og / nx;
            if (og + 1u == (tg + 1u) * nx) xb_add(&bar[XB_TOPGEN], 1u);
            else XB_SPIN(xb_ld(&bar[XB_TOPGEN]) == tg, bar);
            __builtin_amdgcn_fence(__ATOMIC_ACQUIRE, "agent");
            xb_add(&bar[XB_XGEN(b.x)], 1u);
            asm volatile("s_waitcnt vmcnt(0)" ::: "memory");
        } else {
            XB_SPIN(xb_ld(&bar[XB_XGEN(b.x)]) == gen, bar);
            __builtin_amdgcn_fence(__ATOMIC_ACQUIRE, "agent");
            asm volatile("s_waitcnt vmcnt(0)" ::: "memory");
        }
    }
    __syncthreads();
}

struct TrItem { f32x4 v[8]; bf16* dst; int K; unsigned char* dst8; };
__device__ __forceinline__ void tr_issue(TrItem& t, const float* W, int K, int N, bf16* WT, int dst_row0, int k0, int n0, int lane, unsigned char* WT8 = nullptr) {
    const float* wp = W + (size_t)(k0 + (lane >> 3)) * N + n0 + 4 * (lane & 7);
#pragma unroll
    for (int i = 0; i < 8; ++i) t.v[i] = __builtin_nontemporal_load((const f32x4*)(wp + (size_t)(8 * i) * N));
    t.dst = WT + (size_t)dst_row0 * K + k0; t.K = K; t.dst8 = WT8 ? WT8 + (size_t)dst_row0 * K + k0 : nullptr;
}
__device__ __forceinline__ void tr_finish(const TrItem& t, LAS float* scr, int lane) {
#pragma unroll
    for (int i = 0; i < 8; ++i) { LAS float* p = scr + (8 * i + (lane >> 3)) * 33 + 4 * (lane & 7); p[0] = t.v[i][0]; p[1] = t.v[i][1]; p[2] = t.v[i][2]; p[3] = t.v[i][3]; }
    asm volatile("s_waitcnt lgkmcnt(0)" ::: "memory");
    const int c = lane & 7;
    if (t.dst8) {
#pragma unroll
        for (int j = 0; j < 4; ++j) { const int n = (lane >> 3) + 8 * j; const LAS float* s = scr + (8 * c) * 33 + n;
            u32x2 o; o.x = pack4_e4m3(s[0 * 33] * W8_SCALE, s[1 * 33] * W8_SCALE, s[2 * 33] * W8_SCALE, s[3 * 33] * W8_SCALE); o.y = pack4_e4m3(s[4 * 33] * W8_SCALE, s[5 * 33] * W8_SCALE, s[6 * 33] * W8_SCALE, s[7 * 33] * W8_SCALE);
            __builtin_nontemporal_store(o, (u32x2*)(t.dst8 + (size_t)n * t.K + 8 * c)); }
    } else {
#pragma unroll
    for (int j = 0; j < 4; ++j) { const int n = (lane >> 3) + 8 * j; const LAS float* s = scr + (8 * c) * 33 + n;
        u32x4 o; o.x = pk2(s[0 * 33], s[1 * 33]); o.y = pk2(s[2 * 33], s[3 * 33]); o.z = pk2(s[4 * 33], s[5 * 33]); o.w = pk2(s[6 * 33], s[7 * 33]);
        __builtin_nontemporal_store(o, (u32x4*)(t.dst + (size_t)n * t.K + 8 * c)); }
    }
    asm volatile("s_waitcnt lgkmcnt(0)" ::: "memory");
}
__device__ __forceinline__ void p0_transpose_item(const float* W, int K, int N, bf16* WT, int dst_row0, LAS float* scr, int k0, int n0, int lane, unsigned char* WT8 = nullptr) {
    TrItem t; tr_issue(t, W, K, N, WT, dst_row0, k0, n0, lane, WT8); tr_finish(t, scr, lane);
}
__device__ __forceinline__ int map_gu(int n0) { return n0 < EFF ? 256 * (n0 >> 7) + (n0 & 127) : 256 * ((n0 - EFF) >> 7) + 128 + ((n0 - EFF) & 127); }

struct Args {
    const float *x, *mem, *w_in, *b_gate, *w_mem_kv, *sinks, *w_o_sb, *w_o_swa, *w_o_mem, *w_out, *ln1_g, *ln1_b, *w_router, *router_bias, *w_e_gu, *w_e_down, *w_s_gu, *w_s_down, *ln2_g, *ln2_b;
    float* out; unsigned char* ws; int ph_lo, ph_hi, li, pad;
};

__global__ void __launch_bounds__(NWAVES * 64, 2) mega_fwd(Args a) {
    extern __shared__ __attribute__((aligned(16))) unsigned char lds_raw[];
    LAS unsigned char* lds = (LAS unsigned char*)lds_raw;
    volatile LAS unsigned* MISC = (volatile LAS unsigned*)(lds + MISC_OFF);
    const int wave = __builtin_amdgcn_readfirstlane((int)threadIdx.x >> 6);
    const int G = gridDim.x, bx = blockIdx.x;
    const int vcu = (G % 8 == 0) ? (bx % 8) * (G / 8) + bx / 8 : bx;
    const int gw = vcu * NWAVES + wave, NGW = G * NWAVES;
    unsigned char* ws = a.ws;
    unsigned* ctl = (unsigned*)(ws + WS_CTL);
    for (int u = otid(wave); u < (LDS_BYTES - LDSCTL_OFF) / 4; u += NWAVES * 64) ((LAS unsigned*)(lds + LDSCTL_OFF))[u] = 0u;
    __syncthreads();
    XcdBarrier bar = xcd_barrier_post(ctl + CW_BAR + a.li * XCD_BAR_WORDS, MISC + 8, wave);
    const int lo = a.ph_lo, hi = a.ph_hi;
#define IN(k) (lo <= (k) && (k) < hi)
#define SEAM(k) do { if (IN(k) && IN((k) + 1)) xcd_barrier(bar); } while (0)
#define PH_BEGIN(k) if (IN(k)) { const int tid = otid(wave), lane = tid & 63; (void)tid; (void)lane;
#define PH_END(k) } SEAM(k);
    bf16* WIN_T = (bf16*)(ws + WS_WIN_T); bf16* WMKV_T = (bf16*)(ws + WS_WMKV_T); bf16* WOSB_T = (bf16*)(ws + WS_WOSB_T); bf16* WOSW_T = (bf16*)(ws + WS_WOSW_T); bf16* WOM_T = (bf16*)(ws + WS_WOM_T);
    bf16* WOUT_T = (bf16*)(ws + WS_WOUT_T); bf16* WRS_T = (bf16*)(ws + WS_WRS_T); bf16* WSD_T = (bf16*)(ws + WS_WSD_T); bf16* WEGU_T = (bf16*)(ws + WS_WEGU_T); bf16* WED_T = (bf16*)(ws + WS_WED_T);
    bf16* XB = (bf16*)(ws + WS_XB); bf16* MEMB = (bf16*)(ws + WS_MEMB); bf16* MKVB = (bf16*)(ws + WS_MKVB); bf16* PROJB = (bf16*)(ws + WS_PROJB);
    bf16* OSB = (bf16*)(ws + WS_OSB); bf16* OSW = (bf16*)(ws + WS_OSW); bf16* OM = (bf16*)(ws + WS_OM); bf16* MERGED = (bf16*)(ws + WS_MERGED);
    bf16* Z = (bf16*)(ws + WS_Z); bf16* X1B = (bf16*)(ws + WS_X1B); float* LOGITS = (float*)(ws + WS_LOGITS); bf16* HS = (bf16*)(ws + WS_HS); bf16* SHOUT = (bf16*)(ws + WS_SHOUT);
    int* IDX = (int*)(ws + WS_ROUTE + RT_IDX); float* WGT = (float*)(ws + WS_ROUTE + RT_WGT); int* POS = (int*)(ws + WS_ROUTE + RT_POS); int* STOK = (int*)(ws + WS_ROUTE + RT_STOK);
    int* TILES = (int*)(ws + WS_ROUTE + RT_TILES); int* TILES64 = (int*)(ws + WS_ROUTE + RT_TILES64);
    unsigned char* XB8 = ws + WS_XB8; unsigned char* X1B8 = ws + WS_X1B8; unsigned char* WG8_T = ws + WS_WG8_T;
    bf16* HBUF = (bf16*)(ws + WS_HBUF); unsigned char* YS = (unsigned char*)(ws + WS_YS);

    PH_BEGIN(0)
        LAS float* scr = (LAS float*)(lds + wave * 16384);
        constexpr int I_IN = 16 * 184, I_MKV = 16 * 32, I_O = 8 * 32, I_OUT = 16 * 32, I_SGU = 16 * 16, I_R = 16 * 8, I_SD = 4 * 32, I_EGU = 16 * 16, I_ED = 4 * 32;
        constexpr int SMALL = I_IN + I_MKV + 3 * I_O + I_OUT + I_SGU + I_R + I_SD, NITEMS = SMALL;
        for (int it = gw; it < SMALL; it += NGW) {
            int r = it;
            if (r < I_IN) { const int nb = r % 184, kb = r / 184;
                if (nb < 88) p0_transpose_item(a.w_in, D, IN_COLS, WIN_T, 32 * nb, scr, 64 * kb, 32 * nb, lane);
                else p0_transpose_item(a.w_in, D, IN_COLS, WIN_T, 32 * (nb - 88), scr, 64 * kb, 32 * nb, lane, WG8_T);
                continue; } r -= I_IN;
            if (r < I_MKV) { p0_transpose_item(a.w_mem_kv, D, 1024, WMKV_T, 32 * (r % 32), scr, 64 * (r / 32), 32 * (r % 32), lane); continue; } r -= I_MKV;
            if (r < I_O) { p0_transpose_item(a.w_o_sb, 512, D, WOSB_T, 32 * (r % 32), scr, 64 * (r / 32), 32 * (r % 32), lane, (unsigned char*)WOSB_T); continue; } r -= I_O;
            if (r < I_O) { p0_transpose_item(a.w_o_swa, 512, D, WOSW_T, 32 * (r % 32), scr, 64 * (r / 32), 32 * (r % 32), lane, (unsigned char*)WOSW_T); continue; } r -= I_O;
            if (r < I_O) { p0_transpose_item(a.w_o_mem, 512, D, WOM_T, 32 * (r % 32), scr, 64 * (r / 32), 32 * (r % 32), lane, (unsigned char*)WOM_T); continue; } r -= I_O;
            if (r < I_OUT) { p0_transpose_item(a.w_out, D, D, WOUT_T, 32 * (r % 32), scr, 64 * (r / 32), 32 * (r % 32), lane, (unsigned char*)WOUT_T); continue; } r -= I_OUT;
            if (r < I_SGU) { p0_transpose_item(a.w_s_gu, D, 512, WRS_T, map_gu(32 * (r % 16)), scr, 64 * (r / 16), 32 * (r % 16), lane, (unsigned char*)WRS_T); continue; } r -= I_SGU;
            if (r < I_R) { p0_transpose_item(a.w_router, D, NE, WRS_T, 512 + 32 * (r % 8), scr, 64 * (r / 8), 32 * (r % 8), lane); continue; } r -= I_R;
            p0_transpose_item(a.w_s_down, EFF, D, WSD_T, 32 * (r % 32), scr, 64 * (r / 32), 32 * (r % 32), lane, (unsigned char*)WSD_T);
        }
        thin::cvt_rows(a.x, XB, XB8, T, gw, NGW, lane);
        thin::cvt_rows(a.mem, MEMB, nullptr, MROWS, gw, NGW, lane);
    PH_END(0)
    PH_BEGIN(1)
        const int GG = G - NCONV;
        if (bx >= GG) {
            LAS float* scr = (LAS float*)(lds + wave * 16384);
            constexpr int I_EGU = 16 * 16, I_ED = 4 * 32;
            const int cw = (bx - GG) * NWAVES + wave, ncw = NCONV * NWAVES;
            constexpr int NIT = NE * (I_EGU + I_ED);
#define EXP_ISSUE(t, r_) do { const int ri_ = (r_) < NIT ? (r_) : rlast;     \
                const bool gu = ri_ < NE * I_EGU; const int r2 = gu ? ri_ : ri_ - NE * I_EGU; const int per = gu ? I_EGU : I_ED, nbs = gu ? 16 : 32; \
                const int e = r2 / per, q = r2 % per, kb = q / nbs, nb = q % nbs; \
                const float* W = gu ? a.w_e_gu + (size_t)e * D * 512 : a.w_e_down + (size_t)e * EFF * D; \
                unsigned char* W8 = gu ? (unsigned char*)WEGU_T + (size_t)e * 512 * D : (unsigned char*)WED_T + (size_t)e * D * EFF; \
                tr_issue(t, W, gu ? D : EFF, gu ? 512 : D, WEGU_T, gu ? map_gu(32 * nb) : 32 * nb, 64 * kb, 32 * nb, lane, W8); } while (0)
            TrItem tA, tB, tC;
            const int nmine = (NIT - cw + ncw - 1) / ncw, rlast = cw + (nmine - 1) * ncw;
            int r = cw;
            EXP_ISSUE(tA, r); EXP_ISSUE(tB, r + ncw);
            for (; r < NIT; r += 3 * ncw) {
                EXP_ISSUE(tC, r + 2 * ncw); tr_finish(tA, scr, lane);
                EXP_ISSUE(tA, r + 3 * ncw); tr_finish(tB, scr, lane);
                EXP_ISSUE(tB, r + 4 * ncw); tr_finish(tC, scr, lane);
            }
#undef EXP_ISSUE
        } else {
        LAS float* bias_lds = (LAS float*)(lds + BIAS_OFF);
        for (int i = tid; i < 3 * D; i += NWAVES * 64) bias_lds[i] = a.b_gate[i] * -LOG2E;
        __syncthreads();
        { pg8::GridOrder S; S.init(T, OFF_GATE, D, GG, bx, 1); S.A0 = (unsigned)WS_XB; S.B0 = (unsigned)WS_WIN_T;
          pg8::EpiProj E{PROJB};
          pg8::gemm_phase<pg8::EpiProj, pg8::GridOrder, false>(lds, ws, D, S, E, wave); }
        { pg8::GridOrder S; S.init(T, 3 * D, D / 2, GG, (bx + GG - 64) % GG, 1); S.A0 = (unsigned)WS_XB8; S.B0 = (unsigned)WS_WG8_T;
          pg8::EpiGate8 E{bias_lds, (u32x4*)(ws + WS_GT)};
          pg8::gemm_phase<pg8::EpiGate8, pg8::GridOrder, false, false, true>(lds, ws, D / 2, S, E, wave); }
        { pg8::GridOrder S; S.init(MROWS, 1024, D, GG, GG - 1 - bx, 1); S.A0 = (unsigned)WS_MEMB; S.B0 = (unsigned)WS_WMKV_T;
          pg8::EpiBf16 E{MKVB, 1024, 1.f};
          pg8::gemm_phase<pg8::EpiBf16, pg8::GridOrder, false>(lds, ws, D, S, E, wave); }
        }
    PH_END(1)
    PH_BEGIN(2)
        const att::Params P{PROJB, MKVB, a.sinks, (unsigned char*)OSB, (unsigned char*)OSW, (unsigned char*)OM};
        att::phase((LAS char*)lds, P, ctl + CW_QUEUE + 64 * (a.li & 15), a.pad == 1 ? 512 : (a.pad == 2 ? 1536 : 0), a.pad == 3 ? 512 : (a.pad == 1 ? 1536 : att::NUNITS), wave);
    PH_END(2)
    PH_BEGIN(3)
        pg8::GridOrder S; S.init(T, D, 512 / 2, G, bx, 3);
        S.A0 = (unsigned)WS_OSB; S.B0 = (unsigned)WS_WOSB_T; S.asub = (unsigned)(WS_OSW - WS_OSB); S.bsub = (unsigned)(WS_WOSW_T - WS_WOSB_T);
        pg8::EpiOutProj E{(unsigned char*)MERGED, (const u32x4*)(ws + WS_GT)};
        pg8::gemm_phase<pg8::EpiOutProj, pg8::GridOrder, false, false, true>(lds, ws, 512 / 2, S, E, wave);
    PH_END(3)
    PH_BEGIN(4)
        pg8::GridOrder S; S.init(T, D, D / 2, G, bx, 1); S.A0 = (unsigned)WS_MERGED; S.B0 = (unsigned)WS_WOUT_T;
        pg8::EpiY E{Z, XB};
        pg8::gemm_phase<pg8::EpiY, pg8::GridOrder, false, false, true>(lds, ws, D / 2, S, E, wave);
    PH_END(4)
    PH_BEGIN(5) thin::ln1_rows(Z, a.ln1_g, a.ln1_b, X1B, X1B8, gw, NGW, lane); PH_END(5)
    PH_BEGIN(6)
        const bool split = (G % 16 == 0); const int Gs = split ? G / 2 : G, cs = split ? (((bx >> 4) << 3) | (bx & 7)) : bx, side = (bx >> 3) & 1;
        if (!split || side == 0) { pg8::GridOrder S; S.init(T, NE, D, Gs, cs, 1); S.A0 = (unsigned)WS_X1B; S.B0 = (unsigned)(WS_WRS_T + (size_t)512 * D * 2);
            pg8::EpiRouter E{LOGITS};
            pg8::gemm_phase<pg8::EpiRouter, pg8::GridOrder, false>(lds, ws, D, S, E, wave); }
        if (!split || side == 1) { pg8::GridOrder S; S.init(T, 2 * EFF, D / 2, Gs, cs, 1); S.A0 = (unsigned)WS_X1B8; S.B0 = (unsigned)WS_WRS_T;
            pg8::EpiShared8 E{(unsigned char*)HS};
            pg8::gemm_phase<pg8::EpiShared8, pg8::GridOrder, false, false, true>(lds, ws, D / 2, S, E, wave); }
    PH_END(6)
    PH_BEGIN(7) thin::route(LOGITS, a.router_bias, IDX, WGT, ctl + CW_COUNTS, (LAS int*)lds, bx, G, tid); PH_END(7)
    PH_BEGIN(8) thin::scan_scatter(ctl + CW_COUNTS, ctl + CW_CURSOR, IDX, POS, STOK, TILES, TILES64, (LAS int*)lds, bx, G, tid); PH_END(8)
    PH_BEGIN(9)
        { LAS int* tab = (LAS int*)(lds + BIAS_OFF);
          const int ntiles = __builtin_amdgcn_readfirstlane(pg8::build_tile_map(ctl + CW_COUNTS, tab, tid));
          pg8::ExpertOrder S; S.offs = tab; S.cnt = tab + 256; S.tmap = (const LAS unsigned short*)(tab + 512); S.nN = 2; S.nwg = ntiles * 2; S.G = G; S.c = bx; S.A = (unsigned)WS_X1B8; S.rows = STOK; S.arow = 0; S.Bb = (unsigned)WS_WEGU_T; S.bexp = (unsigned)(512 * D); S.bstep = (unsigned)(256 * D);
          pg8::EpiExpGU8 E{(unsigned char*)HBUF};
          pg8::gemm_phase<pg8::EpiExpGU8, pg8::ExpertOrder, true, false, true>(lds, ws, D / 2, S, E, wave); }
        { pg8::GridOrder S; S.init(T, D, EFF / 2, G, bx, 1); S.A0 = (unsigned)WS_HS; S.B0 = (unsigned)WS_WSD_T;
          pg8::EpiBf16 E{SHOUT, D, 1.f / (W8_SCALE * H8_SCALE)};
          int Kh = EFF / 2; asm volatile("" : "+s"(Kh));
          pg8::gemm_phase<pg8::EpiBf16, pg8::GridOrder, false, false, true>(lds, ws, Kh, S, E, wave); }
    PH_END(9)
    PH_BEGIN(10)
        LAS int* tab = (LAS int*)(lds + BIAS_OFF);
        (void)pg8::build_tile_map(ctl + CW_COUNTS, tab, tid);
        LAS int* srt = tab + 1280;
        if (tid < NE) { const int ce = tab[256 + tid]; int rk = 0; for (int j = 0; j < NE; ++j) { const int cj = tab[256 + j]; rk += (cj > ce || (cj == ce && j < tid)) ? 1 : 0; } srt[rk] = tid; }
        __syncthreads();
        pg8::down_phase(lds, ws, tab, tab + 256, srt, G, bx, (unsigned)WS_HBUF, (unsigned)WS_WED_T, (unsigned)WS_YS, (unsigned)(WS_CTL + 768 * 1024), YS_SCALE / (W8_SCALE * H8_SCALE), wave, HYBRID ? a.pad : 0);
    PH_END(10)
    PH_BEGIN(11) thin::final_rows(X1B, SHOUT, YS, POS, WGT, a.ln2_g, a.ln2_b, a.out, gw, NGW, lane); PH_END(11)
#undef IN
#undef SEAM
#undef PH_BEGIN
#undef PH_END
}
extern "C" void kernel_launch(void* const* d_in, const int* in_sizes, int n_in, void* d_out, int out_size, void* d_ws, size_t ws_size, hipStream_t stream) {
    static int grid = 0;
    if (grid == 0) {
        if (n_in != 20 || in_sizes[0] != T * D || out_size != T * D || ws_size < WS_END) { fprintf(stderr, "kernel_launch: unexpected problem shape / workspace (%d inputs, ws %zu)\n", n_in, ws_size); grid = -1; return; }
        int dev = 0, cus = 0;
        if (hipGetDevice(&dev) != hipSuccess || hipDeviceGetAttribute(&cus, hipDeviceAttributeMultiprocessorCount, dev) != hipSuccess) { grid = -1; return; }
        if (hipFuncSetAttribute((const void*)mega_fwd, hipFuncAttributeMaxDynamicSharedMemorySize, LDS_BYTES) != hipSuccess) { fprintf(stderr, "kernel_launch: hipFuncSetAttribute failed\n"); grid = -1; return; }
        (void)hipGetLastError();
        grid = cus;
    }
    if (grid < 0) return;
    (void)hipMemsetAsync((char*)d_ws + WS_CTL, 0, CTL_ZERO_BYTES, stream);
    Args a{};
    const float** f = (const float**)&a;
    for (int i = 0; i < 20; ++i) f[i] = (const float*)d_in[i];
    a.out = (float*)d_out; a.ws = (unsigned char*)d_ws;
#if HYBRID
#ifndef PROBE_ATT_MODE
#define PROBE_ATT_MODE 0
#endif
    unsigned char* ws = (unsigned char*)d_ws;
    bf16* XB = (bf16*)(ws + WS_XB); bf16* MEMB = (bf16*)(ws + WS_MEMB); bf16* MKVB = (bf16*)(ws + WS_MKVB); bf16* PROJB = (bf16*)(ws + WS_PROJB);
    bf16* OSB = (bf16*)(ws + WS_OSB); bf16* OSW = (bf16*)(ws + WS_OSW); bf16* OM = (bf16*)(ws + WS_OM); bf16* MERGED = (bf16*)(ws + WS_MERGED);
    bf16* Z = (bf16*)(ws + WS_Z); bf16* X1B = (bf16*)(ws + WS_X1B); float* LOGITS = (float*)(ws + WS_LOGITS); bf16* HS = (bf16*)(ws + WS_HS); bf16* SHOUT = (bf16*)(ws + WS_SHOUT);
    int* STOK = (int*)(ws + WS_ROUTE + RT_STOK); int* TILES64 = (int*)(ws + WS_ROUTE + RT_TILES64);
    bf16* HBUF = (bf16*)(ws + WS_HBUF); bf16* YS = (bf16*)(ws + WS_YS);
    float* SCR = (float*)(ws + WS_YS);
    static const int opt[NPHASE] = HYBRID_OPT;
#ifdef PROBE_REPS
    static const int reps[NPHASE] = PROBE_REPS;
#else
    static const int reps[NPHASE] = {1, 1, 1, 1, 1, 1, 1, 1, 1, 1, 1, 1};
#endif
    int li = 0;
    for (int p = 0; p < NPHASE; ++p) {
        if (opt[p]) { for (int r = 0; r < reps[p]; ++r) { a.ph_lo = p; a.ph_hi = p + 1; a.li = (li++) & 15; a.pad = (r + 1 < reps[p]) ? PROBE_ATT_MODE : 0;     hipLaunchKernelGGL(mega_fwd, dim3(grid), dim3(NWAVES * 64), LDS_BYTES, stream, a); }
#ifdef ATT_DIFF_TEST
        if (p == 2 && opt[p]) {
            bf16* nsb = (bf16*)(ws + WS_YS); bf16* nsw = nsb + (size_t)T * 512; bf16* nm = nsw + (size_t)T * 512;
            nv::k_sb_attn<<<BATCH * 8 * (SEQ / 64), 64, 0, stream>>>(PROJB, nsb);
            nv::k_swa_attn<<<BATCH * 8 * (SEQ / 64), 64, 0, stream>>>(PROJB, a.sinks, nsw);
            nv::k_mem_attn<<<BATCH * 4 * 2 * (SEQ / 64), 64, 0, stream>>>(PROJB, MKVB, nm);
            unsigned* cw = (unsigned*)(ws + WS_CTL);
            nv::k_maxdiff<<<1024, 256, 0, stream>>>(OSB, nsb, (size_t)T * 512, cw + (ATT_DIFF_TEST == 1 ? 900 : 910));
            nv::k_maxdiff<<<1024, 256, 0, stream>>>(OSW, nsw, (size_t)T * 512, cw + (ATT_DIFF_TEST == 2 ? 900 : 911));
            nv::k_maxdiff<<<1024, 256, 0, stream>>>(OM, nm, (size_t)T * 512, cw + (ATT_DIFF_TEST == 3 ? 900 : 912));
        }
        if (p == NPHASE - 1) nv::k_scale_out<<<1024, 256, 0, stream>>>((float*)d_out, (size_t)T * D, (const unsigned*)(ws + WS_CTL) + 900);
#endif
            continue; }
        switch (p) {
        case 1:
            nv::k_gemm<nv::M_PROJ><<<dim3(IN_COLS / 64, T / 64), 256, 0, stream>>>(XB, D, a.w_in, IN_COLS, PROJB, IN_COLS, D, nullptr, 0, a.b_gate, nullptr);
            nv::k_gemm<nv::M_BF16><<<dim3(1024 / 64, MROWS / 64), 256, 0, stream>>>(MEMB, D, a.w_mem_kv, 1024, MKVB, 1024, D, nullptr, 0, nullptr, nullptr);
            break;
        case 2:
            nv::k_sb_attn<<<BATCH * 8 * (SEQ / 64), 64, 0, stream>>>(PROJB, OSB);
            nv::k_swa_attn<<<BATCH * 8 * (SEQ / 64), 64, 0, stream>>>(PROJB, a.sinks, OSW);
            nv::k_mem_attn<<<BATCH * 4 * 2 * (SEQ / 64), 64, 0, stream>>>(PROJB, MKVB, OM);
            break;
        case 3:
            nv::k_gemm<nv::M_GSET><<<dim3(D / 64, T / 64), 256, 0, stream>>>(OSB, 512, a.w_o_sb, D, nullptr, 0, 512, PROJB + OFF_GATE, IN_COLS, nullptr, SCR);
            nv::k_gemm<nv::M_GADD><<<dim3(D / 64, T / 64), 256, 0, stream>>>(OSW, 512, a.w_o_swa, D, nullptr, 0, 512, PROJB + OFF_GATE + D, IN_COLS, nullptr, SCR);
            nv::k_gemm<nv::M_GFIN><<<dim3(D / 64, T / 64), 256, 0, stream>>>(OM, 512, a.w_o_mem, D, MERGED, D, 512, PROJB + OFF_GATE + 2 * D, IN_COLS, nullptr, SCR);
            break;
        case 4:
            nv::k_gemm<nv::M_Y><<<dim3(D / 64, T / 64), 256, 0, stream>>>(MERGED, D, a.w_out, D, Z, D, D, a.x, D, nullptr, nullptr);
            break;
        case 6:
            nv::k_gemm<nv::M_F32><<<dim3(NE / 64, T / 64), 256, 0, stream>>>(X1B, D, a.w_router, NE, LOGITS, NE, D, nullptr, 0, nullptr, nullptr);
            nv::k_gu<<<dim3(EFF / 64, T / 64), 256, 0, stream>>>(X1B, nullptr, nullptr, a.w_s_gu, 0, HS);
            break;
        case 9:
            nv::k_gu<<<dim3(EFF / 64, MAXT64), 256, 0, stream>>>(X1B, STOK, TILES64, a.w_e_gu, (size_t)D * 2 * EFF, HBUF);
            nv::k_down<false><<<dim3(D / 64, T / 64), 256, 0, stream>>>(HS, nullptr, a.w_s_down, 0, SHOUT);
            break;
        case 10:
            nv::k_down<true><<<dim3(D / 64, MAXT64), 256, 0, stream>>>(HBUF, TILES64, a.w_e_down, (size_t)EFF * D, YS);
            break;
        default: break;
        }
    }
#else
    a.ph_lo = 0; a.ph_hi = NPHASE; a.li = 0;
    hipLaunchKernelGGL(mega_fwd, dim3(grid), dim3(NWAVES * 64), LDS_BYTES, stream, a);
#endif
}
```

```cpp
#define HYBRID 0
#include <hip/hip_runtime.h>
#include <stdint.h>
#include <math.h>
#include <cstdio>

constexpr int D = 1024, BATCH = 8, SEQ = 4096, T = BATCH * SEQ;
constexpr int MEM_LEN = 256, MROWS = BATCH * MEM_LEN;
constexpr int IN_COLS = 5888;
constexpr int OFF_QSB = 0, OFF_KSB = 512, OFF_VSB = 1024, OFF_QSW = 1536, OFF_KSW = 2048, OFF_VSW = 2176, OFF_QM = 2304, OFF_GATE = 2816;
constexpr int NE = 256, TOPK = 8, EFF = 256;
constexpr float LN_EPS = 1e-5f;
constexpr float ALPHA = 1.189207115002721f;
constexpr int NSLOT = T * TOPK;
constexpr float LOG2E = 1.4426950408889634f;
constexpr float LOG2_255 = 7.994353436858858f, GATE_TMAX = 7.988684686772166f - 7.994353436858858f;
constexpr float QS64 = 0.125f * LOG2E;
constexpr float QS128 = 0.08838834764831845f * LOG2E;

constexpr float W8_SCALE = 64.f, W8_INV = 1.f / 64.f;
constexpr float O8_SCALE = 16.f, M8_SCALE = 16.f;
constexpr float H8_SCALE = 16.f;
constexpr float YS_SCALE = 16.f, YS_INV = 1.f / 16.f;
constexpr size_t MiB = 1u << 20;
constexpr size_t WS_CTL = 0, CTL_ZERO_BYTES = 1 * MiB;
constexpr size_t WS_WIN_T = 2 * MiB, WS_WMKV_T = 14 * MiB, WS_WOSB_T = 16 * MiB, WS_WOSW_T = 17 * MiB, WS_WOM_T = 18 * MiB, WS_WOUT_T = 19 * MiB, WS_WRS_T = 21 * MiB, WS_WSD_T = 23 * MiB;
constexpr size_t WS_WEGU_T = 24 * MiB, WS_WED_T = 280 * MiB;
constexpr size_t WS_XB = 408 * MiB, WS_MEMB = 472 * MiB, WS_MKVB = 476 * MiB, WS_PROJB = 480 * MiB;
constexpr size_t WS_OSB = 848 * MiB, WS_OSW = 880 * MiB, WS_OM = 912 * MiB, WS_MERGED = 944 * MiB, WS_Z = 1008 * MiB, WS_X1B = 1136 * MiB, WS_LOGITS = 1200 * MiB, WS_HS = 1232 * MiB, WS_SHOUT = 1248 * MiB;
constexpr size_t WS_XB8 = 1920 * MiB, WS_X1B8 = 1952 * MiB, WS_WG8_T = 1984 * MiB;
constexpr size_t WS_GT = 1728 * MiB;
constexpr size_t WS_ROUTE = 1312 * MiB, WS_HBUF = 1328 * MiB, WS_YS = 1460 * MiB, WS_END = 1988 * MiB;
constexpr size_t RT_IDX = 0, RT_WGT = 1 * MiB, RT_POS = 2 * MiB, RT_STOK = 3 * MiB  , RT_TILES = 5 * MiB  , RT_TILES64 = 6 * MiB  ;
constexpr int MAXT256 = NSLOT / 256 + NE;
constexpr int MAXT64 = NSLOT / 64 + NE;
constexpr int CW_COUNTS = 1024, CW_CURSOR = 1280, CW_QUEUE = 1536  , CW_BAR = 4096;

typedef unsigned short bf16;
typedef short bf16x8 __attribute__((ext_vector_type(8)));
typedef float f32x4 __attribute__((ext_vector_type(4)));
typedef float f32x16 __attribute__((ext_vector_type(16)));
typedef unsigned u32x4 __attribute__((ext_vector_type(4)));
typedef unsigned u32x2 __attribute__((ext_vector_type(2)));

__device__ __forceinline__ unsigned f2bf(float f) { unsigned u = __builtin_bit_cast(unsigned, f); return (u + 0x7fffu + ((u >> 16) & 1u)) >> 16; }
__device__ __forceinline__ unsigned pk2(float lo, float hi) { return f2bf(lo) | (f2bf(hi) << 16); }
__device__ __forceinline__ float bf2f(unsigned b) { return __builtin_bit_cast(float, b << 16); }
__device__ __forceinline__ float bflo(unsigned w) { return __builtin_bit_cast(float, w << 16); }
__device__ __forceinline__ float bfhi(unsigned w) { return __builtin_bit_cast(float, w & 0xffff0000u); }
__device__ __forceinline__ unsigned pack4_e4m3(float a, float b, float c, float d) {
    a = __builtin_amdgcn_fmed3f(a, -448.f, 448.f); b = __builtin_amdgcn_fmed3f(b, -448.f, 448.f); c = __builtin_amdgcn_fmed3f(c, -448.f, 448.f); d = __builtin_amdgcn_fmed3f(d, -448.f, 448.f);
    const unsigned w = __builtin_amdgcn_cvt_pk_fp8_f32(a, b, 0u, false); return __builtin_amdgcn_cvt_pk_fp8_f32(c, d, w, true);
}
__device__ __forceinline__ float wave_sum(float v) {
#pragma unroll
    for (int o = 1; o < 64; o <<= 1) v += __shfl_xor(v, o);
    return v;
}
__device__ __forceinline__ float sigmoidf_(float z) { return 1.f / (1.f + __expf(-z)); }
__device__ __forceinline__ float gate_sig(float z) { z = fminf(fmaxf(z, -30.f), 30.f); return __builtin_amdgcn_rcpf(1.f + __expf(-z)); }

__device__ __forceinline__ int lane_id() { int l; asm volatile("v_mbcnt_lo_u32_b32 %0, -1, 0\n\tv_mbcnt_hi_u32_b32 %0, -1, %0" : "=v"(l)); return l; }
__device__ __forceinline__ int otid(int wave) { int t = (wave << 6) | lane_id(); asm volatile("" : "+v"(t)); return t; }
__device__ __forceinline__ bool is_t0(int wave) { return wave == 0 && lane_id() == 0; }
namespace thin {
#define TLAS __attribute__((address_space(3)))
__device__ __forceinline__ void cvt_rows(const float* __restrict__ src, bf16* __restrict__ dst, unsigned char* __restrict__ dst8  , int rows, int gw, int ngw, int lane) {
    f32x4 cur[4], nxt[4];
    if (gw < rows) {
#pragma unroll
        for (int j = 0; j < 4; ++j) cur[j] = __builtin_nontemporal_load((const f32x4*)(src + (size_t)gw * D) + lane + 64 * j);
    }
    for (int r = gw; r < rows; r += ngw) {
        const int rn = (r + ngw < rows) ? r + ngw : r;
#pragma unroll
        for (int j = 0; j < 4; ++j) nxt[j] = __builtin_nontemporal_load((const f32x4*)(src + (size_t)rn * D) + lane + 64 * j);
        u32x2* d = (u32x2*)(dst + (size_t)r * D) + lane;
#pragma unroll
        for (int j = 0; j < 4; ++j) { u32x2 o; o.x = pk2(cur[j].x, cur[j].y); o.y = pk2(cur[j].z, cur[j].w); d[64 * j] = o; }
        if (dst8) { unsigned* d8 = (unsigned*)(dst8 + (size_t)r * D) + lane;
#pragma unroll
            for (int j = 0; j < 4; ++j) d8[64 * j] = pack4_e4m3(cur[j].x, cur[j].y, cur[j].z, cur[j].w); }
#pragma unroll
        for (int j = 0; j < 4; ++j) cur[j] = nxt[j];
    }
}
__device__ __forceinline__ void ln1_rows(const bf16* __restrict__ Z, const float* __restrict__ g, const float* __restrict__ bta, bf16* __restrict__ XB, unsigned char* __restrict__ XB8, int gw, int ngw, int lane) {
    u32x4 r0[2], r1[2], r2[2];
    const int ra = gw < T ? gw : T - 1, rb = gw + ngw < T ? gw + ngw : T - 1;
#pragma unroll
    for (int j = 0; j < 2; ++j) { r0[j] = __builtin_nontemporal_load((const u32x4*)(Z + (size_t)ra * D) + lane + 64 * j); r1[j] = __builtin_nontemporal_load((const u32x4*)(Z + (size_t)rb * D) + lane + 64 * j); }
    f32x4 gg[4], bb[4];
#pragma unroll
    for (int j = 0; j < 2; ++j) { gg[2 * j] = ((const f32x4*)g)[2 * lane + 128 * j]; gg[2 * j + 1] = ((const f32x4*)g)[2 * lane + 128 * j + 1]; bb[2 * j] = ((const f32x4*)bta)[2 * lane + 128 * j]; bb[2 * j + 1] = ((const f32x4*)bta)[2 * lane + 128 * j + 1]; }
    for (int r = gw; r < T; r += ngw) {
        const int rn = (r + 2 * ngw < T) ? r + 2 * ngw : r;
#pragma unroll
        for (int j = 0; j < 2; ++j) r2[j] = __builtin_nontemporal_load((const u32x4*)(Z + (size_t)rn * D) + lane + 64 * j);
        f32x4 v[4]; float s = 0.f;
#pragma unroll
        for (int j = 0; j < 2; ++j) { const u32x4 z = r0[j]; v[2 * j] = (f32x4){bflo(z.x), bfhi(z.x), bflo(z.y), bfhi(z.y)}; v[2 * j + 1] = (f32x4){bflo(z.z), bfhi(z.z), bflo(z.w), bfhi(z.w)}; }
#pragma unroll
        for (int j = 0; j < 4; ++j) s += (v[j].x + v[j].y) + (v[j].z + v[j].w);
        const float mean = wave_sum(s) * (1.f / D); float s2 = 0.f;
#pragma unroll
        for (int j = 0; j < 4; ++j) { v[j] = v[j] - mean; s2 += (v[j].x * v[j].x + v[j].y * v[j].y) + (v[j].z * v[j].z + v[j].w * v[j].w); }
        const float rstd = rsqrtf(wave_sum(s2) * (1.f / D) + LN_EPS);
        u32x4* xb = (u32x4*)(XB + (size_t)r * D) + lane;
        u32x2* x8 = (u32x2*)(XB8 + (size_t)r * D) + lane;
#pragma unroll
        for (int j = 0; j < 2; ++j) { const f32x4 o0 = v[2 * j] * rstd * gg[2 * j] + bb[2 * j], o1 = v[2 * j + 1] * rstd * gg[2 * j + 1] + bb[2 * j + 1];
            u32x4 w; w.x = pk2(o0.x, o0.y); w.y = pk2(o0.z, o0.w); w.z = pk2(o1.x, o1.y); w.w = pk2(o1.z, o1.w); xb[64 * j] = w;
            u32x2 q; q.x = pack4_e4m3(o0.x, o0.y, o0.z, o0.w); q.y = pack4_e4m3(o1.x, o1.y, o1.z, o1.w); x8[64 * j] = q; }
#pragma unroll
        for (int j = 0; j < 2; ++j) { r0[j] = r1[j]; r1[j] = r2[j]; }
    }
}
__device__ __forceinline__ void route(const float* __restrict__ logits, const float* __restrict__ rbias, int* __restrict__ idx, float* __restrict__ wgt, unsigned* __restrict__ counts,
                                      TLAS int* hist  , int wg, int nwg, int tid) {
    const int lane = tid & 63, wave = tid >> 6;
    if (tid < NE) hist[tid] = 0;
    __syncthreads();
    const int per = (T + nwg - 1) / nwg;
    const f32x4 rb = ((const f32x4*)rbias)[lane];
    constexpr int NT = 2;
    for (int i = wave * NT; i < per; i += 8 * NT) {
        int tok[NT]; bool live[NT]; f32x4 lg[NT];
#pragma unroll
        for (int u = 0; u < NT; ++u) { tok[u] = wg * per + i + u; live[u] = (i + u < per) && tok[u] < T; lg[u] = ((const f32x4*)(logits + (size_t)(live[u] ? tok[u] : wg * per) * NE))[lane]; }
        float s[NT][4], c[NT][4];
#pragma unroll
        for (int u = 0; u < NT; ++u)
#pragma unroll
            for (int j = 0; j < 4; ++j) { s[u][j] = sigmoidf_(lg[u][j]); c[u][j] = s[u][j] + rb[j]; }
        float m1[NT], m2[NT];
#pragma unroll
        for (int u = 0; u < NT; ++u) { const float a = fmaxf(c[u][0], c[u][1]), b = fminf(c[u][0], c[u][1]), d = fmaxf(c[u][2], c[u][3]), e = fminf(c[u][2], c[u][3]); m1[u] = fmaxf(a, d); m2[u] = fmaxf(fminf(a, d), fmaxf(b, e)); }
#pragma unroll
        for (int off = 1; off < 8; off <<= 1)
#pragma unroll
            for (int u = 0; u < NT; ++u) { const float o1 = __shfl_xor(m1[u], off), o2 = __shfl_xor(m2[u], off); const float n1 = fmaxf(m1[u], o1), n2 = fmaxf(fminf(m1[u], o1), fmaxf(m2[u], o2)); m1[u] = n1; m2[u] = n2; }
        const int g = lane >> 3;
        float gs[NT]; int rank[NT];
#pragma unroll
        for (int u = 0; u < NT; ++u) { gs[u] = m1[u] + m2[u]; rank[u] = 0; }
#pragma unroll
        for (int j = 0; j < 8; ++j)
#pragma unroll
            for (int u = 0; u < NT; ++u) { const float gj = __shfl(gs[u], 8 * j); rank[u] += (gj > gs[u] || (gj == gs[u] && j < g)) ? 1 : 0; }
#pragma unroll
        for (int u = 0; u < NT; ++u) if (rank[u] >= 4) { c[u][0] = -INFINITY; c[u][1] = -INFINITY; c[u][2] = -INFINITY; c[u][3] = -INFINITY; }
        int myidx[NT]; float mysc[NT], ssum[NT];
#pragma unroll
        for (int u = 0; u < NT; ++u) { myidx[u] = 0; mysc[u] = 0.f; ssum[u] = 0.f; }
#pragma unroll
        for (int k = 0; k < 8; ++k) {
            float bv[NT]; int be[NT];
#pragma unroll
            for (int u = 0; u < NT; ++u) { bv[u] = c[u][0]; int bi = 0;
#pragma unroll
                for (int j = 1; j < 4; ++j) if (c[u][j] > bv[u]) { bv[u] = c[u][j]; bi = j; }
                be[u] = 4 * lane + bi; }
#pragma unroll
            for (int off = 1; off < 64; off <<= 1)
#pragma unroll
                for (int u = 0; u < NT; ++u) { const float ov = __shfl_xor(bv[u], off); const int oe = __shfl_xor(be[u], off); const bool take = ov > bv[u] || (ov == bv[u] && oe < be[u]); bv[u] = take ? ov : bv[u]; be[u] = take ? oe : be[u]; }
#pragma unroll
            for (int u = 0; u < NT; ++u) { const int wj = be[u] & 3, wl = be[u] >> 2;
                const float sloc = wj == 0 ? s[u][0] : (wj == 1 ? s[u][1] : (wj == 2 ? s[u][2] : s[u][3]));
                const float ssel = __shfl(sloc, wl);
                ssum[u] += ssel; if (lane == k) { myidx[u] = be[u]; mysc[u] = ssel; }
#pragma unroll
                for (int j = 0; j < 4; ++j) c[u][j] = (lane == wl && j == wj) ? -INFINITY : c[u][j]; }
        }
#pragma unroll
        for (int u = 0; u < NT; ++u)
            if (live[u] && lane < 8) { idx[tok[u] * 8 + lane] = myidx[u]; wgt[tok[u] * 8 + lane] = mysc[u] / ssum[u] * 2.5f; __hip_atomic_fetch_add(&hist[myidx[u]], 1, __ATOMIC_RELAXED, __HIP_MEMORY_SCOPE_WORKGROUP); }
    }
    __syncthreads();
    if (tid < NE && hist[tid] > 0) atomicAdd(&counts[tid], (unsigned)hist[tid]);
}
__device__ __forceinline__ void scan_scatter(const unsigned* __restrict__ counts, unsigned* __restrict__ cursor, const int* __restrict__ idx, int* __restrict__ pos_of, int* __restrict__ sorted_tok,
                                             int* __restrict__ tiles256, int* __restrict__ tiles64, TLAS int* lds, int wg, int nwg, int tid) {
    TLAS int* cnt = lds; TLAS int* offs = lds + 256; TLAS int* lcnt = lds + 512; TLAS int* base = lds + 768;
    if (tid < NE) { cnt[tid] = (int)__hip_atomic_load(&counts[tid], __ATOMIC_RELAXED, __HIP_MEMORY_SCOPE_AGENT); lcnt[tid] = 0; }
    __syncthreads();
    if (tid < NE) { int o = 0; for (int j = 0; j < tid; ++j) o += cnt[j]; offs[tid] = o; }
    __syncthreads();
    const int per = NSLOT / nwg;
    int myr[4], mye[4];
#pragma unroll
    for (int i = 0; i < 4; ++i) { const int li = tid + 512 * i; mye[i] = -1; myr[i] = 0;
        if (li < per) { const int e = idx[wg * per + li]; mye[i] = e; myr[i] = __hip_atomic_fetch_add(&lcnt[e], 1, __ATOMIC_RELAXED, __HIP_MEMORY_SCOPE_WORKGROUP); } }
    __syncthreads();
    if (tid < NE) { const int c = lcnt[tid]; base[tid] = offs[tid] + (c > 0 ? (int)atomicAdd(&cursor[tid], (unsigned)c) : 0); }
    __syncthreads();
#pragma unroll
    for (int i = 0; i < 4; ++i) { const int li = tid + 512 * i;
        if (li < per) { const int slot = wg * per + li; const int p = base[mye[i]] + myr[i]; pos_of[slot] = p; sorted_tok[p] = slot >> 3; } }
    if (wg == 0) {
        if (tid < 256) sorted_tok[NSLOT + tid] = 0;
        if (HYBRID && tid < NE) { const int c = cnt[tid], off = offs[tid];
            int t256 = 0, t64 = 0; for (int j = 0; j < tid; ++j) { t256 += (cnt[j] + 255) >> 8; t64 += (cnt[j] + 63) >> 6; }
            const int n256 = (c + 255) >> 8, n64 = (c + 63) >> 6;
            for (int i = 0; i < n256; ++i) { tiles256[t256 + i] = tid; tiles256[MAXT256 + t256 + i] = off + 256 * i; tiles256[2 * MAXT256 + t256 + i] = (c - 256 * i) < 256 ? (c - 256 * i) : 256; }
            for (int i = 0; i < n64; ++i) { tiles64[t64 + i] = tid; tiles64[MAXT64 + t64 + i] = off + 64 * i; tiles64[2 * MAXT64 + t64 + i] = (c - 64 * i) < 64 ? (c - 64 * i) : 64; }
            if (tid == NE - 1) { tiles256[3 * MAXT256] = t256 + n256; tiles64[3 * MAXT64] = t64 + n64; } }
    }
    __syncthreads();
}
__device__ __forceinline__ void final_rows(const bf16* __restrict__ X1, const bf16* __restrict__ SH, const unsigned char* __restrict__ YS, const int* __restrict__ pos_of, const float* __restrict__ wgt,
                                           const float* __restrict__ g, const float* __restrict__ bta, float* __restrict__ out, int gw, int ngw, int lane) {
    typedef float f2_ __attribute__((ext_vector_type(2)));
    f32x4 gg[4], bb[4];
#pragma unroll
    for (int j = 0; j < 4; ++j) { gg[j] = ((const f32x4*)g)[lane + 64 * j]; bb[j] = ((const f32x4*)bta)[lane + 64 * j]; }
    const int l8 = lane & 7;
    unsigned slot_cur = 0u, slot_nxt = 0u;
    if (gw < T) slot_cur = (lane & 8) ? __float_as_uint(wgt[gw * 8 + l8]) : (unsigned)pos_of[gw * 8 + l8];
    for (int row = gw; row < T; row += ngw) {
        const int rn = (row + ngw < T) ? row + ngw : row;
        slot_nxt = (lane & 8) ? __float_as_uint(wgt[rn * 8 + l8]) : (unsigned)pos_of[rn * 8 + l8];
        unsigned yv[8][4];
#pragma unroll
        for (int k = 0; k < 8; ++k) { const int p = __builtin_amdgcn_readlane((int)slot_cur, k);
#pragma unroll
            for (int j = 0; j < 4; ++j) yv[k][j] = __builtin_nontemporal_load((const unsigned*)(YS + (size_t)p * D) + lane + 64 * j); }
        f32x4 v[4];
#pragma unroll
        for (int j = 0; j < 4; ++j) { const u32x2 a = ((const u32x2*)(X1 + (size_t)row * D))[lane + 64 * j]; const u32x2 s = ((const u32x2*)(SH + (size_t)row * D))[lane + 64 * j];
            v[j].x = ALPHA * bflo(a.x) + bflo(s.x); v[j].y = ALPHA * bfhi(a.x) + bfhi(s.x); v[j].z = ALPHA * bflo(a.y) + bflo(s.y); v[j].w = ALPHA * bfhi(a.y) + bfhi(s.y); }
#pragma unroll
        for (int k = 0; k < 8; ++k) { const float w = __uint_as_float((unsigned)__builtin_amdgcn_readlane((int)slot_cur, 8 + k)) * YS_INV;
#pragma unroll
            for (int j = 0; j < 4; ++j) { const f2_ lo = __builtin_amdgcn_cvt_pk_f32_fp8(yv[k][j], false), hi = __builtin_amdgcn_cvt_pk_f32_fp8(yv[k][j], true);
                v[j].x += w * lo.x; v[j].y += w * lo.y; v[j].z += w * hi.x; v[j].w += w * hi.y; } }
        float s = 0.f;
#pragma unroll
        for (int j = 0; j < 4; ++j) s += (v[j].x + v[j].y) + (v[j].z + v[j].w);
        const float mean = wave_sum(s) * (1.f / D); float s2 = 0.f;
#pragma unroll
        for (int j = 0; j < 4; ++j) { v[j] = v[j] - mean; s2 += (v[j].x * v[j].x + v[j].y * v[j].y) + (v[j].z * v[j].z + v[j].w * v[j].w); }
        const float rstd = rsqrtf(wave_sum(s2) * (1.f / D) + LN_EPS);
#pragma unroll
        for (int j = 0; j < 4; ++j) __builtin_nontemporal_store(v[j] * rstd * gg[j] + bb[j], (f32x4*)(out + (size_t)row * D) + lane + 64 * j);
        slot_cur = slot_nxt;
    }
}
}
namespace pg8 {
#define PG8_LAS __attribute__((address_space(3)))
typedef unsigned short bf16_t;
typedef short bf16x8 __attribute__((ext_vector_type(8)));
typedef float f32x4 __attribute__((ext_vector_type(4)));
typedef float f32x2 __attribute__((ext_vector_type(2)));
typedef unsigned u32x4 __attribute__((ext_vector_type(4)));
typedef unsigned u32x2 __attribute__((ext_vector_type(2)));
constexpr int BM = 256, BK = 64, HALF = 128, HTB = HALF * BK * 2  , STAGE_BYTES = 8 * HTB, NXCD = 8, WGM = 8;

__host__ __device__ __forceinline__ int lds_byte(int r, int c) { const int st = (r >> 4) * 2 + (c >> 5), rr = r & 15, cc = c & 31, ob = rr * 64 + cc * 2; return st * 1024 + (ob ^ (((ob >> 9) & 1) << 5)); }
__host__ __device__ __forceinline__ void stage_rc(int b, int& R, int& C) { const int st = b / 1024, sb = b % 1024, swz = sb ^ (((sb >> 9) & 1) << 5); R = (st >> 1) * 16 + swz / 64; C = (st & 1) * 32 + (swz % 64) / 2; }
__host__ __device__ __forceinline__ int perm32(int rho) { const int n = rho >> 4, i = rho & 15; return 8 * (i >> 2) + 4 * n + (i & 3); }

struct Unit { unsigned A; unsigned B; int pm, pn, aux, nr; };

__device__ __forceinline__ unsigned cvt_pk_bf16(float lo, float hi) { typedef __bf16 bf16x2_t __attribute__((ext_vector_type(2))); f32x2 v = {lo, hi}; bf16x2_t b = __builtin_convertvector(v, bf16x2_t); return __builtin_bit_cast(unsigned, b); }

typedef int i32x8 __attribute__((ext_vector_type(8)));
typedef i32x8 i32x8_a16 __attribute__((aligned(16)));
template <class Epi, class Sched, bool GATHER, bool GATHER_NR = false, bool F8 = false>
__device__ __forceinline__ void gemm_phase(PG8_LAS unsigned char* lds, const unsigned char* wsbase, const int K, const Sched& S, Epi& E, const int wave) {
    const __amdgpu_buffer_rsrc_t rsrc = __builtin_amdgcn_make_buffer_rsrc((void*)wsbase, 0, 0x7fffffff, 0x00020000);
    const int tid_ = otid(wave);
    const int tid = tid_, wid = wave, lane = tid & 63, wr = wid >> 2, wc = wid & 3, fr = lane & 15, fq = lane >> 4;
    const int nt = K / BK;
    unsigned voffA[2], voffB[2];
#pragma unroll
    for (int i = 0; i < 2; ++i) { int R, C; stage_rc(tid * 16 + i * 8192, R, C); const int Rb = Epi::PERM ? ((R & ~31) + perm32(R & 31)) : R;
        voffA[i] = (unsigned)(R * K + C) * 2u; voffB[i] = (unsigned)(Rb * K + C) * 2u; }
    const unsigned kstep = (unsigned)(BK * 2);
    const unsigned hstep = (unsigned)HALF * (unsigned)K * 2u;
    const unsigned ldsw = (unsigned)wid * 1024u, ldsb = (unsigned)(size_t)lds;
    const int aoff = lds_byte(wr * 64 + fr, fq * 8), boff = lds_byte(wc * 32 + fr, fq * 8);
#define PG8_SA(b, h) (((b) * 2 + (h)) * HTB)
#define PG8_SB(b, h) ((4 + (b) * 2 + (h)) * HTB)
#define PG8_STAGE(bufoff, gbase, voff) do { _Pragma("unroll") for (int _i = 0; _i < 2; ++_i) \
        asm volatile("s_mov_b32 m0, %0\n\ts_nop 0\n\tbuffer_load_dwordx4 %1, %2, %3 offen lds" :: "s"(ldsb + (unsigned)(bufoff) + ldsw + (unsigned)(_i * 8192)), "v"((voff)[_i]), "s"(rsrc), "s"((unsigned)(gbase)) : "m0", "memory"); } while (0)
#define PG8_STAGE_A(bufoff, p, h, g) do { if (GATHER) PG8_STAGE(bufoff, p, (g)[h]); else PG8_STAGE(bufoff, (p) + (h) * hstep, voffA); } while (0)
    const int aoff8 = lds_byte(wr * 64 + fr, fq * 16), boff8 = lds_byte(wc * 32 + fr, fq * 16);
#define PG8_LDA8(dst, b, h) do { _Pragma("unroll") for (int m = 0; m < 4; ++m) dst[m] = *(const PG8_LAS i32x8_a16*)(lds + PG8_SA(b, h) + aoff8 + m * 2048); } while (0)
#define PG8_LDB8(dst, b, h) do { _Pragma("unroll") for (int n = 0; n < 2; ++n) dst[n] = *(const PG8_LAS i32x8_a16*)(lds + PG8_SB(b, h) + boff8 + n * 2048); } while (0)
#define PG8_MMA8(ai, bj, At, Bt) do { __builtin_amdgcn_s_setprio(1); _Pragma("unroll") for (int m = 0; m < 4; ++m) _Pragma("unroll") for (int n = 0; n < 2; ++n) \
        acc[ai][bj][m][n] = __builtin_amdgcn_mfma_scale_f32_16x16x128_f8f6f4(Bt[n], At[m], acc[ai][bj][m][n], 0, 0, 0, 0x7F7F7F7F, 0, 0x7F7F7F7F); __builtin_amdgcn_s_setprio(0); } while (0)
#define PG8_LDA(dst, b, h) do { _Pragma("unroll") for (int m = 0; m < 4; ++m) _Pragma("unroll") for (int k = 0; k < 2; ++k) dst[m][k] = *(const PG8_LAS bf16x8*)(lds + PG8_SA(b, h) + aoff + m * 2048 + k * 1024); } while (0)
#define PG8_LDB(dst, b, h) do { _Pragma("unroll") for (int n = 0; n < 2; ++n) _Pragma("unroll") for (int k = 0; k < 2; ++k) dst[n][k] = *(const PG8_LAS bf16x8*)(lds + PG8_SB(b, h) + boff + n * 2048 + k * 1024); } while (0)
#define PG8_MMA(ai, bj, At, Bt) do { __builtin_amdgcn_s_setprio(1); _Pragma("unroll") for (int m = 0; m < 4; ++m) _Pragma("unroll") for (int n = 0; n < 2; ++n) _Pragma("unroll") for (int k = 0; k < 2; ++k) \
        acc[ai][bj][m][n] = __builtin_amdgcn_mfma_f32_16x16x32_bf16(Bt[n][k], At[m][k], acc[ai][bj][m][n], 0, 0, 0); __builtin_amdgcn_s_setprio(0); } while (0)
#define PG8_WAIT_V(n) asm volatile("s_waitcnt vmcnt(" #n ")" ::: "memory")
#define PG8_WAIT_L(n) asm volatile("s_waitcnt lgkmcnt(" #n ")" ::: "memory")
#define PG8_BAR __builtin_amdgcn_s_barrier()
#define PG8_SCHED __builtin_amdgcn_sched_barrier(0)
#define PG8_GOFF(dst, u) do { if (GATHER) { _Pragma("unroll") for (int _i = 0; _i < 2; ++_i) { int _R, _C; stage_rc(tid * 16 + _i * 8192, _R, _C); _Pragma("unroll") for (int _h = 0; _h < 2; ++_h) \
        dst[_h][_i] = (unsigned)(S.row_index((u), _R + _h * HALF) * K + _C) * 2u; } } } while (0)
    Unit cur, nxt; int ui = 0;
    if (!S.next(0, cur)) return;
    f32x4 acc[2][2][4][2];
#pragma unroll
    for (int a = 0; a < 2; ++a)
#pragma unroll
        for (int b = 0; b < 2; ++b)
#pragma unroll
            for (int m = 0; m < 4; ++m)
#pragma unroll
                for (int n = 0; n < 2; ++n) acc[a][b][m][n] = (f32x4){0.f, 0.f, 0.f, 0.f};
    bf16x8 At[4][2], B0[2][2], B1[2][2];
    i32x8 At8[4], B08[2], B18[2];
    unsigned curG[2][2] = {{0u, 0u}, {0u, 0u}}, nxtG[2][2] = {{0u, 0u}, {0u, 0u}};
    unsigned cA = cur.A, cB = cur.B;
    PG8_GOFF(curG, cur);
    PG8_STAGE(PG8_SB(0, 0), cB, voffB); PG8_STAGE(PG8_SB(0, 1), cB + hstep, voffB); PG8_STAGE_A(PG8_SA(0, 0), cA, 0, curG); PG8_STAGE_A(PG8_SA(0, 1), cA, 1, curG);
    if (wr == 1) PG8_BAR;
    PG8_WAIT_V(2); PG8_BAR;
    PG8_STAGE(PG8_SB(1, 0), cB + kstep, voffB); PG8_STAGE_A(PG8_SA(1, 0), cA + kstep, 0, curG); PG8_STAGE(PG8_SB(1, 1), cB + hstep + kstep, voffB);
    PG8_WAIT_V(6); PG8_BAR;
    for (;;) {
        const bool has_next = S.next(ui + 1, nxt);
        const unsigned nA = has_next ? nxt.A : cA, nB = has_next ? nxt.B : cB;
        if (GATHER) { if (has_next) PG8_GOFF(nxtG, nxt); else { _Pragma("unroll") for (int _h = 0; _h < 2; ++_h) _Pragma("unroll") for (int _i = 0; _i < 2; ++_i) nxtG[_h][_i] = curG[_h][_i]; } }
#pragma unroll 1
        for (int t = 0; t < nt; t += 2) {
            const bool last = (t == nt - 2);
            const unsigned a1 = cA + (unsigned)(t + 1) * kstep;
            const unsigned a2 = last ? nA : cA + (unsigned)(t + 2) * kstep, b2 = last ? nB : cB + (unsigned)(t + 2) * kstep;
            const unsigned a3 = a2 + kstep, b3 = b2 + kstep;
            if (F8) { PG8_LDB8(B08, 0, 0); PG8_LDB8(B18, 0, 1); PG8_SCHED; PG8_LDA8(At8, 0, 0); } else { PG8_LDB(B0, 0, 0); PG8_LDB(B1, 0, 1); PG8_SCHED; PG8_LDA(At, 0, 0); } PG8_STAGE_A(PG8_SA(1, 1), a1, 1, curG);
            if (GATHER) { if (last) { _Pragma("unroll") for (int _h = 0; _h < 2; ++_h) _Pragma("unroll") for (int _i = 0; _i < 2; ++_i) curG[_h][_i] = nxtG[_h][_i]; } }
            PG8_WAIT_V(8); PG8_WAIT_L(0); PG8_BAR; if (F8) { PG8_MMA8(0, 0, At8, B08); PG8_MMA8(0, 1, At8, B18); } else { PG8_MMA(0, 0, At, B0); PG8_MMA(0, 1, At, B1); } PG8_BAR; PG8_SCHED;
            if (F8) PG8_LDA8(At8, 0, 1); else PG8_LDA(At, 0, 1); PG8_STAGE(PG8_SB(0, 0), b2, voffB); PG8_STAGE(PG8_SB(0, 1), b2 + hstep, voffB); PG8_STAGE_A(PG8_SA(0, 0), a2, 0, curG);
            PG8_WAIT_V(8); PG8_WAIT_L(0); PG8_BAR; if (!GATHER_NR || cur.nr > HALF) { if (F8) { PG8_MMA8(1, 0, At8, B08); PG8_MMA8(1, 1, At8, B18); } else { PG8_MMA(1, 0, At, B0); PG8_MMA(1, 1, At, B1); } } PG8_BAR; PG8_SCHED;
            if (F8) { PG8_LDB8(B08, 1, 0); PG8_LDB8(B18, 1, 1); PG8_SCHED; PG8_LDA8(At8, 1, 0); } else { PG8_LDB(B0, 1, 0); PG8_LDB(B1, 1, 1); PG8_SCHED; PG8_LDA(At, 1, 0); } PG8_STAGE_A(PG8_SA(0, 1), a2, 1, curG);
            PG8_WAIT_V(8); PG8_WAIT_L(0); PG8_BAR; if (F8) { PG8_MMA8(0, 0, At8, B08); PG8_MMA8(0, 1, At8, B18); } else { PG8_MMA(0, 0, At, B0); PG8_MMA(0, 1, At, B1); } PG8_BAR; PG8_SCHED;
            if (F8) PG8_LDA8(At8, 1, 1); else PG8_LDA(At, 1, 1); PG8_STAGE(PG8_SB(1, 0), b3, voffB); PG8_STAGE(PG8_SB(1, 1), b3 + hstep, voffB); PG8_STAGE_A(PG8_SA(1, 0), a3, 0, curG);
            PG8_WAIT_V(8); PG8_WAIT_L(0); PG8_BAR; if (!GATHER_NR || cur.nr > HALF) { if (F8) { PG8_MMA8(1, 0, At8, B08); PG8_MMA8(1, 1, At8, B18); } else { PG8_MMA(1, 0, At, B0); PG8_MMA(1, 1, At, B1); } } PG8_BAR; PG8_SCHED;
        }
        if (wr == 0) PG8_BAR;
        { const int l2 = lane_id();
          E(acc, cur, wr, wc, l2 & 15, l2 >> 4); }
        if (!has_next) break;
        if (!E.keep(cur)) {
#pragma unroll
        for (int a = 0; a < 2; ++a)
#pragma unroll
            for (int b = 0; b < 2; ++b)
#pragma unroll
                for (int m = 0; m < 4; ++m)
#pragma unroll
                    for (int n = 0; n < 2; ++n) acc[a][b][m][n] = (f32x4){0.f, 0.f, 0.f, 0.f};
        }
        cur = nxt; cA = nA; cB = nB; ++ui;
        if (wr == 1) PG8_BAR;
    }
    PG8_WAIT_V(0);
    PG8_BAR;
#undef PG8_SA
#undef PG8_SB
#undef PG8_STAGE
#undef PG8_STAGE_A
#undef PG8_LDA
#undef PG8_LDA8
#undef PG8_LDB8
#undef PG8_MMA8
#undef PG8_LDB
#undef PG8_MMA
#undef PG8_WAIT_V
#undef PG8_WAIT_L
#undef PG8_BAR
#undef PG8_SCHED
#undef PG8_GOFF
}

struct GridOrder {
    unsigned A0, B0, asub, bsub; int nsub, nM, nN, nwg, G, c; unsigned astep, bstep;
    __device__ __forceinline__ void init(int M, int N, int K, int G_, int c_, int nsub_) { nM = M / BM; nN = N / BM; nwg = nM * nN; G = G_; c = c_; nsub = nsub_; astep = (unsigned)BM * (unsigned)K * 2u; bstep = astep; asub = 0; bsub = 0; }
    __device__ __forceinline__ bool next(int i, Unit& u) const {
        const int sub = i % nsub; const long L = (long)(i / nsub) * G + c; if (L >= nwg) return false;
        int wgid = (int)L; { const int q = nwg / NXCD, r = nwg % NXCD, xcd = wgid % NXCD, off = wgid / NXCD; wgid = (xcd < r ? xcd * (q + 1) : r * (q + 1) + (xcd - r) * q) + off; }
        const int nig = WGM * nN, gid = wgid / nig, fm = gid * WGM, gsz = (nM - fm) < WGM ? (nM - fm) : WGM;
        u.pm = fm + ((wgid % nig) % gsz); u.pn = (wgid % nig) / gsz; u.aux = sub; u.nr = BM;
        const unsigned a_ = A0 + (unsigned)sub * asub, b_ = B0 + (unsigned)sub * bsub;
        u.A = a_ + (unsigned)u.pm * astep; u.B = b_ + (unsigned)u.pn * bstep; return true;
    }
    __device__ __forceinline__ int row_index(const Unit&, int r) const { return r; }
};
}
namespace pg8 {
#define EPI_FOR_AI_M _Pragma("unroll") for (int ai = 0; ai < 2; ++ai) _Pragma("unroll") for (int m = 0; m < 4; ++m)
__device__ __forceinline__ u32x4 pack8(const f32x4& v0, const f32x4& v1) { u32x4 w; w.x = cvt_pk_bf16(v0[0], v0[1]); w.y = cvt_pk_bf16(v0[2], v0[3]); w.z = cvt_pk_bf16(v1[0], v1[1]); w.w = cvt_pk_bf16(v1[2], v1[3]); return w; }
__device__ __forceinline__ void unpack8(const u32x4& w, f32x4& v0, f32x4& v1) { v0 = (f32x4){bflo(w.x), bfhi(w.x), bflo(w.y), bfhi(w.y)}; v1 = (f32x4){bflo(w.z), bfhi(w.z), bflo(w.w), bfhi(w.w)}; }
__device__ __forceinline__ float silu_mul(float g, float u) { return g * u * __builtin_amdgcn_rcpf(1.f + __expf(-g)); }

struct EpiProj {
    static constexpr bool PERM = true;
    bf16_t* O;
    __device__ __forceinline__ bool keep(const Unit&) const { return false; }
    __device__ __forceinline__ void operator()(f32x4 (&acc)[2][2][4][2], const Unit& u, int wr, int wc, int fr, int fq) const {
        const int row0 = u.pm * BM + wr * 64 + fr, col0 = u.pn * BM + wc * 32 + 8 * fq;
        const int pn = u.pn;
        const float sc = (pn < 2 || pn == 6 || pn == 7) ? QS64 : ((pn == 9 || pn == 10) ? QS128 : 1.f);
        EPI_FOR_AI_M { bf16_t* rowp = O + (size_t)(row0 + ai * HALF + m * 16) * IN_COLS + col0;
#pragma unroll
            for (int bj = 0; bj < 2; ++bj) *(u32x4*)(rowp + bj * HALF) = pack8(acc[ai][bj][m][0] * sc, acc[ai][bj][m][1] * sc); }
    }
};
struct EpiGate8 {
    static constexpr bool PERM = true;
    const PG8_LAS float* b_gate; unsigned char* GT;
    __device__ __forceinline__ bool keep(const Unit&) const { return false; }
    __device__ __forceinline__ void operator()(f32x4 (&acc)[2][2][4][2], const Unit& u, int wr, int wc, int fr, int fq) const {
        const int col0 = u.pn * BM + wc * 32 + 8 * fq;
        f32x4 bv[2][2];
#pragma unroll
        for (int bj = 0; bj < 2; ++bj)
#pragma unroll
            for (int n = 0; n < 2; ++n) bv[bj][n] = *(const PG8_LAS f32x4*)(b_gate + col0 + bj * HALF + 4 * n);
        unsigned char* tile = GT + ((size_t)(u.pm * 12 + u.pn) * 16) * 512 * 8;
        unsigned off = (unsigned)((wr * 4 + wc) * 64 + (fq * 16 + fr)) * 8u;
        EPI_FOR_AI_M {
#pragma unroll
            for (int bj = 0; bj < 2; ++bj) { const f32x4 v0 = acc[ai][bj][m][0] * (-W8_INV * LOG2E) + bv[bj][0], v1 = acc[ai][bj][m][1] * (-W8_INV * LOG2E) + bv[bj][1];
                u32x2 w; w.x = 0u; w.y = 0u;
#pragma unroll
                for (int j = 0; j < 4; ++j) {
                    w.x = __builtin_amdgcn_cvt_pk_u8_f32(__builtin_amdgcn_rcpf((1.f / 255.f) + __builtin_amdgcn_exp2f(__builtin_amdgcn_fmed3f(v0[j], -30.f * LOG2E - LOG2_255, GATE_TMAX))), (unsigned)j, w.x);
                    w.y = __builtin_amdgcn_cvt_pk_u8_f32(__builtin_amdgcn_rcpf((1.f / 255.f) + __builtin_amdgcn_exp2f(__builtin_amdgcn_fmed3f(v1[j], -30.f * LOG2E - LOG2_255, GATE_TMAX))), (unsigned)j, w.y); }
                *(u32x2*)(tile + off) = w; off += 512u * 8u; asm volatile("" : "+v"(off)); } }
    }
};
struct EpiBf16 {
    static constexpr bool PERM = true;
    bf16_t* O; int ldc; float sc;
    __device__ __forceinline__ bool keep(const Unit&) const { return false; }
    __device__ __forceinline__ void operator()(f32x4 (&acc)[2][2][4][2], const Unit& u, int wr, int wc, int fr, int fq) const {
        const int row0 = u.pm * BM + wr * 64 + fr, col0 = u.pn * BM + wc * 32 + 8 * fq;
        EPI_FOR_AI_M { bf16_t* rowp = O + (size_t)(row0 + ai * HALF + m * 16) * ldc + col0;
#pragma unroll
            for (int bj = 0; bj < 2; ++bj) *(u32x4*)(rowp + bj * HALF) = pack8(acc[ai][bj][m][0] * sc, acc[ai][bj][m][1] * sc); }
    }
};
struct EpiOutProj {
    static constexpr bool PERM = true;
    unsigned char* O; const u32x2* GT;
    __device__ __forceinline__ bool keep(const Unit& u) const { return u.aux != 2; }
    __device__ __forceinline__ void operator()(f32x4 (&acc)[2][2][4][2], const Unit& u, int wr, int wc, int fr, int fq) const {
        const int row0 = u.pm * BM + wr * 64 + fr, col0 = u.pn * BM + wc * 32 + 8 * fq; const int sub = u.aux;
        const u32x2* ga = GT + ((size_t)(u.pm * 12 + sub * 4 + u.pn) * 16) * 512 + (wr * 4 + wc) * 64 + (fq * 16 + fr);
        const u32x2* gb = ga + (sub != 2 ? (size_t)4 * 16 * 512 : 0);
#pragma unroll
        for (int ai = 0; ai < 2; ++ai) {
            u32x2 wa[4][2], wb[4][2];
#pragma unroll
            for (int m = 0; m < 4; ++m)
#pragma unroll
                for (int bj = 0; bj < 2; ++bj) { const int fi = ((ai * 4 + m) * 2 + bj) * 512; wa[m][bj] = ga[fi]; wb[m][bj] = gb[fi]; }
#pragma unroll
            for (int m = 0; m < 4; ++m) { const size_t row = (size_t)(row0 + ai * HALF + m * 16);
#pragma unroll
                for (int bj = 0; bj < 2; ++bj) {
                    f32x4 a0, a1;
#pragma unroll
                    for (int j = 0; j < 4; ++j) { a0[j] = (float)((wa[m][bj].x >> (8 * j)) & 0xffu); a1[j] = (float)((wa[m][bj].y >> (8 * j)) & 0xffu); }
                    if (sub != 2) {
#pragma unroll
                        for (int j = 0; j < 4; ++j) { a0[j] *= __builtin_amdgcn_rcpf((float)((wb[m][bj].x >> (8 * j)) & 0xffu)); a1[j] *= __builtin_amdgcn_rcpf((float)((wb[m][bj].y >> (8 * j)) & 0xffu)); } }
                    acc[ai][bj][m][0] = acc[ai][bj][m][0] * a0; acc[ai][bj][m][1] = acc[ai][bj][m][1] * a1;
                    if (sub == 2) { constexpr float sc = M8_SCALE / (O8_SCALE * W8_SCALE * 255.f); const f32x4 v0 = acc[ai][bj][m][0] * sc, v1 = acc[ai][bj][m][1] * sc;
                        u32x2 w; w.x = pack4_e4m3(v0[0], v0[1], v0[2], v0[3]); w.y = pack4_e4m3(v1[0], v1[1], v1[2], v1[3]); *(u32x2*)(O + row * D + col0 + bj * HALF) = w; } } }
        }
    }
};
struct EpiY {
    static constexpr bool PERM = true;
    bf16_t* Z; const bf16_t* XB;
    __device__ __forceinline__ bool keep(const Unit&) const { return false; }
    __device__ __forceinline__ void operator()(f32x4 (&acc)[2][2][4][2], const Unit& u, int wr, int wc, int fr, int fq) const {
        const int row0 = u.pm * BM + wr * 64 + fr, col0 = u.pn * BM + wc * 32 + 8 * fq;
        u32x4 xv[2][4][2];
#pragma unroll
        for (int ai = 0; ai < 2; ++ai)
#pragma unroll
            for (int m = 0; m < 4; ++m) { const size_t off = (size_t)(row0 + ai * HALF + m * 16) * D + col0;
#pragma unroll
                for (int bj = 0; bj < 2; ++bj) xv[ai][m][bj] = *(const u32x4*)(XB + off + bj * HALF); }
#pragma unroll
        for (int ai = 0; ai < 2; ++ai)
#pragma unroll
            for (int m = 0; m < 4; ++m) { const size_t off = (size_t)(row0 + ai * HALF + m * 16) * D + col0;
#pragma unroll
                for (int bj = 0; bj < 2; ++bj) { f32x4 x0, x1; unpack8(xv[ai][m][bj], x0, x1);
                    *(u32x4*)(Z + off + bj * HALF) = pack8(x0 * ALPHA + acc[ai][bj][m][0] * (1.f / (M8_SCALE * W8_SCALE)), x1 * ALPHA + acc[ai][bj][m][1] * (1.f / (M8_SCALE * W8_SCALE))); } }
    }
};
struct EpiRouter {
    static constexpr bool PERM = true;
    float* logits;
    __device__ __forceinline__ bool keep(const Unit&) const { return false; }
    __device__ __forceinline__ void operator()(f32x4 (&acc)[2][2][4][2], const Unit& u, int wr, int wc, int fr, int fq) const {
        const int row0 = u.pm * BM + wr * 64 + fr, c8 = wc * 32 + 8 * fq;
        EPI_FOR_AI_M { float* rowp = logits + (size_t)(row0 + ai * HALF + m * 16) * NE + c8;
#pragma unroll
            for (int bj = 0; bj < 2; ++bj) { *(f32x4*)(rowp + bj * HALF) = acc[ai][bj][m][0]; *(f32x4*)(rowp + bj * HALF + 4) = acc[ai][bj][m][1]; } }
    }
};
struct EpiShared8 {
    static constexpr bool PERM = true;
    unsigned char* HS;
    __device__ __forceinline__ bool keep(const Unit&) const { return false; }
    __device__ __forceinline__ void operator()(f32x4 (&acc)[2][2][4][2], const Unit& u, int wr, int wc, int fr, int fq) const {
        const int row0 = u.pm * BM + wr * 64 + fr, c8 = wc * 32 + 8 * fq;
        EPI_FOR_AI_M { f32x4 h0, h1;
#pragma unroll
            for (int j = 0; j < 4; ++j) { h0[j] = silu_mul(acc[ai][0][m][0][j] * W8_INV, acc[ai][1][m][0][j] * (W8_INV * H8_SCALE)); h1[j] = silu_mul(acc[ai][0][m][1][j] * W8_INV, acc[ai][1][m][1][j] * (W8_INV * H8_SCALE)); }
            u32x2 w; w.x = pack4_e4m3(h0[0], h0[1], h0[2], h0[3]); w.y = pack4_e4m3(h1[0], h1[1], h1[2], h1[3]);
            *(u32x2*)(HS + (size_t)(row0 + ai * HALF + m * 16) * EFF + u.pn * HALF + c8) = w; }
    }
};
struct EpiExpGU {
    static constexpr bool PERM = true;
    bf16_t* H;
    __device__ __forceinline__ bool keep(const Unit&) const { return false; }
    __device__ __forceinline__ void operator()(f32x4 (&acc)[2][2][4][2], const Unit& u, int wr, int wc, int fr, int fq) const {
        const int c8 = wc * 32 + 8 * fq;
        EPI_FOR_AI_M { const int rl = ai * HALF + wr * 64 + m * 16 + fr; f32x4 h0, h1;
#pragma unroll
            for (int j = 0; j < 4; ++j) { h0[j] = silu_mul(acc[ai][0][m][0][j], acc[ai][1][m][0][j]); h1[j] = silu_mul(acc[ai][0][m][1][j], acc[ai][1][m][1][j]); }
            if (rl < u.nr) *(u32x4*)(H + (size_t)(u.pm + rl) * EFF + u.pn * HALF + c8) = pack8(h0, h1); }
    }
};
struct EpiExpGU8 {
    static constexpr bool PERM = true;
    unsigned char* H;
    __device__ __forceinline__ bool keep(const Unit&) const { return false; }
    __device__ __forceinline__ void operator()(f32x4 (&acc)[2][2][4][2], const Unit& u, int wr, int wc, int fr, int fq) const {
        const int c8 = wc * 32 + 8 * fq;
        EPI_FOR_AI_M { const int rl = ai * HALF + wr * 64 + m * 16 + fr; f32x4 h0, h1;
#pragma unroll
            for (int j = 0; j < 4; ++j) { h0[j] = silu_mul(acc[ai][0][m][0][j] * W8_INV, acc[ai][1][m][0][j] * (W8_INV * H8_SCALE)); h1[j] = silu_mul(acc[ai][0][m][1][j] * W8_INV, acc[ai][1][m][1][j] * (W8_INV * H8_SCALE)); }
            if (rl < u.nr) { u32x2 w; w.x = pack4_e4m3(h0[0], h0[1], h0[2], h0[3]); w.y = pack4_e4m3(h1[0], h1[1], h1[2], h1[3]);
                *(u32x2*)(H + (size_t)(u.pm + rl) * EFF + u.pn * HALF + c8) = w; } }
    }
};
__device__ __forceinline__ unsigned pack4_fp8(const f32x4& v) {
    const float a = fminf(fmaxf(v[0] * YS_SCALE, -448.f), 448.f), b = fminf(fmaxf(v[1] * YS_SCALE, -448.f), 448.f), c = fminf(fmaxf(v[2] * YS_SCALE, -448.f), 448.f), d = fminf(fmaxf(v[3] * YS_SCALE, -448.f), 448.f);
    unsigned w = __builtin_amdgcn_cvt_pk_fp8_f32(a, b, 0u, false); return __builtin_amdgcn_cvt_pk_fp8_f32(c, d, w, true);
}
struct EpiExpDown {
    static constexpr bool PERM = true;
    unsigned char* Y; float sc;
    __device__ __forceinline__ bool keep(const Unit&) const { return false; }
    __device__ __forceinline__ void operator()(f32x4 (&acc)[2][2][4][2], const Unit& u, int wr, int wc, int fr, int fq) const {
        const int col0 = u.pn * BM + wc * 32 + 8 * fq;
        EPI_FOR_AI_M { const int rl = ai * HALF + wr * 64 + m * 16 + fr;
            if (rl < u.nr) { unsigned char* rowp = Y + (size_t)(u.pm + rl) * D + col0;
#pragma unroll
                for (int bj = 0; bj < 2; ++bj) { u32x2 w; w.x = pack4_fp8(acc[ai][bj][m][0] * sc); w.y = pack4_fp8(acc[ai][bj][m][1] * sc); *(u32x2*)(rowp + bj * HALF) = w; } } }
    }
};
struct ExpertOrder {
    const PG8_LAS int* offs; const PG8_LAS int* cnt; const PG8_LAS unsigned short* tmap;
    int nN, nwg, G, c; unsigned A; const int* rows; unsigned arow; unsigned Bb, bexp, bstep;
    __device__ __forceinline__ bool next(int i, Unit& u) const {
        const long L = (long)i * G + c; if (L >= nwg) return false;
        int wgid = (int)L; { const int q = nwg / NXCD, r = nwg % NXCD, xcd = wgid % NXCD, off = wgid / NXCD; wgid = (xcd < r ? xcd * (q + 1) : r * (q + 1) + (xcd - r) * q) + off; }
        const int tile = wgid / nN; u.pn = wgid % nN;
        const int tm = __builtin_amdgcn_readfirstlane((int)tmap[tile]); const int e = tm >> 7, ti = tm & 127;
        const int ce = __builtin_amdgcn_readfirstlane(cnt[e]), oe = __builtin_amdgcn_readfirstlane(offs[e]);
        u.aux = e; u.pm = oe + 256 * ti; u.nr = (ce - 256 * ti) < 256 ? (ce - 256 * ti) : 256;
        u.A = rows ? A : A + (unsigned)u.pm * arow; u.B = Bb + (unsigned)u.aux * bexp + (unsigned)u.pn * bstep; return true;
    }
    __device__ __forceinline__ int row_index(const Unit& u, int r) const { return rows[u.pm + r]; }
};
__device__ __forceinline__ int build_tile_map(const unsigned* counts, PG8_LAS int* tab, int tid) {
    PG8_LAS int* offs = tab; PG8_LAS int* cnt = tab + 256; PG8_LAS unsigned short* tmap = (PG8_LAS unsigned short*)(tab + 512); PG8_LAS int* tot = tab + 512 + 640;
    if (tid < 256) cnt[tid] = (int)__hip_atomic_load(&counts[tid], __ATOMIC_RELAXED, __HIP_MEMORY_SCOPE_AGENT);
    __syncthreads();
    if (tid < 256) { int o = 0, t0 = 0; for (int j = 0; j < tid; ++j) { o += cnt[j]; t0 += (cnt[j] + 255) >> 8; }
        offs[tid] = o; const int nt = (cnt[tid] + 255) >> 8;
        for (int i = 0; i < nt; ++i) tmap[t0 + i] = (unsigned short)((tid << 7) | i);
        if (tid == 255) tot[0] = t0 + nt; }
    __syncthreads();
    return tot[0];
}

__device__ __forceinline__ void down_phase(PG8_LAS unsigned char* lds, unsigned char* wsbase, const PG8_LAS int* offs, const PG8_LAS int* cnt, const PG8_LAS int* srt, const int G, const int c, const unsigned Abase, const unsigned Bbase, const unsigned Ybase, const unsigned dump0, const float sc, const int wave, const int probe  ) {
    const __amdgpu_buffer_rsrc_t rsrc = __builtin_amdgcn_make_buffer_rsrc((void*)wsbase, 0, 0x7fffffff, 0x00020000);
    const int tid = otid(wave), wid = wave, lane = tid & 63, wr = wid >> 2, wc = wid & 3, fr = lane & 15, fq = lane >> 4;
    constexpr unsigned ROWB = EFF;
    unsigned voffA[2];
#pragma unroll
    for (int i = 0; i < 2; ++i) { int R, C; stage_rc(tid * 16 + i * 8192, R, C); voffA[i] = (unsigned)R * ROWB + (unsigned)C * 2u; }
    const unsigned ldsw = (unsigned)wid * 1024u, ldsb = (unsigned)(size_t)lds;
    const int aoff8 = lds_byte(wr * 64 + fr, fq * 16);
#define DN_LOAD(ldsoff, goff, voff) do { _Pragma("unroll") for (int _i = 0; _i < 2; ++_i) \
        asm volatile("s_mov_b32 m0, %0\n\ts_nop 0\n\tbuffer_load_dwordx4 %1, %2, %3 offen lds" :: "s"(ldsb + (unsigned)(ldsoff) + ldsw + (unsigned)(_i * 8192)), "v"((voff)[_i]), "s"(rsrc), "s"((unsigned)(goff)) : "m0", "memory"); } while (0)
#define DN_STAGE_A(st) do { if (probe == 3) break; const int _s = (st) < nst ? (st) : nst - 1; const unsigned _g = arow0 + (unsigned)_s * (128u * ROWB); const unsigned _l = (unsigned)((st) & 3) * 32768u; \
        DN_LOAD(_l, _g, voffA); DN_LOAD(_l + 16384u, _g + 128u, voffA); } while (0)
#define DN_WAIT(n) asm volatile("s_waitcnt vmcnt(" #n ")" ::: "memory")
#define DN_BAR __builtin_amdgcn_s_barrier()
    for (int it = 0;; ++it) {
        const int L = it * G + c; if (L >= NE * 4) break;
        int e, pn;
        if (G == 256) { const int g = (c & 7) + 8 * (c >> 5); pn = (c >> 3) & 3; e = __builtin_amdgcn_readfirstlane(srt[it * 64 + ((it & 1) ? 63 - g : g)]); }
        else { const int x = L & 7, j = L >> 3; e = ((j >> 2) << 3) | x; pn = j & 3; }
        const int ce = __builtin_amdgcn_readfirstlane(cnt[e]), oe = __builtin_amdgcn_readfirstlane(offs[e]);
        if (ce <= 0) continue;
        const int nst = (ce + 127) >> 7;
        const unsigned arow0 = Abase + (unsigned)oe * ROWB;
        const unsigned b0 = Bbase + (unsigned)e * (unsigned)(D * EFF) + (unsigned)pn * (256u * ROWB);
        unsigned voffB[2]; int boff8;
        { const int t2 = otid(wave), l2 = t2 & 63;
#pragma unroll
          for (int i = 0; i < 2; ++i) { int R, C; stage_rc(t2 * 16 + i * 8192, R, C); const int Rb = (R >> 5) * 64 + 16 * ((R & 15) >> 2) + 4 * ((R >> 4) & 1) + (R & 3); voffB[i] = (unsigned)Rb * ROWB + (unsigned)C * 2u; }
          boff8 = lds_byte(wc * 32 + (l2 & 15), (l2 >> 4) * 16); }
#pragma unroll
        for (int b = 0; b < 2; ++b)
#pragma unroll
            for (int h = 0; h < 2; ++h) DN_LOAD(65536u + (unsigned)(b * 2 + h) * 16384u, b0 + (unsigned)h * (8u * ROWB) + (unsigned)b * 128u, voffB);
        DN_STAGE_A(0); DN_STAGE_A(1);
        DN_WAIT(8); DN_BAR;
        i32x8 Bf[2][2][2];
#pragma unroll
        for (int b = 0; b < 2; ++b)
#pragma unroll
            for (int bj = 0; bj < 2; ++bj)
#pragma unroll
                for (int n = 0; n < 2; ++n) Bf[b][bj][n] = *(const PG8_LAS i32x8_a16*)(lds + 65536 + (b * 2 + bj) * 16384 + boff8 + n * 2048);
        asm volatile("s_waitcnt lgkmcnt(0)" ::: "memory");
#pragma unroll
        for (int b = 0; b < 2; ++b)
#pragma unroll
            for (int bj = 0; bj < 2; ++bj)
#pragma unroll
                for (int n = 0; n < 2; ++n) asm volatile("" : "+v"(Bf[b][bj][n]));
        DN_BAR;
        DN_STAGE_A(2); DN_STAGE_A(3);
        f32x4 acc[2][4][2];
#pragma unroll
        for (int bj = 0; bj < 2; ++bj)
#pragma unroll
            for (int m = 0; m < 4; ++m)
#pragma unroll
                for (int n = 0; n < 2; ++n) acc[bj][m][n] = (f32x4){0.f, 0.f, 0.f, 0.f};
#define DN_MFMA(st) do { const int _q = (st) & 3; const f32x4 _z = {0.f, 0.f, 0.f, 0.f}; if (probe == 2) { _Pragma("unroll") for (int bj = 0; bj < 2; ++bj) _Pragma("unroll") for (int m = 0; m < 4; ++m) _Pragma("unroll") for (int n = 0; n < 2; ++n) acc[bj][m][n] = _z; break; } \
        { i32x8 At[4]; \
          _Pragma("unroll") for (int m = 0; m < 4; ++m) At[m] = *(const PG8_LAS i32x8_a16*)(lds + _q * 32768 + aoff8 + m * 2048); \
          __builtin_amdgcn_s_setprio(1); \
          _Pragma("unroll") for (int bj = 0; bj < 2; ++bj) _Pragma("unroll") for (int m = 0; m < 4; ++m) _Pragma("unroll") for (int n = 0; n < 2; ++n) \
              acc[bj][m][n] = __builtin_amdgcn_mfma_scale_f32_16x16x128_f8f6f4(Bf[0][bj][n], At[m], _z, 0, 0, 0, 0x7F7F7F7F, 0, 0x7F7F7F7F);     \
          __builtin_amdgcn_s_setprio(0); __builtin_amdgcn_sched_barrier(0); } \
        { i32x8 At[4]; \
          _Pragma("unroll") for (int m = 0; m < 4; ++m) At[m] = *(const PG8_LAS i32x8_a16*)(lds + _q * 32768 + 16384 + aoff8 + m * 2048); \
          __builtin_amdgcn_s_setprio(1); \
          _Pragma("unroll") for (int bj = 0; bj < 2; ++bj) _Pragma("unroll") for (int m = 0; m < 4; ++m) _Pragma("unroll") for (int n = 0; n < 2; ++n) \
              acc[bj][m][n] = __builtin_amdgcn_mfma_scale_f32_16x16x128_f8f6f4(Bf[1][bj][n], At[m], acc[bj][m][n], 0, 0, 0, 0x7F7F7F7F, 0, 0x7F7F7F7F); \
          __builtin_amdgcn_s_setprio(0); __builtin_amdgcn_sched_barrier(0); } } while (0)
#define DN_EPI(st) do { const int _l = lane_id(), _fr = _l & 15, _fq = _l >> 4;     \
        const int _r0 = (st) * 128 + wr * 64 + _fr; const unsigned _y0 = Ybase + (unsigned)(oe + _r0) * (unsigned)D + (unsigned)(pn * 256 + wc * 64 + 16 * _fq); const unsigned dump = dump0 + (unsigned)(wid * 64 + _l) * 16u; \
        _Pragma("unroll") for (int m = 0; m < 4; ++m) { const bool _ok = (_r0 + 16 * m) < ce && probe != 1; u32x4 w; \
            { const f32x4 v0 = acc[0][m][0] * sc, v1 = acc[0][m][1] * sc, v2 = acc[1][m][0] * sc, v3 = acc[1][m][1] * sc; \
              w.x = pack4_e4m3(v0[0], v0[1], v0[2], v0[3]); w.y = pack4_e4m3(v1[0], v1[1], v1[2], v1[3]); w.z = pack4_e4m3(v2[0], v2[1], v2[2], v2[3]); w.w = pack4_e4m3(v3[0], v3[1], v3[2], v3[3]); } \
            const unsigned _o = _ok ? _y0 + (unsigned)(16 * m) * (unsigned)D : dump; \
            __builtin_amdgcn_raw_buffer_store_b128(w, rsrc, (int)_o, 0, 0); } } while (0)
#define DN_STEP_HEAD(s) do { if ((s) >= 4) DN_WAIT(20); else if ((s) == 3) DN_WAIT(16); else if ((s) == 2) DN_WAIT(12); else if ((s) == 1) DN_WAIT(8); else DN_WAIT(12);     \
            DN_BAR; \
            if ((s) >= 1) DN_STAGE_A((s) + 3);                           } while (0)
        if (wr == 0) {
            for (int s = 0; s < nst; ++s) { DN_STEP_HEAD(s); DN_MFMA(s); DN_BAR; DN_EPI(s); }
        } else {
            for (int s = 0; s < nst; ++s) { DN_STEP_HEAD(s); if (s >= 1) { DN_EPI(s - 1); } DN_BAR; DN_MFMA(s); }
            DN_EPI(nst - 1);
        }
#undef DN_STEP_HEAD
        DN_WAIT(0); DN_BAR;
    }
#undef DN_LOAD
#undef DN_STAGE_A
#undef DN_WAIT
#undef DN_BAR
#undef DN_MFMA
#undef DN_EPI
}
}
namespace att {
#define ALAS __attribute__((address_space(3)))
typedef short s16x4 __attribute__((ext_vector_type(4)));
constexpr int KSLOT = 16384, VSLOT = 16384, LDS_K = 0, LDS_V = 2 * KSLOT, LDS_FLAG = 4 * KSLOT;
enum { SB = 0, SWA = 1, MEM = 2 };
__device__ __forceinline__ int crow(int r, int hi) { return (r & 3) + 8 * (r >> 2) + 4 * hi; }
__device__ __forceinline__ unsigned cvtpk(float lo, float hi) { typedef float f2 __attribute__((ext_vector_type(2))); typedef __bf16 b2 __attribute__((ext_vector_type(2))); f2 v = {lo, hi}; b2 b = __builtin_convertvector(v, b2); return __builtin_bit_cast(unsigned, b); }
__device__ __forceinline__ float xhalf(float v) { return __shfl_xor(v, 32); }
__device__ __forceinline__ s16x4 vtr(const ALAS char* p) { typedef short v4i16_t __attribute__((ext_vector_type(4))); return __builtin_bit_cast(s16x4, __builtin_amdgcn_ds_read_tr16_b64_v4i16((ALAS v4i16_t*)p)); }

__device__ __forceinline__ void att_bar() { asm volatile("s_waitcnt lgkmcnt(0)" ::: "memory"); __builtin_amdgcn_s_barrier(); asm volatile("" ::: "memory"); }
template <int HD> struct Stage { u32x4 k[HD / 64], v[HD / 64]; };
template <int HD> __device__ __forceinline__ void tile_load(Stage<HD>& s, const bf16* Kb, const bf16* Vb, int pitch, int kv0, int wid, int lane) {
#pragma unroll
    for (int i = 0; i < HD / 64; ++i) { const int p = wid + 8 * i;
        s.k[i] = *(const u32x4*)(Kb + (size_t)(kv0 + lane) * pitch + p * 8);
        s.v[i] = *(const u32x4*)(Vb + (size_t)(kv0 + 16 * (p & 3) + (lane >> 2)) * pitch + (p >> 2) * 32 + (lane & 3) * 8); }
}
template <int HD> __device__ __forceinline__ void tile_store(const Stage<HD>& s, ALAS char* lds, int slot, int wid, int lane) {
#pragma unroll
    for (int i = 0; i < HD / 64; ++i) { const int p = wid + 8 * i;
        *(ALAS u32x4*)(lds + LDS_K + slot * KSLOT + p * 1024 + lane * 16) = s.k[i];
        *(ALAS u32x4*)(lds + LDS_V + slot * VSLOT + p * 1024 + lane * 16) = s.v[i]; }
}
template <int HD> __device__ __forceinline__ void qkt(f32x16& p0, f32x16& p1, const ALAS char* Kslot, const bf16x8* qr, int r32, int hi) {
    const ALAS char* kb = Kslot + hi * 1024 + r32 * 16;
#pragma unroll
    for (int r = 0; r < 16; ++r) { p0[r] = 0.f; p1[r] = 0.f; }
#pragma unroll
    for (int h0 = 0; h0 < HD / 16; h0 += 4) {
        bf16x8 kf[8];
#pragma unroll
        for (int d = 0; d < 4; ++d) { kf[2 * d] = *(const ALAS bf16x8*)(kb + (h0 + d) * 2048); kf[2 * d + 1] = *(const ALAS bf16x8*)(kb + (h0 + d) * 2048 + 512); }
        __builtin_amdgcn_sched_barrier(0);
#pragma unroll
        for (int d = 0; d < 4; ++d) { p0 = __builtin_amdgcn_mfma_f32_32x32x16_bf16(kf[2 * d], qr[h0 + d], p0, 0, 0, 0); p1 = __builtin_amdgcn_mfma_f32_32x32x16_bf16(kf[2 * d + 1], qr[h0 + d], p1, 0, 0, 0); }
        __builtin_amdgcn_sched_barrier(0);
    }
}
template <int HD> __device__ __forceinline__ void pvT(f32x16* oT, const ALAS char* Vslot, const u32x4* pw, int lane) {
    const int hi = lane >> 5;
    const ALAS char* vb = Vslot + ((lane >> 4) & 1) * 32 + (lane & 3) * 8 + (4 * hi + ((lane & 15) >> 2)) * 64;
#pragma unroll
    for (int dd = 0; dd < HD / 32; dd += 2) {
        s16x4 lo[2][4], h4[2][4];
#pragma unroll
        for (int e = 0; e < 2; ++e)
#pragma unroll
            for (int ks = 0; ks < 4; ++ks) { lo[e][ks] = vtr(vb + (dd + e) * 4096 + ks * 1024); h4[e][ks] = vtr(vb + (dd + e) * 4096 + ks * 1024 + 512); }
        __builtin_amdgcn_sched_barrier(0);
#pragma unroll
        for (int ks = 0; ks < 4; ++ks)
#pragma unroll
            for (int e = 0; e < 2; ++e) {
                const bf16x8 vf = (bf16x8){lo[e][ks][0], lo[e][ks][1], lo[e][ks][2], lo[e][ks][3], h4[e][ks][0], h4[e][ks][1], h4[e][ks][2], h4[e][ks][3]};
                oT[dd + e] = __builtin_amdgcn_mfma_f32_32x32x16_bf16(vf, __builtin_bit_cast(bf16x8, pw[ks]), oT[dd + e], 0, 0, 0); }
        __builtin_amdgcn_sched_barrier(0);
    }
}
__device__ __forceinline__ void pack_p(u32x4* pw, const f32x16& p0, const f32x16& p1) {
#pragma unroll
    for (int i = 0; i < 4; ++i) { pw[0][i] = cvtpk(p0[2 * i], p0[2 * i + 1]); pw[1][i] = cvtpk(p0[8 + 2 * i], p0[9 + 2 * i]); pw[2][i] = cvtpk(p1[2 * i], p1[2 * i + 1]); pw[3][i] = cvtpk(p1[8 + 2 * i], p1[9 + 2 * i]); }
}
__device__ __forceinline__ void sb_tile(f32x16& p0, f32x16& p1, float& Pc, bool masked, int qpos, int kv0, int hi) {
    float gm[32];
#pragma unroll
    for (int r = 0; r < 32; ++r) { const float z = fminf(r < 16 ? p0[r] : p1[r - 16], 100.f);
        const float e = __builtin_amdgcn_exp2f(z); float g = __builtin_amdgcn_rcpf(1.f + e), bt = e * g;
        if (masked) { const int kv = kv0 + crow(r & 15, hi) + (r >> 4) * 32; const bool ok = kv < qpos; g = ok ? g : 1.f; bt = ok ? bt : 0.f; }
        gm[r] = g; if (r < 16) p0[r] = bt; else p1[r - 16] = bt; }
    float suf[9]; suf[8] = 1.f;
#pragma unroll
    for (int g = 7; g >= 0; --g) suf[g] = suf[g + 1] * ((gm[4 * g] * gm[4 * g + 1]) * (gm[4 * g + 2] * gm[4 * g + 3]));
    float psuf[9]; psuf[8] = 1.f;
#pragma unroll
    for (int g = 0; g < 8; ++g) psuf[g] = xhalf(suf[g]);
#pragma unroll
    for (int g = 0; g < 8; ++g) {
        float run = Pc * suf[g + 1] * (hi ? psuf[g + 1] : psuf[g]);
#pragma unroll
        for (int i = 3; i >= 0; --i) { const int r = 4 * g + i;
            if (r < 16) p0[r] *= run; else p1[r - 16] *= run;
            run *= gm[r]; } }
    Pc *= suf[0] * psuf[0];
}

template <int MODE, int ND> __device__ __forceinline__ void soft_tile_(f32x16& p0, f32x16& p1, float& m, float& l, f32x16 (&oT)[ND], float slope, int qpos, int kv0, int hi) {
    float rm = -1e30f;
    if (MODE == SWA) {
#pragma unroll
        for (int r = 0; r < 32; ++r) { const int kv = kv0 + crow(r & 15, hi) + (r >> 4) * 32; const int dist = qpos - kv; const bool valid = dist >= 0 && dist < 128;
            const float z = (r < 16 ? p0[r] : p1[r - 16]) - slope * (float)dist; const float zz = valid ? z : -1e30f;
            if (r < 16) p0[r] = zz; else p1[r - 16] = zz; rm = fmaxf(rm, zz); }
    } else {
#pragma unroll
        for (int r = 0; r < 16; ++r) rm = fmaxf(rm, fmaxf(p0[r], p1[r]));
    }
    rm = fmaxf(rm, xhalf(rm));
    const float mn = fmaxf(m, rm), f = __builtin_amdgcn_exp2f(m - mn); m = mn;
    float ps = 0.f;
#pragma unroll
    for (int r = 0; r < 16; ++r) { p0[r] = __builtin_amdgcn_exp2f(p0[r] - mn); p1[r] = __builtin_amdgcn_exp2f(p1[r] - mn); ps += p0[r] + p1[r]; }
    ps += xhalf(ps);
    l = l * f + ps;
#pragma unroll
    for (int d0 = 0; d0 < ND; ++d0)
#pragma unroll
        for (int r = 0; r < 16; ++r) oT[d0][r] *= f;
}
template <int MODE> __device__ __forceinline__ void soft_tile(f32x16& p0, f32x16& p1, float& m, float& l, f32x16 (&oT)[2], float slope, int qpos, int kv0, int hi) { soft_tile_<MODE, 2>(p0, p1, m, l, oT, slope, qpos, kv0, hi); }
template <int MODE> __device__ __forceinline__ void soft_tile(f32x16& p0, f32x16& p1, float& m, float& l, f32x16 (&oT)[4], float slope, int qpos, int kv0, int hi) { soft_tile_<MODE, 4>(p0, p1, m, l, oT, slope, qpos, kv0, hi); }

struct Params { const bf16* projb; const bf16* mkvb; const float* sinks; unsigned char* osb; unsigned char* osw; unsigned char* om; };

template <int MODE> __device__ __forceinline__ void unit(ALAS char* lds, const Params& P, int b, int h, int qb, const int wid) {
    constexpr int HD = (MODE == MEM) ? 128 : 64;
    const int tid = otid(wid), lane = tid & 63, r32 = lane & 31, hi = lane >> 5;
    const int hq = (MODE == SWA) ? 4 * h + (wid >> 1) : h;
    const int q0 = (MODE == SWA) ? qb * 64 : qb * 256, qw0 = (MODE == SWA) ? q0 + 32 * (wid & 1) : q0 + 32 * wid, qpos = qw0 + r32;
    const bf16* Qb; const bf16* Kb; const bf16* Vb; unsigned char* Ob; int kpitch;
    if (MODE == SB)       { Qb = P.projb + (size_t)b * SEQ * IN_COLS + OFF_QSB + h * 64; Kb = P.projb + (size_t)b * SEQ * IN_COLS + OFF_KSB + h * 64; Vb = P.projb + (size_t)b * SEQ * IN_COLS + OFF_VSB + h * 64; Ob = P.osb + (size_t)b * SEQ * 512 + h * 64; kpitch = IN_COLS; }
    else if (MODE == SWA) { Qb = P.projb + (size_t)b * SEQ * IN_COLS + OFF_QSW + hq * 64; Kb = P.projb + (size_t)b * SEQ * IN_COLS + OFF_KSW + h * 64; Vb = P.projb + (size_t)b * SEQ * IN_COLS + OFF_VSW + h * 64; Ob = P.osw + (size_t)b * SEQ * 512 + hq * 64; kpitch = IN_COLS; }
    else                  { Qb = P.projb + (size_t)b * SEQ * IN_COLS + OFF_QM + h * 128; Kb = P.mkvb + (size_t)b * MEM_LEN * 1024 + h * 128; Vb = P.mkvb + (size_t)b * MEM_LEN * 1024 + 512 + h * 128; Ob = P.om + (size_t)b * SEQ * 512 + h * 128; kpitch = 1024; }
    int jlo, jhi;
    if (MODE == SB) { jlo = 0; jhi = 4 * qb + 3; } else if (MODE == SWA) { jlo = qb - 2; if (jlo < 0) jlo = 0; jhi = qb; } else { jlo = 0; jhi = 3; }
    const int ntile = jhi - jlo + 1, dj = (MODE == SB) ? -1 : 1, jfirst = (MODE == SB) ? jhi : jlo;
    Stage<HD> stA, stB;
    tile_load<HD>(stA, Kb, Vb, kpitch, jfirst * 64, wid, lane);
    tile_load<HD>(stB, Kb, Vb, kpitch, (jfirst + (ntile > 1 ? dj : 0)) * 64, wid, lane);
    bf16x8 qr[HD / 16];
#pragma unroll
    for (int d0 = 0; d0 < HD / 16; ++d0) qr[d0] = *(const bf16x8*)(Qb + (size_t)qpos * IN_COLS + d0 * 16 + hi * 8);
    f32x16 oT[HD / 32];
#pragma unroll
    for (int d0 = 0; d0 < HD / 32; ++d0)
#pragma unroll
        for (int r = 0; r < 16; ++r) oT[d0][r] = 0.f;
    float C = 1.f;
    float m = (MODE == SWA) ? P.sinks[hq] * LOG2E : -1e30f, l = (MODE == SWA) ? 1.f : 0.f;
    const float slope = (MODE == SWA) ? exp2f(-(float)(hq + 1)) * LOG2E : 0.f;
    tile_store<HD>(stA, lds, 0, wid, lane);
#pragma unroll
    for (int d0 = 0; d0 < HD / 16; ++d0) asm volatile("" : "+v"(qr[d0]));
    att_bar();
    bool stop = false;
    ALAS unsigned* dflag = (ALAS unsigned*)(lds + LDS_FLAG + 64);
#define ATT_STEP(it, SLOT, ST_LOAD, ST_STORE) do { \
        const int j = jfirst + (it) * dj, kv0 = j * 64; \
        tile_load<HD>(ST_LOAD, Kb, Vb, kpitch, ((it) + 2 < ntile ? j + 2 * dj : j) * 64, wid, lane);     \
        bool active = true; \
        if (MODE == SB) active = (kv0 <= qw0 + 30) && !__all(C == 0.f);     \
        else if (MODE == SWA) active = (kv0 <= qw0 + 31) && (kv0 + 63 >= qw0 - 127); \
        if (active) { \
            f32x16 p0, p1; \
            qkt<HD>(p0, p1, lds + LDS_K + (SLOT) * KSLOT, qr, r32, hi); \
            if (MODE == SB) { sb_tile(p0, p1, C, kv0 + 63 >= qw0, qpos, kv0, hi); } \
            else { soft_tile<MODE>(p0, p1, m, l, oT, slope, qpos, kv0, hi); } \
            u32x4 pw[4]; pack_p(pw, p0, p1); \
            pvT<HD>(oT, lds + LDS_V + (SLOT) * VSLOT, pw, lane); \
        } \
        tile_store<HD>(ST_STORE, lds, (SLOT) ^ 1, wid, lane); \
        if (MODE == SB) { const int wdone = __all(C == 0.f) ? 1 : 0; if (lane == 0) dflag[((it) & 1) * 8 + wid] = (unsigned)wdone; \
                          att_bar(); \
                          const ALAS u32x4* df = (const ALAS u32x4*)(dflag + ((it) & 1) * 8); const u32x4 f0 = df[0], f1 = df[1]; \
                          if ((f0.x & f0.y & f0.z & f0.w & f1.x & f1.y & f1.z & f1.w) != 0u) stop = true; } \
        else att_bar(); \
    } while (0)
    for (int it = 0; it < ntile && !stop; it += 2) {
        ATT_STEP(it, 0, stA, stB);
        if (stop || it + 1 >= ntile) break;
        ATT_STEP(it + 1, 1, stB, stA);
    }
#undef ATT_STEP
    const float inv = (MODE == SB) ? O8_SCALE : O8_SCALE / l;
    unsigned char* orow = Ob + (size_t)qpos * 512 + 32 * hi;
#pragma unroll
    for (int dp = 0; dp < HD / 64; ++dp) { u32x4 w0, w1; unsigned pk[8];
#pragma unroll
        for (int g = 0; g < 4; ++g) {
            const unsigned P_ = pack4_e4m3(oT[2 * dp][4 * g] * inv, oT[2 * dp][4 * g + 1] * inv, oT[2 * dp][4 * g + 2] * inv, oT[2 * dp][4 * g + 3] * inv);
            const unsigned Q_ = pack4_e4m3(oT[2 * dp + 1][4 * g] * inv, oT[2 * dp + 1][4 * g + 1] * inv, oT[2 * dp + 1][4 * g + 2] * inv, oT[2 * dp + 1][4 * g + 3] * inv);
            const auto sw = __builtin_amdgcn_permlane32_swap(P_, Q_, false, false);
            pk[2 * g] = sw[0]; pk[2 * g + 1] = sw[1]; }
        w0.x = pk[0]; w0.y = pk[1]; w0.z = pk[2]; w0.w = pk[3]; w1.x = pk[4]; w1.y = pk[5]; w1.z = pk[6]; w1.w = pk[7];
        *(u32x4*)(orow + 64 * dp) = w0; *(u32x4*)(orow + 64 * dp + 16) = w1; }
}

constexpr int NUNITS = 2560;
__device__ __forceinline__ void phase(ALAS char* lds, const Params& P, unsigned* queue, int ulo, int uhi, const int wave) {
    volatile ALAS int* flag = (volatile ALAS int*)(lds + LDS_FLAG);
    if (is_t0(wave)) { flag[0] = (int)atomicAdd(queue, 1u); }
    __syncthreads();
    int u = ulo + flag[0];
    for (int k = 0;; ++k) {
        if (u >= uhi) break;
        int tnext = 0; if (is_t0(wave)) tnext = (int)atomicAdd(queue, 1u);
        if (u < 512) { const int qb = u >> 5, bh = u & 31; unit<MEM>(lds, P, bh >> 2, bh & 3, qb, wave); }
        else if (u < 1536) { const int v = u - 512, qb = 15 - (v >> 6), bh = v & 63; unit<SB>(lds, P, bh >> 3, bh & 7, qb, wave); }
        else { const int v = u - 1536, qb = v >> 4, bh = v & 15; unit<SWA>(lds, P, bh >> 1, bh & 1, qb, wave); }
        if (is_t0(wave)) flag[(k + 1) & 1] = tnext;
        __syncthreads();
        u = ulo + flag[(k + 1) & 1];
    }
}
}
constexpr int NWAVES = 8;
constexpr int RING_BYTES = 131072, LDSCTL_OFF = RING_BYTES, MISC_OFF = LDSCTL_OFF + 320, BIAS_OFF = RING_BYTES + 1024  , LDS_BYTES = 147456;
constexpr int NPHASE = 12;
#ifndef CONV_CONTIG
#define CONV_CONTIG 0
#endif
#ifndef NCONV_WG
#define NCONV_WG 88
#endif
constexpr int NCONV = NCONV_WG;
#define GAS __attribute__((address_space(1)))
#define LAS __attribute__((address_space(3)))

#define XB_TMO      128
#define XB_XCNT(j)  (256  + 64 * (j))
#define XB_XSUB(j)  (1280 + 64 * (j))
#define XB_XGEN(j)  (2304 + 64 * (j))
#define XB_TOP      3328
#define XB_TOPGEN   3392
#define XCD_BAR_WORDS 3456
#define XB_SPIN_CAP (1u << 18)
__device__ __forceinline__ unsigned xb_ld(unsigned* p)              { return __hip_atomic_load(p, __ATOMIC_RELAXED, __HIP_MEMORY_SCOPE_AGENT); }
__device__ __forceinline__ unsigned xb_add(unsigned* p, unsigned v) { return __hip_atomic_fetch_add(p, v, __ATOMIC_RELAXED, __HIP_MEMORY_SCOPE_AGENT); }
__device__ __forceinline__ unsigned xb_xcc_id() { return (unsigned)__builtin_amdgcn_s_getreg((3 << 11) | 20) & 0xFu; }
#define XB_SPIN(cond, bar) do { unsigned _sp = 0; while (cond) { __builtin_amdgcn_s_sleep(1); \
    if ((++_sp & 255u) == 0u) { if (xb_ld(&(bar)[XB_TMO])) break; if (_sp > XB_SPIN_CAP) { atomicAdd(&(bar)[XB_TMO], 1u); break; } } } } while (0)
struct XcdBarrier { unsigned* bar; unsigned x; volatile LAS unsigned* st; int wave; };
__device__ __forceinline__ XcdBarrier xcd_barrier_post(unsigned* bar, volatile LAS unsigned* st, int wave) {
    XcdBarrier b; b.bar = bar; b.x = xb_xcc_id(); b.st = st; b.wave = wave;
    if (is_t0(wave)) (void)xb_add(&bar[XB_XCNT(b.x)], 1u);
    return b;
}
__device__ __forceinline__ void xcd_barrier_complete(unsigned* bar, unsigned x, unsigned& nloc, unsigned& nx) {
    const unsigned G = gridDim.x * gridDim.y * gridDim.z;
    unsigned sum, cnt, mine, sp = 0u;
    for (;;) {
        sum = 0u; cnt = 0u; mine = 0u;
#pragma unroll
        for (unsigned j = 0; j < 16; ++j) { const unsigned c = xb_ld(&bar[XB_XCNT(j)]); sum += c; cnt += (c > 0u) ? 1u : 0u; mine = (j == x) ? c : mine; }
        if (sum == G) break;
        __builtin_amdgcn_s_sleep(1);
        if ((++sp & 255u) == 0u) { if (xb_ld(&bar[XB_TMO])) break; if (sp > XB_SPIN_CAP) { atomicAdd(&bar[XB_TMO], 1u); break; } }
    }
    nloc = mine > 0u ? mine : 1u; nx = cnt > 0u ? cnt : 1u;
}
__device__ __forceinline__ void xcd_barrier(const XcdBarrier& b) {
    asm volatile("s_waitcnt vmcnt(0)" ::: "memory");
    __syncthreads();
    if (is_t0(b.wave)) {
        unsigned* bar = b.bar;
        __builtin_amdgcn_s_waitcnt(0);
        unsigned nloc = b.st[0], nx = b.st[1];
        if (nloc == 0u) { xcd_barrier_complete(bar, b.x, nloc, nx); b.st[0] = nloc; b.st[1] = nx; }
        const unsigned old = xb_add(&bar[XB_XSUB(b.x)], 1u);
        const unsigned gen = old / nloc;
        if (old + 1u == (gen + 1u) * nloc) {
            __builtin_amdgcn_fence(__ATOMIC_RELEASE, "agent");
            asm volatile("s_waitcnt vmcnt(0)" ::: "memory");
            const unsigned og = xb_add(&bar[XB_TOP], 1u);
            const unsigned tg = og / nx;
            if (og + 1u == (tg + 1u) * nx) xb_add(&bar[XB_TOPGEN], 1u);
            else XB_SPIN(xb_ld(&bar[XB_TOPGEN]) == tg, bar);
            __builtin_amdgcn_fence(__ATOMIC_ACQUIRE, "agent");
            xb_add(&bar[XB_XGEN(b.x)], 1u);
            asm volatile("s_waitcnt vmcnt(0)" ::: "memory");
        } else {
            XB_SPIN(xb_ld(&bar[XB_XGEN(b.x)]) == gen, bar);
            __builtin_amdgcn_fence(__ATOMIC_ACQUIRE, "agent");
            asm volatile("s_waitcnt vmcnt(0)" ::: "memory");
        }
    }
    __syncthreads();
}

struct TrItem { f32x4 v[8]; bf16* dst; int K; unsigned char* dst8; };
__device__ __forceinline__ void tr_issue(TrItem& t, const float* W, int K, int N, bf16* WT, int dst_row0, int k0, int n0, int lane, unsigned char* WT8 = nullptr) {
    const float* wp = W + (size_t)(k0 + (lane >> 3)) * N + n0 + 4 * (lane & 7);
#pragma unroll
    for (int i = 0; i < 8; ++i) t.v[i] = __builtin_nontemporal_load((const f32x4*)(wp + (size_t)(8 * i) * N));
    t.dst = WT + (size_t)dst_row0 * K + k0; t.K = K; t.dst8 = WT8 ? WT8 + (size_t)dst_row0 * K + k0 : nullptr;
}
__device__ __forceinline__ void tr_finish(const TrItem& t, LAS float* scr, int lane) {
#pragma unroll
    for (int i = 0; i < 8; ++i) { LAS float* p = scr + (8 * i + (lane >> 3)) * 33 + 4 * (lane & 7); p[0] = t.v[i][0]; p[1] = t.v[i][1]; p[2] = t.v[i][2]; p[3] = t.v[i][3]; }
    asm volatile("s_waitcnt lgkmcnt(0)" ::: "memory");
    const int c = lane & 7;
    if (t.dst8) {
#pragma unroll
        for (int j = 0; j < 4; ++j) { const int n = (lane >> 3) + 8 * j; const LAS float* s = scr + (8 * c) * 33 + n;
            u32x2 o; o.x = pack4_e4m3(s[0 * 33] * W8_SCALE, s[1 * 33] * W8_SCALE, s[2 * 33] * W8_SCALE, s[3 * 33] * W8_SCALE); o.y = pack4_e4m3(s[4 * 33] * W8_SCALE, s[5 * 33] * W8_SCALE, s[6 * 33] * W8_SCALE, s[7 * 33] * W8_SCALE);
            __builtin_nontemporal_store(o, (u32x2*)(t.dst8 + (size_t)n * t.K + 8 * c)); }
    } else {
#pragma unroll
    for (int j = 0; j < 4; ++j) { const int n = (lane >> 3) + 8 * j; const LAS float* s = scr + (8 * c) * 33 + n;
        u32x4 o; o.x = pk2(s[0 * 33], s[1 * 33]); o.y = pk2(s[2 * 33], s[3 * 33]); o.z = pk2(s[4 * 33], s[5 * 33]); o.w = pk2(s[6 * 33], s[7 * 33]);
        __builtin_nontemporal_store(o, (u32x4*)(t.dst + (size_t)n * t.K + 8 * c)); }
    }
    asm volatile("s_waitcnt lgkmcnt(0)" ::: "memory");
}
__device__ __forceinline__ void p0_transpose_item(const float* W, int K, int N, bf16* WT, int dst_row0, LAS float* scr, int k0, int n0, int lane, unsigned char* WT8 = nullptr) {
    TrItem t; tr_issue(t, W, K, N, WT, dst_row0, k0, n0, lane, WT8); tr_finish(t, scr, lane);
}
__device__ __forceinline__ int map_gu(int n0) { return n0 < EFF ? 256 * (n0 >> 7) + (n0 & 127) : 256 * ((n0 - EFF) >> 7) + 128 + ((n0 - EFF) & 127); }

struct Args {
    const float *x, *mem, *w_in, *b_gate, *w_mem_kv, *sinks, *w_o_sb, *w_o_swa, *w_o_mem, *w_out, *ln1_g, *ln1_b, *w_router, *router_bias, *w_e_gu, *w_e_down, *w_s_gu, *w_s_down, *ln2_g, *ln2_b;
    float* out; unsigned char* ws; int ph_lo, ph_hi, li, pad;
};

__global__ void __launch_bounds__(NWAVES * 64, 2) mega_fwd(Args a) {
    extern __shared__ __attribute__((aligned(16))) unsigned char lds_raw[];
    LAS unsigned char* lds = (LAS unsigned char*)lds_raw;
    volatile LAS unsigned* MISC = (volatile LAS unsigned*)(lds + MISC_OFF);
    const int wave = __builtin_amdgcn_readfirstlane((int)threadIdx.x >> 6);
    const int G = gridDim.x, bx = blockIdx.x;
    const int vcu = (G % 8 == 0) ? (bx % 8) * (G / 8) + bx / 8 : bx;
    const int gw = vcu * NWAVES + wave, NGW = G * NWAVES;
    unsigned char* ws = a.ws;
    unsigned* ctl = (unsigned*)(ws + WS_CTL);
    for (int u = otid(wave); u < (LDS_BYTES - LDSCTL_OFF) / 4; u += NWAVES * 64) ((LAS unsigned*)(lds + LDSCTL_OFF))[u] = 0u;
    __syncthreads();
    XcdBarrier bar = xcd_barrier_post(ctl + CW_BAR + a.li * XCD_BAR_WORDS, MISC + 8, wave);
    const int lo = a.ph_lo, hi = a.ph_hi;
#define IN(k) (lo <= (k) && (k) < hi)
#define SEAM(k) do { if (IN(k) && IN((k) + 1)) xcd_barrier(bar); } while (0)
#define PH_BEGIN(k) if (IN(k)) { const int tid = otid(wave), lane = tid & 63; (void)tid; (void)lane;
#define PH_END(k) } SEAM(k);
    bf16* WIN_T = (bf16*)(ws + WS_WIN_T); bf16* WMKV_T = (bf16*)(ws + WS_WMKV_T); bf16* WOSB_T = (bf16*)(ws + WS_WOSB_T); bf16* WOSW_T = (bf16*)(ws + WS_WOSW_T); bf16* WOM_T = (bf16*)(ws + WS_WOM_T);
    bf16* WOUT_T = (bf16*)(ws + WS_WOUT_T); bf16* WRS_T = (bf16*)(ws + WS_WRS_T); bf16* WSD_T = (bf16*)(ws + WS_WSD_T); bf16* WEGU_T = (bf16*)(ws + WS_WEGU_T); bf16* WED_T = (bf16*)(ws + WS_WED_T);
    bf16* XB = (bf16*)(ws + WS_XB); bf16* MEMB = (bf16*)(ws + WS_MEMB); bf16* MKVB = (bf16*)(ws + WS_MKVB); bf16* PROJB = (bf16*)(ws + WS_PROJB);
    bf16* OSB = (bf16*)(ws + WS_OSB); bf16* OSW = (bf16*)(ws + WS_OSW); bf16* OM = (bf16*)(ws + WS_OM); bf16* MERGED = (bf16*)(ws + WS_MERGED);
    bf16* Z = (bf16*)(ws + WS_Z); bf16* X1B = (bf16*)(ws + WS_X1B); float* LOGITS = (float*)(ws + WS_LOGITS); bf16* HS = (bf16*)(ws + WS_HS); bf16* SHOUT = (bf16*)(ws + WS_SHOUT);
    int* IDX = (int*)(ws + WS_ROUTE + RT_IDX); float* WGT = (float*)(ws + WS_ROUTE + RT_WGT); int* POS = (int*)(ws + WS_ROUTE + RT_POS); int* STOK = (int*)(ws + WS_ROUTE + RT_STOK);
    int* TILES = (int*)(ws + WS_ROUTE + RT_TILES); int* TILES64 = (int*)(ws + WS_ROUTE + RT_TILES64);
    unsigned char* XB8 = ws + WS_XB8; unsigned char* X1B8 = ws + WS_X1B8; unsigned char* WG8_T = ws + WS_WG8_T;
    bf16* HBUF = (bf16*)(ws + WS_HBUF); unsigned char* YS = (unsigned char*)(ws + WS_YS);

    PH_BEGIN(0)
        LAS float* scr = (LAS float*)(lds + wave * 16384);
        constexpr int I_IN = 16 * 184, I_MKV = 16 * 32, I_O = 8 * 32, I_OUT = 16 * 32, I_SGU = 16 * 16, I_R = 16 * 8, I_SD = 4 * 32, I_EGU = 16 * 16, I_ED = 4 * 32;
        constexpr int SMALL = I_IN + I_MKV + 3 * I_O + I_OUT + I_SGU + I_R + I_SD, NITEMS = SMALL;
        for (int it = gw; it < SMALL; it += NGW) {
            int r = it;
            if (r < I_IN) { const int nb = r % 184, kb = r / 184;
                if (nb < 88) p0_transpose_item(a.w_in, D, IN_COLS, WIN_T, 32 * nb, scr, 64 * kb, 32 * nb, lane);
                else p0_transpose_item(a.w_in, D, IN_COLS, WIN_T, 32 * (nb - 88), scr, 64 * kb, 32 * nb, lane, WG8_T);
                continue; } r -= I_IN;
            if (r < I_MKV) { p0_transpose_item(a.w_mem_kv, D, 1024, WMKV_T, 32 * (r % 32), scr, 64 * (r / 32), 32 * (r % 32), lane); continue; } r -= I_MKV;
            if (r < I_O) { p0_transpose_item(a.w_o_sb, 512, D, WOSB_T, 32 * (r % 32), scr, 64 * (r / 32), 32 * (r % 32), lane, (unsigned char*)WOSB_T); continue; } r -= I_O;
            if (r < I_O) { p0_transpose_item(a.w_o_swa, 512, D, WOSW_T, 32 * (r % 32), scr, 64 * (r / 32), 32 * (r % 32), lane, (unsigned char*)WOSW_T); continue; } r -= I_O;
            if (r < I_O) { p0_transpose_item(a.w_o_mem, 512, D, WOM_T, 32 * (r % 32), scr, 64 * (r / 32), 32 * (r % 32), lane, (unsigned char*)WOM_T); continue; } r -= I_O;
            if (r < I_OUT) { p0_transpose_item(a.w_out, D, D, WOUT_T, 32 * (r % 32), scr, 64 * (r / 32), 32 * (r % 32), lane, (unsigned char*)WOUT_T); continue; } r -= I_OUT;
            if (r < I_SGU) { p0_transpose_item(a.w_s_gu, D, 512, WRS_T, map_gu(32 * (r % 16)), scr, 64 * (r / 16), 32 * (r % 16), lane, (unsigned char*)WRS_T); continue; } r -= I_SGU;
            if (r < I_R) { p0_transpose_item(a.w_router, D, NE, WRS_T, 512 + 32 * (r % 8), scr, 64 * (r / 8), 32 * (r % 8), lane); continue; } r -= I_R;
            p0_transpose_item(a.w_s_down, EFF, D, WSD_T, 32 * (r % 32), scr, 64 * (r / 32), 32 * (r % 32), lane, (unsigned char*)WSD_T);
        }
        thin::cvt_rows(a.x, XB, XB8, T, gw, NGW, lane);
        thin::cvt_rows(a.mem, MEMB, nullptr, MROWS, gw, NGW, lane);
    PH_END(0)
    PH_BEGIN(1)
        const int GG = G - NCONV;
        if (bx >= GG) {
            LAS float* scr = (LAS float*)(lds + wave * 16384);
            constexpr int I_EGU = 16 * 16, I_ED = 4 * 32;
            const int cw = (bx - GG) * NWAVES + wave, ncw = NCONV * NWAVES;
            constexpr int NIT = NE * (I_EGU + I_ED);
#define EXP_ISSUE(t, r_) do { const int ri_ = (r_) < NIT ? (r_) : rlast;     \
                const bool gu = ri_ < NE * I_EGU; const int r2 = gu ? ri_ : ri_ - NE * I_EGU; const int per = gu ? I_EGU : I_ED, nbs = gu ? 16 : 32; \
                const int e = r2 / per, q = r2 % per, kb = q / nbs, nb = q % nbs; \
                const float* W = gu ? a.w_e_gu + (size_t)e * D * 512 : a.w_e_down + (size_t)e * EFF * D; \
                unsigned char* W8 = gu ? (unsigned char*)WEGU_T + (size_t)e * 512 * D : (unsigned char*)WED_T + (size_t)e * D * EFF; \
                tr_issue(t, W, gu ? D : EFF, gu ? 512 : D, WEGU_T, gu ? map_gu(32 * nb) : 32 * nb, 64 * kb, 32 * nb, lane, W8); } while (0)
            TrItem tA, tB, tC;
            const int nmine = (NIT - cw + ncw - 1) / ncw, rlast = cw + (nmine - 1) * ncw;
            int r = cw;
            EXP_ISSUE(tA, r); EXP_ISSUE(tB, r + ncw);
            for (; r < NIT; r += 3 * ncw) {
                EXP_ISSUE(tC, r + 2 * ncw); tr_finish(tA, scr, lane);
                EXP_ISSUE(tA, r + 3 * ncw); tr_finish(tB, scr, lane);
                EXP_ISSUE(tB, r + 4 * ncw); tr_finish(tC, scr, lane);
            }
#undef EXP_ISSUE
        } else {
        LAS float* bias_lds = (LAS float*)(lds + BIAS_OFF);
        for (int i = tid; i < 3 * D; i += NWAVES * 64) bias_lds[i] = a.b_gate[i] * -LOG2E - LOG2_255;
        __syncthreads();
        { pg8::GridOrder S; S.init(T, OFF_GATE, D, GG, bx, 1); S.A0 = (unsigned)WS_XB; S.B0 = (unsigned)WS_WIN_T;
          pg8::EpiProj E{PROJB};
          pg8::gemm_phase<pg8::EpiProj, pg8::GridOrder, false>(lds, ws, D, S, E, wave); }
        { pg8::GridOrder S; S.init(T, 3 * D, D / 2, GG, (bx + GG - 64) % GG, 1); S.A0 = (unsigned)WS_XB8; S.B0 = (unsigned)WS_WG8_T;
          pg8::EpiGate8 E{bias_lds, ws + WS_GT};
          pg8::gemm_phase<pg8::EpiGate8, pg8::GridOrder, false, false, true>(lds, ws, D / 2, S, E, wave); }
        { pg8::GridOrder S; S.init(MROWS, 1024, D, GG, GG - 1 - bx, 1); S.A0 = (unsigned)WS_MEMB; S.B0 = (unsigned)WS_WMKV_T;
          pg8::EpiBf16 E{MKVB, 1024, 1.f};
          pg8::gemm_phase<pg8::EpiBf16, pg8::GridOrder, false>(lds, ws, D, S, E, wave); }
        }
    PH_END(1)
    PH_BEGIN(2)
        const att::Params P{PROJB, MKVB, a.sinks, (unsigned char*)OSB, (unsigned char*)OSW, (unsigned char*)OM};
        att::phase((LAS char*)lds, P, ctl + CW_QUEUE + 64 * (a.li & 15), a.pad == 1 ? 512 : (a.pad == 2 ? 1536 : 0), a.pad == 3 ? 512 : (a.pad == 1 ? 1536 : att::NUNITS), wave);
    PH_END(2)
    PH_BEGIN(3)
        pg8::GridOrder S; S.init(T, D, 512 / 2, G, bx, 3);
        S.A0 = (unsigned)WS_OSB; S.B0 = (unsigned)WS_WOSB_T; S.asub = (unsigned)(WS_OSW - WS_OSB); S.bsub = (unsigned)(WS_WOSW_T - WS_WOSB_T);
        pg8::EpiOutProj E{(unsigned char*)MERGED, (const u32x2*)(ws + WS_GT)};
        pg8::gemm_phase<pg8::EpiOutProj, pg8::GridOrder, false, false, true>(lds, ws, 512 / 2, S, E, wave);
    PH_END(3)
    PH_BEGIN(4)
        pg8::GridOrder S; S.init(T, D, D / 2, G, bx, 1); S.A0 = (unsigned)WS_MERGED; S.B0 = (unsigned)WS_WOUT_T;
        pg8::EpiY E{Z, XB};
        pg8::gemm_phase<pg8::EpiY, pg8::GridOrder, false, false, true>(lds, ws, D / 2, S, E, wave);
    PH_END(4)
    PH_BEGIN(5) thin::ln1_rows(Z, a.ln1_g, a.ln1_b, X1B, X1B8, gw, NGW, lane); PH_END(5)
    PH_BEGIN(6)
        const bool split = (G % 16 == 0); const int Gs = split ? G / 2 : G, cs = split ? (((bx >> 4) << 3) | (bx & 7)) : bx, side = (bx >> 3) & 1;
        if (!split || side == 0) { pg8::GridOrder S; S.init(T, NE, D, Gs, cs, 1); S.A0 = (unsigned)WS_X1B; S.B0 = (unsigned)(WS_WRS_T + (size_t)512 * D * 2);
            pg8::EpiRouter E{LOGITS};
            pg8::gemm_phase<pg8::EpiRouter, pg8::GridOrder, false>(lds, ws, D, S, E, wave); }
        if (!split || side == 1) { pg8::GridOrder S; S.init(T, 2 * EFF, D / 2, Gs, cs, 1); S.A0 = (unsigned)WS_X1B8; S.B0 = (unsigned)WS_WRS_T;
            pg8::EpiShared8 E{(unsigned char*)HS};
            pg8::gemm_phase<pg8::EpiShared8, pg8::GridOrder, false, false, true>(lds, ws, D / 2, S, E, wave); }
    PH_END(6)
    PH_BEGIN(7) thin::route(LOGITS, a.router_bias, IDX, WGT, ctl + CW_COUNTS, (LAS int*)lds, bx, G, tid); PH_END(7)
    PH_BEGIN(8) thin::scan_scatter(ctl + CW_COUNTS, ctl + CW_CURSOR, IDX, POS, STOK, TILES, TILES64, (LAS int*)lds, bx, G, tid); PH_END(8)
    PH_BEGIN(9)
        { LAS int* tab = (LAS int*)(lds + BIAS_OFF);
          const int ntiles = __builtin_amdgcn_readfirstlane(pg8::build_tile_map(ctl + CW_COUNTS, tab, tid));
          pg8::ExpertOrder S; S.offs = tab; S.cnt = tab + 256; S.tmap = (const LAS unsigned short*)(tab + 512); S.nN = 2; S.nwg = ntiles * 2; S.G = G; S.c = bx; S.A = (unsigned)WS_X1B8; S.rows = STOK; S.arow = 0; S.Bb = (unsigned)WS_WEGU_T; S.bexp = (unsigned)(512 * D); S.bstep = (unsigned)(256 * D);
          pg8::EpiExpGU8 E{(unsigned char*)HBUF};
          pg8::gemm_phase<pg8::EpiExpGU8, pg8::ExpertOrder, true, false, true>(lds, ws, D / 2, S, E, wave); }
        { pg8::GridOrder S; S.init(T, D, EFF / 2, G, bx, 1); S.A0 = (unsigned)WS_HS; S.B0 = (unsigned)WS_WSD_T;
          pg8::EpiBf16 E{SHOUT, D, 1.f / (W8_SCALE * H8_SCALE)};
          int Kh = EFF / 2; asm volatile("" : "+s"(Kh));
          pg8::gemm_phase<pg8::EpiBf16, pg8::GridOrder, false, false, true>(lds, ws, Kh, S, E, wave); }
    PH_END(9)
    PH_BEGIN(10)
        LAS int* tab = (LAS int*)(lds + BIAS_OFF);
        (void)pg8::build_tile_map(ctl + CW_COUNTS, tab, tid);
        LAS int* srt = tab + 1280;
        if (tid < NE) { const int ce = tab[256 + tid]; int rk = 0; for (int j = 0; j < NE; ++j) { const int cj = tab[256 + j]; rk += (cj > ce || (cj == ce && j < tid)) ? 1 : 0; } srt[rk] = tid; }
        __syncthreads();
        pg8::down_phase(lds, ws, tab, tab + 256, srt, G, bx, (unsigned)WS_HBUF, (unsigned)WS_WED_T, (unsigned)WS_YS, (unsigned)(WS_CTL + 768 * 1024), YS_SCALE / (W8_SCALE * H8_SCALE), wave, HYBRID ? a.pad : 0);
    PH_END(10)
    PH_BEGIN(11) thin::final_rows(X1B, SHOUT, YS, POS, WGT, a.ln2_g, a.ln2_b, a.out, gw, NGW, lane); PH_END(11)
#undef IN
#undef SEAM
#undef PH_BEGIN
#undef PH_END
}
extern "C" void kernel_launch(void* const* d_in, const int* in_sizes, int n_in, void* d_out, int out_size, void* d_ws, size_t ws_size, hipStream_t stream) {
    static int grid = 0;
    if (grid == 0) {
        if (n_in != 20 || in_sizes[0] != T * D || out_size != T * D || ws_size < WS_END) { fprintf(stderr, "kernel_launch: unexpected problem shape / workspace (%d inputs, ws %zu)\n", n_in, ws_size); grid = -1; return; }
        int dev = 0, cus = 0;
        if (hipGetDevice(&dev) != hipSuccess || hipDeviceGetAttribute(&cus, hipDeviceAttributeMultiprocessorCount, dev) != hipSuccess) { grid = -1; return; }
        if (hipFuncSetAttribute((const void*)mega_fwd, hipFuncAttributeMaxDynamicSharedMemorySize, LDS_BYTES) != hipSuccess) { fprintf(stderr, "kernel_launch: hipFuncSetAttribute failed\n"); grid = -1; return; }
        (void)hipGetLastError();
        grid = cus;
    }
    if (grid < 0) return;
    (void)hipMemsetAsync((char*)d_ws + WS_CTL, 0, CTL_ZERO_BYTES, stream);
    Args a{};
    const float** f = (const float**)&a;
    for (int i = 0; i < 20; ++i) f[i] = (const float*)d_in[i];
    a.out = (float*)d_out; a.ws = (unsigned char*)d_ws;
#if HYBRID
#ifndef PROBE_ATT_MODE
#define PROBE_ATT_MODE 0
#endif
    unsigned char* ws = (unsigned char*)d_ws;
    bf16* XB = (bf16*)(ws + WS_XB); bf16* MEMB = (bf16*)(ws + WS_MEMB); bf16* MKVB = (bf16*)(ws + WS_MKVB); bf16* PROJB = (bf16*)(ws + WS_PROJB);
    bf16* OSB = (bf16*)(ws + WS_OSB); bf16* OSW = (bf16*)(ws + WS_OSW); bf16* OM = (bf16*)(ws + WS_OM); bf16* MERGED = (bf16*)(ws + WS_MERGED);
    bf16* Z = (bf16*)(ws + WS_Z); bf16* X1B = (bf16*)(ws + WS_X1B); float* LOGITS = (float*)(ws + WS_LOGITS); bf16* HS = (bf16*)(ws + WS_HS); bf16* SHOUT = (bf16*)(ws + WS_SHOUT);
    int* STOK = (int*)(ws + WS_ROUTE + RT_STOK); int* TILES64 = (int*)(ws + WS_ROUTE + RT_TILES64);
    bf16* HBUF = (bf16*)(ws + WS_HBUF); bf16* YS = (bf16*)(ws + WS_YS);
    float* SCR = (float*)(ws + WS_YS);
    static const int opt[NPHASE] = HYBRID_OPT;
#ifdef PROBE_REPS
    static const int reps[NPHASE] = PROBE_REPS;
#else
    static const int reps[NPHASE] = {1, 1, 1, 1, 1, 1, 1, 1, 1, 1, 1, 1};
#endif
    int li = 0;
    for (int p = 0; p < NPHASE; ++p) {
        if (opt[p]) { for (int r = 0; r < reps[p]; ++r) { a.ph_lo = p; a.ph_hi = p + 1; a.li = (li++) & 15; a.pad = (r + 1 < reps[p]) ? PROBE_ATT_MODE : 0;     hipLaunchKernelGGL(mega_fwd, dim3(grid), dim3(NWAVES * 64), LDS_BYTES, stream, a); }
#ifdef ATT_DIFF_TEST
        if (p == 2 && opt[p]) {
            bf16* nsb = (bf16*)(ws + WS_YS); bf16* nsw = nsb + (size_t)T * 512; bf16* nm = nsw + (size_t)T * 512;
            nv::k_sb_attn<<<BATCH * 8 * (SEQ / 64), 64, 0, stream>>>(PROJB, nsb);
            nv::k_swa_attn<<<BATCH * 8 * (SEQ / 64), 64, 0, stream>>>(PROJB, a.sinks, nsw);
            nv::k_mem_attn<<<BATCH * 4 * 2 * (SEQ / 64), 64, 0, stream>>>(PROJB, MKVB, nm);
            unsigned* cw = (unsigned*)(ws + WS_CTL);
            nv::k_maxdiff<<<1024, 256, 0, stream>>>(OSB, nsb, (size_t)T * 512, cw + (ATT_DIFF_TEST == 1 ? 900 : 910));
            nv::k_maxdiff<<<1024, 256, 0, stream>>>(OSW, nsw, (size_t)T * 512, cw + (ATT_DIFF_TEST == 2 ? 900 : 911));
            nv::k_maxdiff<<<1024, 256, 0, stream>>>(OM, nm, (size_t)T * 512, cw + (ATT_DIFF_TEST == 3 ? 900 : 912));
        }
        if (p == NPHASE - 1) nv::k_scale_out<<<1024, 256, 0, stream>>>((float*)d_out, (size_t)T * D, (const unsigned*)(ws + WS_CTL) + 900);
#endif
            continue; }
        switch (p) {
        case 1:
            nv::k_gemm<nv::M_PROJ><<<dim3(IN_COLS / 64, T / 64), 256, 0, stream>>>(XB, D, a.w_in, IN_COLS, PROJB, IN_COLS, D, nullptr, 0, a.b_gate, nullptr);
            nv::k_gemm<nv::M_BF16><<<dim3(1024 / 64, MROWS / 64), 256, 0, stream>>>(MEMB, D, a.w_mem_kv, 1024, MKVB, 1024, D, nullptr, 0, nullptr, nullptr);
            break;
        case 2:
            nv::k_sb_attn<<<BATCH * 8 * (SEQ / 64), 64, 0, stream>>>(PROJB, OSB);
            nv::k_swa_attn<<<BATCH * 8 * (SEQ / 64), 64, 0, stream>>>(PROJB, a.sinks, OSW);
            nv::k_mem_attn<<<BATCH * 4 * 2 * (SEQ / 64), 64, 0, stream>>>(PROJB, MKVB, OM);
            break;
        case 3:
            nv::k_gemm<nv::M_GSET><<<dim3(D / 64, T / 64), 256, 0, stream>>>(OSB, 512, a.w_o_sb, D, nullptr, 0, 512, PROJB + OFF_GATE, IN_COLS, nullptr, SCR);
            nv::k_gemm<nv::M_GADD><<<dim3(D / 64, T / 64), 256, 0, stream>>>(OSW, 512, a.w_o_swa, D, nullptr, 0, 512, PROJB + OFF_GATE + D, IN_COLS, nullptr, SCR);
            nv::k_gemm<nv::M_GFIN><<<dim3(D / 64, T / 64), 256, 0, stream>>>(OM, 512, a.w_o_mem, D, MERGED, D, 512, PROJB + OFF_GATE + 2 * D, IN_COLS, nullptr, SCR);
            break;
        case 4:
            nv::k_gemm<nv::M_Y><<<dim3(D / 64, T / 64), 256, 0, stream>>>(MERGED, D, a.w_out, D, Z, D, D, a.x, D, nullptr, nullptr);
            break;
        case 6:
            nv::k_gemm<nv::M_F32><<<dim3(NE / 64, T / 64), 256, 0, stream>>>(X1B, D, a.w_router, NE, LOGITS, NE, D, nullptr, 0, nullptr, nullptr);
            nv::k_gu<<<dim3(EFF / 64, T / 64), 256, 0, stream>>>(X1B, nullptr, nullptr, a.w_s_gu, 0, HS);
            break;
        case 9:
            nv::k_gu<<<dim3(EFF / 64, MAXT64), 256, 0, stream>>>(X1B, STOK, TILES64, a.w_e_gu, (size_t)D * 2 * EFF, HBUF);
            nv::k_down<false><<<dim3(D / 64, T / 64), 256, 0, stream>>>(HS, nullptr, a.w_s_down, 0, SHOUT);
            break;
        case 10:
            nv::k_down<true><<<dim3(D / 64, MAXT64), 256, 0, stream>>>(HBUF, TILES64, a.w_e_down, (size_t)EFF * D, YS);
            break;
        default: break;
        }
    }
#else
    a.ph_lo = 0; a.ph_hi = NPHASE; a.li = 0;
    hipLaunchKernelGGL(mega_fwd, dim3(grid), dim3(NWAVES * 64), LDS_BYTES, stream, a);
#endif
}
```

```cpp
#define HYBRID 0
#include <hip/hip_runtime.h>
#include <stdint.h>
#include <math.h>
#include <cstdio>

constexpr int D = 1024, BATCH = 8, SEQ = 4096, T = BATCH * SEQ;
constexpr int MEM_LEN = 256, MROWS = BATCH * MEM_LEN;
constexpr int IN_COLS = 5888;
constexpr int OFF_QSB = 0, OFF_KSB = 512, OFF_VSB = 1024, OFF_QSW = 1536, OFF_KSW = 2048, OFF_VSW = 2176, OFF_QM = 2304, OFF_GATE = 2816;
constexpr int NE = 256, TOPK = 8, EFF = 256;
constexpr float LN_EPS = 1e-5f;
constexpr float ALPHA = 1.189207115002721f;
constexpr int NSLOT = T * TOPK;
constexpr float LOG2E = 1.4426950408889634f;
constexpr float LOG2_255 = 7.994353436858858f, GATE_TMAX = 7.988684686772166f - 7.994353436858858f;
constexpr float QS64 = 0.125f * LOG2E;
constexpr float QS128 = 0.08838834764831845f * LOG2E;

constexpr float W8_SCALE = 64.f, W8_INV = 1.f / 64.f;
constexpr float O8_SCALE = 16.f, M8_SCALE = 16.f;
constexpr float H8_SCALE = 16.f;
constexpr float YS_SCALE = 16.f, YS_INV = 1.f / 16.f;
constexpr size_t MiB = 1u << 20;
constexpr size_t WS_CTL = 0, CTL_ZERO_BYTES = 1 * MiB;
constexpr size_t WS_WIN_T = 2 * MiB, WS_WMKV_T = 14 * MiB, WS_WOSB_T = 16 * MiB, WS_WOSW_T = 17 * MiB, WS_WOM_T = 18 * MiB, WS_WOUT_T = 19 * MiB, WS_WRS_T = 21 * MiB, WS_WSD_T = 23 * MiB;
constexpr size_t WS_WEGU_T = 24 * MiB, WS_WED_T = 280 * MiB;
constexpr size_t WS_XB = 408 * MiB, WS_MEMB = 472 * MiB, WS_MKVB = 476 * MiB, WS_PROJB = 480 * MiB;
constexpr size_t WS_OSB = 848 * MiB, WS_OSW = 880 * MiB, WS_OM = 912 * MiB, WS_MERGED = 944 * MiB, WS_Z = 1008 * MiB, WS_X1B = 1136 * MiB, WS_LOGITS = 1200 * MiB, WS_HS = 1232 * MiB, WS_SHOUT = 1248 * MiB;
constexpr size_t WS_XB8 = 1920 * MiB, WS_X1B8 = 1952 * MiB, WS_WG8_T = 1984 * MiB;
constexpr size_t WS_GT = 1728 * MiB;
constexpr size_t WS_ROUTE = 1312 * MiB, WS_HBUF = 1328 * MiB, WS_YS = 1460 * MiB, WS_END = 1988 * MiB;
constexpr size_t RT_IDX = 0, RT_WGT = 1 * MiB, RT_POS = 2 * MiB, RT_STOK = 3 * MiB  , RT_TILES = 5 * MiB  , RT_TILES64 = 6 * MiB  ;
constexpr int MAXT256 = NSLOT / 256 + NE;
constexpr int MAXT64 = NSLOT / 64 + NE;
constexpr int CW_COUNTS = 1024, CW_CURSOR = 1280, CW_QUEUE = 1536  , CW_BAR = 4096;

typedef unsigned short bf16;
typedef short bf16x8 __attribute__((ext_vector_type(8)));
typedef float f32x4 __attribute__((ext_vector_type(4)));
typedef float f32x16 __attribute__((ext_vector_type(16)));
typedef unsigned u32x4 __attribute__((ext_vector_type(4)));
typedef unsigned u32x2 __attribute__((ext_vector_type(2)));

__device__ __forceinline__ unsigned f2bf(float f) { unsigned u = __builtin_bit_cast(unsigned, f); return (u + 0x7fffu + ((u >> 16) & 1u)) >> 16; }
__device__ __forceinline__ unsigned pk2(float lo, float hi) { return f2bf(lo) | (f2bf(hi) << 16); }
__device__ __forceinline__ float bf2f(unsigned b) { return __builtin_bit_cast(float, b << 16); }
__device__ __forceinline__ float bflo(unsigned w) { return __builtin_bit_cast(float, w << 16); }
__device__ __forceinline__ float bfhi(unsigned w) { return __builtin_bit_cast(float, w & 0xffff0000u); }
__device__ __forceinline__ unsigned pack4_e4m3(float a, float b, float c, float d) {
    a = __builtin_amdgcn_fmed3f(a, -448.f, 448.f); b = __builtin_amdgcn_fmed3f(b, -448.f, 448.f); c = __builtin_amdgcn_fmed3f(c, -448.f, 448.f); d = __builtin_amdgcn_fmed3f(d, -448.f, 448.f);
    const unsigned w = __builtin_amdgcn_cvt_pk_fp8_f32(a, b, 0u, false); return __builtin_amdgcn_cvt_pk_fp8_f32(c, d, w, true);
}
__device__ __forceinline__ float wave_sum(float v) {
#pragma unroll
    for (int o = 1; o < 64; o <<= 1) v += __shfl_xor(v, o);
    return v;
}
__device__ __forceinline__ float sigmoidf_(float z) { return 1.f / (1.f + __expf(-z)); }
__device__ __forceinline__ float gate_sig(float z) { z = fminf(fmaxf(z, -30.f), 30.f); return __builtin_amdgcn_rcpf(1.f + __expf(-z)); }

__device__ __forceinline__ int lane_id() { int l; asm volatile("v_mbcnt_lo_u32_b32 %0, -1, 0\n\tv_mbcnt_hi_u32_b32 %0, -1, %0" : "=v"(l)); return l; }
__device__ __forceinline__ int otid(int wave) { int t = (wave << 6) | lane_id(); asm volatile("" : "+v"(t)); return t; }
__device__ __forceinline__ bool is_t0(int wave) { return wave == 0 && lane_id() == 0; }
namespace thin {
#define TLAS __attribute__((address_space(3)))
__device__ __forceinline__ void cvt_rows(const float* __restrict__ src, bf16* __restrict__ dst, unsigned char* __restrict__ dst8  , int rows, int gw, int ngw, int lane) {
    f32x4 cur[4], nxt[4];
    if (gw < rows) {
#pragma unroll
        for (int j = 0; j < 4; ++j) cur[j] = __builtin_nontemporal_load((const f32x4*)(src + (size_t)gw * D) + lane + 64 * j);
    }
    for (int r = gw; r < rows; r += ngw) {
        const int rn = (r + ngw < rows) ? r + ngw : r;
#pragma unroll
        for (int j = 0; j < 4; ++j) nxt[j] = __builtin_nontemporal_load((const f32x4*)(src + (size_t)rn * D) + lane + 64 * j);
        u32x2* d = (u32x2*)(dst + (size_t)r * D) + lane;
#pragma unroll
        for (int j = 0; j < 4; ++j) { u32x2 o; o.x = pk2(cur[j].x, cur[j].y); o.y = pk2(cur[j].z, cur[j].w); d[64 * j] = o; }
        if (dst8) { unsigned* d8 = (unsigned*)(dst8 + (size_t)r * D) + lane;
#pragma unroll
            for (int j = 0; j < 4; ++j) d8[64 * j] = pack4_e4m3(cur[j].x, cur[j].y, cur[j].z, cur[j].w); }
#pragma unroll
        for (int j = 0; j < 4; ++j) cur[j] = nxt[j];
    }
}
__device__ __forceinline__ void ln1_rows(const bf16* __restrict__ Z, const float* __restrict__ g, const float* __restrict__ bta, bf16* __restrict__ XB, unsigned char* __restrict__ XB8, int gw, int ngw, int lane) {
    u32x4 r0[2], r1[2], r2[2];
    const int ra = gw < T ? gw : T - 1, rb = gw + ngw < T ? gw + ngw : T - 1;
#pragma unroll
    for (int j = 0; j < 2; ++j) { r0[j] = __builtin_nontemporal_load((const u32x4*)(Z + (size_t)ra * D) + lane + 64 * j); r1[j] = __builtin_nontemporal_load((const u32x4*)(Z + (size_t)rb * D) + lane + 64 * j); }
    f32x4 gg[4], bb[4];
#pragma unroll
    for (int j = 0; j < 2; ++j) { gg[2 * j] = ((const f32x4*)g)[2 * lane + 128 * j]; gg[2 * j + 1] = ((const f32x4*)g)[2 * lane + 128 * j + 1]; bb[2 * j] = ((const f32x4*)bta)[2 * lane + 128 * j]; bb[2 * j + 1] = ((const f32x4*)bta)[2 * lane + 128 * j + 1]; }
    for (int r = gw; r < T; r += ngw) {
        const int rn = (r + 2 * ngw < T) ? r + 2 * ngw : r;
#pragma unroll
        for (int j = 0; j < 2; ++j) r2[j] = __builtin_nontemporal_load((const u32x4*)(Z + (size_t)rn * D) + lane + 64 * j);
        f32x4 v[4]; float s = 0.f;
#pragma unroll
        for (int j = 0; j < 2; ++j) { const u32x4 z = r0[j]; v[2 * j] = (f32x4){bflo(z.x), bfhi(z.x), bflo(z.y), bfhi(z.y)}; v[2 * j + 1] = (f32x4){bflo(z.z), bfhi(z.z), bflo(z.w), bfhi(z.w)}; }
#pragma unroll
        for (int j = 0; j < 4; ++j) s += (v[j].x + v[j].y) + (v[j].z + v[j].w);
        const float mean = wave_sum(s) * (1.f / D); float s2 = 0.f;
#pragma unroll
        for (int j = 0; j < 4; ++j) { v[j] = v[j] - mean; s2 += (v[j].x * v[j].x + v[j].y * v[j].y) + (v[j].z * v[j].z + v[j].w * v[j].w); }
        const float rstd = rsqrtf(wave_sum(s2) * (1.f / D) + LN_EPS);
        u32x4* xb = (u32x4*)(XB + (size_t)r * D) + lane;
        u32x2* x8 = (u32x2*)(XB8 + (size_t)r * D) + lane;
#pragma unroll
        for (int j = 0; j < 2; ++j) { const f32x4 o0 = v[2 * j] * rstd * gg[2 * j] + bb[2 * j], o1 = v[2 * j + 1] * rstd * gg[2 * j + 1] + bb[2 * j + 1];
            u32x4 w; w.x = pk2(o0.x, o0.y); w.y = pk2(o0.z, o0.w); w.z = pk2(o1.x, o1.y); w.w = pk2(o1.z, o1.w); xb[64 * j] = w;
            u32x2 q; q.x = pack4_e4m3(o0.x, o0.y, o0.z, o0.w); q.y = pack4_e4m3(o1.x, o1.y, o1.z, o1.w); x8[64 * j] = q; }
#pragma unroll
        for (int j = 0; j < 2; ++j) { r0[j] = r1[j]; r1[j] = r2[j]; }
    }
}
__device__ __forceinline__ void route(const float* __restrict__ logits, const float* __restrict__ rbias, int* __restrict__ idx, float* __restrict__ wgt, unsigned* __restrict__ counts,
                                      TLAS int* hist  , int wg, int nwg, int tid) {
    const int lane = tid & 63, wave = tid >> 6;
    if (tid < NE) hist[tid] = 0;
    __syncthreads();
    const int per = (T + nwg - 1) / nwg;
    const f32x4 rb = ((const f32x4*)rbias)[lane];
    constexpr int NT = 2;
    for (int i = wave * NT; i < per; i += 8 * NT) {
        int tok[NT]; bool live[NT]; f32x4 lg[NT];
#pragma unroll
        for (int u = 0; u < NT; ++u) { tok[u] = wg * per + i + u; live[u] = (i + u < per) && tok[u] < T; lg[u] = ((const f32x4*)(logits + (size_t)(live[u] ? tok[u] : wg * per) * NE))[lane]; }
        float s[NT][4], c[NT][4];
#pragma unroll
        for (int u = 0; u < NT; ++u)
#pragma unroll
            for (int j = 0; j < 4; ++j) { s[u][j] = sigmoidf_(lg[u][j]); c[u][j] = s[u][j] + rb[j]; }
        float m1[NT], m2[NT];
#pragma unroll
        for (int u = 0; u < NT; ++u) { const float a = fmaxf(c[u][0], c[u][1]), b = fminf(c[u][0], c[u][1]), d = fmaxf(c[u][2], c[u][3]), e = fminf(c[u][2], c[u][3]); m1[u] = fmaxf(a, d); m2[u] = fmaxf(fminf(a, d), fmaxf(b, e)); }
#pragma unroll
        for (int off = 1; off < 8; off <<= 1)
#pragma unroll
            for (int u = 0; u < NT; ++u) { const float o1 = __shfl_xor(m1[u], off), o2 = __shfl_xor(m2[u], off); const float n1 = fmaxf(m1[u], o1), n2 = fmaxf(fminf(m1[u], o1), fmaxf(m2[u], o2)); m1[u] = n1; m2[u] = n2; }
        const int g = lane >> 3;
        float gs[NT]; int rank[NT];
#pragma unroll
        for (int u = 0; u < NT; ++u) { gs[u] = m1[u] + m2[u]; rank[u] = 0; }
#pragma unroll
        for (int j = 0; j < 8; ++j)
#pragma unroll
            for (int u = 0; u < NT; ++u) { const float gj = __shfl(gs[u], 8 * j); rank[u] += (gj > gs[u] || (gj == gs[u] && j < g)) ? 1 : 0; }
#pragma unroll
        for (int u = 0; u < NT; ++u) if (rank[u] >= 4) { c[u][0] = -INFINITY; c[u][1] = -INFINITY; c[u][2] = -INFINITY; c[u][3] = -INFINITY; }
        int myidx[NT]; float mysc[NT], ssum[NT];
#pragma unroll
        for (int u = 0; u < NT; ++u) { myidx[u] = 0; mysc[u] = 0.f; ssum[u] = 0.f; }
#pragma unroll
        for (int k = 0; k < 8; ++k) {
            float bv[NT]; int be[NT];
#pragma unroll
            for (int u = 0; u < NT; ++u) { bv[u] = c[u][0]; int bi = 0;
#pragma unroll
                for (int j = 1; j < 4; ++j) if (c[u][j] > bv[u]) { bv[u] = c[u][j]; bi = j; }
                be[u] = 4 * lane + bi; }
#pragma unroll
            for (int off = 1; off < 64; off <<= 1)
#pragma unroll
                for (int u = 0; u < NT; ++u) { const float ov = __shfl_xor(bv[u], off); const int oe = __shfl_xor(be[u], off); const bool take = ov > bv[u] || (ov == bv[u] && oe < be[u]); bv[u] = take ? ov : bv[u]; be[u] = take ? oe : be[u]; }
#pragma unroll
            for (int u = 0; u < NT; ++u) { const int wj = be[u] & 3, wl = be[u] >> 2;
                const float sloc = wj == 0 ? s[u][0] : (wj == 1 ? s[u][1] : (wj == 2 ? s[u][2] : s[u][3]));
                const float ssel = __shfl(sloc, wl);
                ssum[u] += ssel; if (lane == k) { myidx[u] = be[u]; mysc[u] = ssel; }
#pragma unroll
                for (int j = 0; j < 4; ++j) c[u][j] = (lane == wl && j == wj) ? -INFINITY : c[u][j]; }
        }
#pragma unroll
        for (int u = 0; u < NT; ++u)
            if (live[u] && lane < 8) { idx[tok[u] * 8 + lane] = myidx[u]; wgt[tok[u] * 8 + lane] = mysc[u] / ssum[u] * 2.5f; __hip_atomic_fetch_add(&hist[myidx[u]], 1, __ATOMIC_RELAXED, __HIP_MEMORY_SCOPE_WORKGROUP); }
    }
    __syncthreads();
    if (tid < NE && hist[tid] > 0) atomicAdd(&counts[tid], (unsigned)hist[tid]);
}
__device__ __forceinline__ void scan_scatter(const unsigned* __restrict__ counts, unsigned* __restrict__ cursor, const int* __restrict__ idx, int* __restrict__ pos_of, int* __restrict__ sorted_tok,
                                             int* __restrict__ tiles256, int* __restrict__ tiles64, TLAS int* lds, int wg, int nwg, int tid) {
    TLAS int* cnt = lds; TLAS int* offs = lds + 256; TLAS int* lcnt = lds + 512; TLAS int* base = lds + 768;
    if (tid < NE) { cnt[tid] = (int)__hip_atomic_load(&counts[tid], __ATOMIC_RELAXED, __HIP_MEMORY_SCOPE_AGENT); lcnt[tid] = 0; }
    __syncthreads();
    if (tid < NE) { int o = 0; for (int j = 0; j < tid; ++j) o += cnt[j]; offs[tid] = o; }
    __syncthreads();
    const int per = NSLOT / nwg;
    int myr[4], mye[4];
#pragma unroll
    for (int i = 0; i < 4; ++i) { const int li = tid + 512 * i; mye[i] = -1; myr[i] = 0;
        if (li < per) { const int e = idx[wg * per + li]; mye[i] = e; myr[i] = __hip_atomic_fetch_add(&lcnt[e], 1, __ATOMIC_RELAXED, __HIP_MEMORY_SCOPE_WORKGROUP); } }
    __syncthreads();
    if (tid < NE) { const int c = lcnt[tid]; base[tid] = offs[tid] + (c > 0 ? (int)atomicAdd(&cursor[tid], (unsigned)c) : 0); }
    __syncthreads();
#pragma unroll
    for (int i = 0; i < 4; ++i) { const int li = tid + 512 * i;
        if (li < per) { const int slot = wg * per + li; const int p = base[mye[i]] + myr[i]; pos_of[slot] = p; sorted_tok[p] = slot >> 3; } }
    if (wg == 0) {
        if (tid < 256) sorted_tok[NSLOT + tid] = 0;
        if (HYBRID && tid < NE) { const int c = cnt[tid], off = offs[tid];
            int t256 = 0, t64 = 0; for (int j = 0; j < tid; ++j) { t256 += (cnt[j] + 255) >> 8; t64 += (cnt[j] + 63) >> 6; }
            const int n256 = (c + 255) >> 8, n64 = (c + 63) >> 6;
            for (int i = 0; i < n256; ++i) { tiles256[t256 + i] = tid; tiles256[MAXT256 + t256 + i] = off + 256 * i; tiles256[2 * MAXT256 + t256 + i] = (c - 256 * i) < 256 ? (c - 256 * i) : 256; }
            for (int i = 0; i < n64; ++i) { tiles64[t64 + i] = tid; tiles64[MAXT64 + t64 + i] = off + 64 * i; tiles64[2 * MAXT64 + t64 + i] = (c - 64 * i) < 64 ? (c - 64 * i) : 64; }
            if (tid == NE - 1) { tiles256[3 * MAXT256] = t256 + n256; tiles64[3 * MAXT64] = t64 + n64; } }
    }
    __syncthreads();
}
__device__ __forceinline__ void final_rows(const bf16* __restrict__ X1, const bf16* __restrict__ SH, const unsigned char* __restrict__ YS, const int* __restrict__ pos_of, const float* __restrict__ wgt,
                                           const float* __restrict__ g, const float* __restrict__ bta, float* __restrict__ out, int gw, int ngw, int lane) {
    typedef float f2_ __attribute__((ext_vector_type(2)));
    f32x4 gg[4], bb[4];
#pragma unroll
    for (int j = 0; j < 4; ++j) { gg[j] = ((const f32x4*)g)[lane + 64 * j]; bb[j] = ((const f32x4*)bta)[lane + 64 * j]; }
    const int l8 = lane & 7;
    unsigned slot_cur = 0u, slot_nxt = 0u;
    if (gw < T) slot_cur = (lane & 8) ? __float_as_uint(wgt[gw * 8 + l8]) : (unsigned)pos_of[gw * 8 + l8];
    for (int row = gw; row < T; row += ngw) {
        const int rn = (row + ngw < T) ? row + ngw : row;
        slot_nxt = (lane & 8) ? __float_as_uint(wgt[rn * 8 + l8]) : (unsigned)pos_of[rn * 8 + l8];
        unsigned yv[8][4];
#pragma unroll
        for (int k = 0; k < 8; ++k) { const int p = __builtin_amdgcn_readlane((int)slot_cur, k);
#pragma unroll
            for (int j = 0; j < 4; ++j) yv[k][j] = __builtin_nontemporal_load((const unsigned*)(YS + (size_t)p * D) + lane + 64 * j); }
        f32x4 v[4];
#pragma unroll
        for (int j = 0; j < 4; ++j) { const u32x2 a = ((const u32x2*)(X1 + (size_t)row * D))[lane + 64 * j]; const u32x2 s = ((const u32x2*)(SH + (size_t)row * D))[lane + 64 * j];
            v[j].x = ALPHA * bflo(a.x) + bflo(s.x); v[j].y = ALPHA * bfhi(a.x) + bfhi(s.x); v[j].z = ALPHA * bflo(a.y) + bflo(s.y); v[j].w = ALPHA * bfhi(a.y) + bfhi(s.y); }
#pragma unroll
        for (int k = 0; k < 8; ++k) { const float w = __uint_as_float((unsigned)__builtin_amdgcn_readlane((int)slot_cur, 8 + k)) * YS_INV;
#pragma unroll
            for (int j = 0; j < 4; ++j) { const f2_ lo = __builtin_amdgcn_cvt_pk_f32_fp8(yv[k][j], false), hi = __builtin_amdgcn_cvt_pk_f32_fp8(yv[k][j], true);
                v[j].x += w * lo.x; v[j].y += w * lo.y; v[j].z += w * hi.x; v[j].w += w * hi.y; } }
        float s = 0.f;
#pragma unroll
        for (int j = 0; j < 4; ++j) s += (v[j].x + v[j].y) + (v[j].z + v[j].w);
        const float mean = wave_sum(s) * (1.f / D); float s2 = 0.f;
#pragma unroll
        for (int j = 0; j < 4; ++j) { v[j] = v[j] - mean; s2 += (v[j].x * v[j].x + v[j].y * v[j].y) + (v[j].z * v[j].z + v[j].w * v[j].w); }
        const float rstd = rsqrtf(wave_sum(s2) * (1.f / D) + LN_EPS);
#pragma unroll
        for (int j = 0; j < 4; ++j) __builtin_nontemporal_store(v[j] * rstd * gg[j] + bb[j], (f32x4*)(out + (size_t)row * D) + lane + 64 * j);
        slot_cur = slot_nxt;
    }
}
}
namespace pg8 {
#define PG8_LAS __attribute__((address_space(3)))
typedef unsigned short bf16_t;
typedef short bf16x8 __attribute__((ext_vector_type(8)));
typedef float f32x4 __attribute__((ext_vector_type(4)));
typedef float f32x2 __attribute__((ext_vector_type(2)));
typedef unsigned u32x4 __attribute__((ext_vector_type(4)));
typedef unsigned u32x2 __attribute__((ext_vector_type(2)));
constexpr int BM = 256, BK = 64, HALF = 128, HTB = HALF * BK * 2  , STAGE_BYTES = 8 * HTB, NXCD = 8, WGM = 8;

__host__ __device__ __forceinline__ int lds_byte(int r, int c) { const int st = (r >> 4) * 2 + (c >> 5), rr = r & 15, cc = c & 31, ob = rr * 64 + cc * 2; return st * 1024 + (ob ^ (((ob >> 9) & 1) << 5)); }
__host__ __device__ __forceinline__ void stage_rc(int b, int& R, int& C) { const int st = b / 1024, sb = b % 1024, swz = sb ^ (((sb >> 9) & 1) << 5); R = (st >> 1) * 16 + swz / 64; C = (st & 1) * 32 + (swz % 64) / 2; }
__host__ __device__ __forceinline__ int perm32(int rho) { const int n = rho >> 4, i = rho & 15; return 8 * (i >> 2) + 4 * n + (i & 3); }

struct Unit { unsigned A; unsigned B; int pm, pn, aux, nr; };

__device__ __forceinline__ unsigned cvt_pk_bf16(float lo, float hi) { typedef __bf16 bf16x2_t __attribute__((ext_vector_type(2))); f32x2 v = {lo, hi}; bf16x2_t b = __builtin_convertvector(v, bf16x2_t); return __builtin_bit_cast(unsigned, b); }

typedef int i32x8 __attribute__((ext_vector_type(8)));
typedef i32x8 i32x8_a16 __attribute__((aligned(16)));
template <class Epi, class Sched, bool GATHER, bool GATHER_NR = false, bool F8 = false>
__device__ __forceinline__ void gemm_phase(PG8_LAS unsigned char* lds, const unsigned char* wsbase, const int K, const Sched& S, Epi& E, const int wave) {
    const __amdgpu_buffer_rsrc_t rsrc = __builtin_amdgcn_make_buffer_rsrc((void*)wsbase, 0, 0x7fffffff, 0x00020000);
    const int tid_ = otid(wave);
    const int tid = tid_, wid = wave, lane = tid & 63, wr = wid >> 2, wc = wid & 3, fr = lane & 15, fq = lane >> 4;
    const int nt = K / BK;
    unsigned voffA[2], voffB[2];
#pragma unroll
    for (int i = 0; i < 2; ++i) { int R, C; stage_rc(tid * 16 + i * 8192, R, C); const int Rb = Epi::PERM ? ((R & ~31) + perm32(R & 31)) : R;
        voffA[i] = (unsigned)(R * K + C) * 2u; voffB[i] = (unsigned)(Rb * K + C) * 2u; }
    const unsigned kstep = (unsigned)(BK * 2);
    const unsigned hstep = (unsigned)HALF * (unsigned)K * 2u;
    const unsigned ldsw = (unsigned)wid * 1024u, ldsb = (unsigned)(size_t)lds;
    const int aoff = lds_byte(wr * 64 + fr, fq * 8), boff = lds_byte(wc * 32 + fr, fq * 8);
#define PG8_SA(b, h) (((b) * 2 + (h)) * HTB)
#define PG8_SB(b, h) ((4 + (b) * 2 + (h)) * HTB)
#define PG8_STAGE(bufoff, gbase, voff) do { _Pragma("unroll") for (int _i = 0; _i < 2; ++_i) \
        asm volatile("s_mov_b32 m0, %0\n\ts_nop 0\n\tbuffer_load_dwordx4 %1, %2, %3 offen lds" :: "s"(ldsb + (unsigned)(bufoff) + ldsw + (unsigned)(_i * 8192)), "v"((voff)[_i]), "s"(rsrc), "s"((unsigned)(gbase)) : "m0", "memory"); } while (0)
#define PG8_STAGE_A(bufoff, p, h, g) do { if (GATHER) PG8_STAGE(bufoff, p, (g)[h]); else PG8_STAGE(bufoff, (p) + (h) * hstep, voffA); } while (0)
    const int aoff8 = lds_byte(wr * 64 + fr, fq * 16), boff8 = lds_byte(wc * 32 + fr, fq * 16);
#define PG8_LDA8(dst, b, h) do { _Pragma("unroll") for (int m = 0; m < 4; ++m) dst[m] = *(const PG8_LAS i32x8_a16*)(lds + PG8_SA(b, h) + aoff8 + m * 2048); } while (0)
#define PG8_LDB8(dst, b, h) do { _Pragma("unroll") for (int n = 0; n < 2; ++n) dst[n] = *(const PG8_LAS i32x8_a16*)(lds + PG8_SB(b, h) + boff8 + n * 2048); } while (0)
#define PG8_MMA8(ai, bj, At, Bt) do { __builtin_amdgcn_s_setprio(1); _Pragma("unroll") for (int m = 0; m < 4; ++m) _Pragma("unroll") for (int n = 0; n < 2; ++n) \
        acc[ai][bj][m][n] = __builtin_amdgcn_mfma_scale_f32_16x16x128_f8f6f4(Bt[n], At[m], acc[ai][bj][m][n], 0, 0, 0, 0x7F7F7F7F, 0, 0x7F7F7F7F); __builtin_amdgcn_s_setprio(0); } while (0)
#define PG8_LDA(dst, b, h) do { _Pragma("unroll") for (int m = 0; m < 4; ++m) _Pragma("unroll") for (int k = 0; k < 2; ++k) dst[m][k] = *(const PG8_LAS bf16x8*)(lds + PG8_SA(b, h) + aoff + m * 2048 + k * 1024); } while (0)
#define PG8_LDB(dst, b, h) do { _Pragma("unroll") for (int n = 0; n < 2; ++n) _Pragma("unroll") for (int k = 0; k < 2; ++k) dst[n][k] = *(const PG8_LAS bf16x8*)(lds + PG8_SB(b, h) + boff + n * 2048 + k * 1024); } while (0)
#define PG8_MMA(ai, bj, At, Bt) do { __builtin_amdgcn_s_setprio(1); _Pragma("unroll") for (int m = 0; m < 4; ++m) _Pragma("unroll") for (int n = 0; n < 2; ++n) _Pragma("unroll") for (int k = 0; k < 2; ++k) \
        acc[ai][bj][m][n] = __builtin_amdgcn_mfma_f32_16x16x32_bf16(Bt[n][k], At[m][k], acc[ai][bj][m][n], 0, 0, 0); __builtin_amdgcn_s_setprio(0); } while (0)
#define PG8_WAIT_V(n) asm volatile("s_waitcnt vmcnt(" #n ")" ::: "memory")
#define PG8_WAIT_L(n) asm volatile("s_waitcnt lgkmcnt(" #n ")" ::: "memory")
#define PG8_BAR __builtin_amdgcn_s_barrier()
#define PG8_SCHED __builtin_amdgcn_sched_barrier(0)
#define PG8_GOFF(dst, u) do { if (GATHER) { _Pragma("unroll") for (int _i = 0; _i < 2; ++_i) { int _R, _C; stage_rc(tid * 16 + _i * 8192, _R, _C); _Pragma("unroll") for (int _h = 0; _h < 2; ++_h) \
        dst[_h][_i] = (unsigned)(S.row_index((u), _R + _h * HALF) * K + _C) * 2u; } } } while (0)
    Unit cur, nxt; int ui = 0;
    if (!S.next(0, cur)) return;
    f32x4 acc[2][2][4][2];
#pragma unroll
    for (int a = 0; a < 2; ++a)
#pragma unroll
        for (int b = 0; b < 2; ++b)
#pragma unroll
            for (int m = 0; m < 4; ++m)
#pragma unroll
                for (int n = 0; n < 2; ++n) acc[a][b][m][n] = (f32x4){0.f, 0.f, 0.f, 0.f};
    bf16x8 At[4][2], B0[2][2], B1[2][2];
    i32x8 At8[4], B08[2], B18[2];
    unsigned curG[2][2] = {{0u, 0u}, {0u, 0u}}, nxtG[2][2] = {{0u, 0u}, {0u, 0u}};
    unsigned cA = cur.A, cB = cur.B;
    PG8_GOFF(curG, cur);
    PG8_STAGE(PG8_SB(0, 0), cB, voffB); PG8_STAGE(PG8_SB(0, 1), cB + hstep, voffB); PG8_STAGE_A(PG8_SA(0, 0), cA, 0, curG); PG8_STAGE_A(PG8_SA(0, 1), cA, 1, curG);
    if (wr == 1) PG8_BAR;
    PG8_WAIT_V(2); PG8_BAR;
    PG8_STAGE(PG8_SB(1, 0), cB + kstep, voffB); PG8_STAGE_A(PG8_SA(1, 0), cA + kstep, 0, curG); PG8_STAGE(PG8_SB(1, 1), cB + hstep + kstep, voffB);
    PG8_WAIT_V(6); PG8_BAR;
    for (;;) {
        const bool has_next = S.next(ui + 1, nxt);
        const unsigned nA = has_next ? nxt.A : cA, nB = has_next ? nxt.B : cB;
        if (GATHER) { if (has_next) PG8_GOFF(nxtG, nxt); else { _Pragma("unroll") for (int _h = 0; _h < 2; ++_h) _Pragma("unroll") for (int _i = 0; _i < 2; ++_i) nxtG[_h][_i] = curG[_h][_i]; } }
#pragma unroll 1
        for (int t = 0; t < nt; t += 2) {
            const bool last = (t == nt - 2);
            const unsigned a1 = cA + (unsigned)(t + 1) * kstep;
            const unsigned a2 = last ? nA : cA + (unsigned)(t + 2) * kstep, b2 = last ? nB : cB + (unsigned)(t + 2) * kstep;
            const unsigned a3 = a2 + kstep, b3 = b2 + kstep;
            if (F8) { PG8_LDB8(B08, 0, 0); PG8_LDB8(B18, 0, 1); PG8_SCHED; PG8_LDA8(At8, 0, 0); } else { PG8_LDB(B0, 0, 0); PG8_LDB(B1, 0, 1); PG8_SCHED; PG8_LDA(At, 0, 0); } PG8_STAGE_A(PG8_SA(1, 1), a1, 1, curG);
            if (GATHER) { if (last) { _Pragma("unroll") for (int _h = 0; _h < 2; ++_h) _Pragma("unroll") for (int _i = 0; _i < 2; ++_i) curG[_h][_i] = nxtG[_h][_i]; } }
            PG8_WAIT_V(8); PG8_WAIT_L(0); PG8_BAR; if (F8) { PG8_MMA8(0, 0, At8, B08); PG8_MMA8(0, 1, At8, B18); } else { PG8_MMA(0, 0, At, B0); PG8_MMA(0, 1, At, B1); } PG8_BAR; PG8_SCHED;
            if (F8) PG8_LDA8(At8, 0, 1); else PG8_LDA(At, 0, 1); PG8_STAGE(PG8_SB(0, 0), b2, voffB); PG8_STAGE(PG8_SB(0, 1), b2 + hstep, voffB); PG8_STAGE_A(PG8_SA(0, 0), a2, 0, curG);
            PG8_WAIT_V(8); PG8_WAIT_L(0); PG8_BAR; if (!GATHER_NR || cur.nr > HALF) { if (F8) { PG8_MMA8(1, 0, At8, B08); PG8_MMA8(1, 1, At8, B18); } else { PG8_MMA(1, 0, At, B0); PG8_MMA(1, 1, At, B1); } } PG8_BAR; PG8_SCHED;
            if (F8) { PG8_LDB8(B08, 1, 0); PG8_LDB8(B18, 1, 1); PG8_SCHED; PG8_LDA8(At8, 1, 0); } else { PG8_LDB(B0, 1, 0); PG8_LDB(B1, 1, 1); PG8_SCHED; PG8_LDA(At, 1, 0); } PG8_STAGE_A(PG8_SA(0, 1), a2, 1, curG);
            PG8_WAIT_V(8); PG8_WAIT_L(0); PG8_BAR; if (F8) { PG8_MMA8(0, 0, At8, B08); PG8_MMA8(0, 1, At8, B18); } else { PG8_MMA(0, 0, At, B0); PG8_MMA(0, 1, At, B1); } PG8_BAR; PG8_SCHED;
            if (F8) PG8_LDA8(At8, 1, 1); else PG8_LDA(At, 1, 1); PG8_STAGE(PG8_SB(1, 0), b3, voffB); PG8_STAGE(PG8_SB(1, 1), b3 + hstep, voffB); PG8_STAGE_A(PG8_SA(1, 0), a3, 0, curG);
            PG8_WAIT_V(8); PG8_WAIT_L(0); PG8_BAR; if (!GATHER_NR || cur.nr > HALF) { if (F8) { PG8_MMA8(1, 0, At8, B08); PG8_MMA8(1, 1, At8, B18); } else { PG8_MMA(1, 0, At, B0); PG8_MMA(1, 1, At, B1); } } PG8_BAR; PG8_SCHED;
        }
        if (wr == 0) PG8_BAR;
        { const int l2 = lane_id();
          E(acc, cur, wr, wc, l2 & 15, l2 >> 4); }
        if (!has_next) break;
        if (!E.keep(cur)) {
#pragma unroll
        for (int a = 0; a < 2; ++a)
#pragma unroll
            for (int b = 0; b < 2; ++b)
#pragma unroll
                for (int m = 0; m < 4; ++m)
#pragma unroll
                    for (int n = 0; n < 2; ++n) acc[a][b][m][n] = (f32x4){0.f, 0.f, 0.f, 0.f};
        }
        cur = nxt; cA = nA; cB = nB; ++ui;
        if (wr == 1) PG8_BAR;
    }
    PG8_WAIT_V(0);
    PG8_BAR;
#undef PG8_SA
#undef PG8_SB
#undef PG8_STAGE
#undef PG8_STAGE_A
#undef PG8_LDA
#undef PG8_LDA8
#undef PG8_LDB8
#undef PG8_MMA8
#undef PG8_LDB
#undef PG8_MMA
#undef PG8_WAIT_V
#undef PG8_WAIT_L
#undef PG8_BAR
#undef PG8_SCHED
#undef PG8_GOFF
}

struct GridOrder {
    unsigned A0, B0, asub, bsub; int nsub, nM, nN, nwg, G, c; unsigned astep, bstep;
    __device__ __forceinline__ void init(int M, int N, int K, int G_, int c_, int nsub_) { nM = M / BM; nN = N / BM; nwg = nM * nN; G = G_; c = c_; nsub = nsub_; astep = (unsigned)BM * (unsigned)K * 2u; bstep = astep; asub = 0; bsub = 0; }
    __device__ __forceinline__ bool next(int i, Unit& u) const {
        const int sub = i % nsub; const long L = (long)(i / nsub) * G + c; if (L >= nwg) return false;
        int wgid = (int)L; { const int q = nwg / NXCD, r = nwg % NXCD, xcd = wgid % NXCD, off = wgid / NXCD; wgid = (xcd < r ? xcd * (q + 1) : r * (q + 1) + (xcd - r) * q) + off; }
        const int nig = WGM * nN, gid = wgid / nig, fm = gid * WGM, gsz = (nM - fm) < WGM ? (nM - fm) : WGM;
        u.pm = fm + ((wgid % nig) % gsz); u.pn = (wgid % nig) / gsz; u.aux = sub; u.nr = BM;
        const unsigned a_ = A0 + (unsigned)sub * asub, b_ = B0 + (unsigned)sub * bsub;
        u.A = a_ + (unsigned)u.pm * astep; u.B = b_ + (unsigned)u.pn * bstep; return true;
    }
    __device__ __forceinline__ int row_index(const Unit&, int r) const { return r; }
};
}
namespace pg8 {
#define EPI_FOR_AI_M _Pragma("unroll") for (int ai = 0; ai < 2; ++ai) _Pragma("unroll") for (int m = 0; m < 4; ++m)
__device__ __forceinline__ u32x4 pack8(const f32x4& v0, const f32x4& v1) { u32x4 w; w.x = cvt_pk_bf16(v0[0], v0[1]); w.y = cvt_pk_bf16(v0[2], v0[3]); w.z = cvt_pk_bf16(v1[0], v1[1]); w.w = cvt_pk_bf16(v1[2], v1[3]); return w; }
__device__ __forceinline__ void unpack8(const u32x4& w, f32x4& v0, f32x4& v1) { v0 = (f32x4){bflo(w.x), bfhi(w.x), bflo(w.y), bfhi(w.y)}; v1 = (f32x4){bflo(w.z), bfhi(w.z), bflo(w.w), bfhi(w.w)}; }
__device__ __forceinline__ float silu_mul(float g, float u) { return g * u * __builtin_amdgcn_rcpf(1.f + __expf(-g)); }

struct EpiProj {
    static constexpr bool PERM = true;
    bf16_t* O;
    __device__ __forceinline__ bool keep(const Unit&) const { return false; }
    __device__ __forceinline__ void operator()(f32x4 (&acc)[2][2][4][2], const Unit& u, int wr, int wc, int fr, int fq) const {
        const int row0 = u.pm * BM + wr * 64 + fr, col0 = u.pn * BM + wc * 32 + 8 * fq;
        const int pn = u.pn;
        const float sc = (pn < 2 || pn == 6 || pn == 7) ? QS64 : ((pn == 9 || pn == 10) ? QS128 : 1.f);
        EPI_FOR_AI_M { bf16_t* rowp = O + (size_t)(row0 + ai * HALF + m * 16) * IN_COLS + col0;
#pragma unroll
            for (int bj = 0; bj < 2; ++bj) *(u32x4*)(rowp + bj * HALF) = pack8(acc[ai][bj][m][0] * sc, acc[ai][bj][m][1] * sc); }
    }
};
struct EpiGate8 {
    static constexpr bool PERM = true;
    const PG8_LAS float* b_gate; unsigned char* GT;
    __device__ __forceinline__ bool keep(const Unit&) const { return false; }
    __device__ __forceinline__ void operator()(f32x4 (&acc)[2][2][4][2], const Unit& u, int wr, int wc, int fr, int fq) const {
        const int col0 = u.pn * BM + wc * 32 + 8 * fq;
        f32x4 bv[2][2];
#pragma unroll
        for (int bj = 0; bj < 2; ++bj)
#pragma unroll
            for (int n = 0; n < 2; ++n) bv[bj][n] = *(const PG8_LAS f32x4*)(b_gate + col0 + bj * HALF + 4 * n);
        unsigned char* tile = GT + ((size_t)(u.pm * 12 + u.pn) * 8) * 512 * 16;
        unsigned off = (unsigned)((wr * 4 + wc) * 64 + (fq * 16 + fr)) * 16u;
        EPI_FOR_AI_M { u32x4 w; w.x = 0u; w.y = 0u; w.z = 0u; w.w = 0u;
#pragma unroll
            for (int j = 0; j < 4; ++j) {
                const f32x4 t0 = acc[ai][0][m][0] * (-W8_INV * LOG2E) + bv[0][0], t1 = acc[ai][0][m][1] * (-W8_INV * LOG2E) + bv[0][1], t2 = acc[ai][1][m][0] * (-W8_INV * LOG2E) + bv[1][0], t3 = acc[ai][1][m][1] * (-W8_INV * LOG2E) + bv[1][1];
                w.x = __builtin_amdgcn_cvt_pk_u8_f32(__builtin_amdgcn_rcpf((1.f / 255.f) + __builtin_amdgcn_exp2f(__builtin_amdgcn_fmed3f(t0[j], -30.f * LOG2E - LOG2_255, GATE_TMAX))), (unsigned)j, w.x);
                w.y = __builtin_amdgcn_cvt_pk_u8_f32(__builtin_amdgcn_rcpf((1.f / 255.f) + __builtin_amdgcn_exp2f(__builtin_amdgcn_fmed3f(t1[j], -30.f * LOG2E - LOG2_255, GATE_TMAX))), (unsigned)j, w.y);
                w.z = __builtin_amdgcn_cvt_pk_u8_f32(__builtin_amdgcn_rcpf((1.f / 255.f) + __builtin_amdgcn_exp2f(__builtin_amdgcn_fmed3f(t2[j], -30.f * LOG2E - LOG2_255, GATE_TMAX))), (unsigned)j, w.z);
                w.w = __builtin_amdgcn_cvt_pk_u8_f32(__builtin_amdgcn_rcpf((1.f / 255.f) + __builtin_amdgcn_exp2f(__builtin_amdgcn_fmed3f(t3[j], -30.f * LOG2E - LOG2_255, GATE_TMAX))), (unsigned)j, w.w); }
            *(u32x4*)(tile + off) = w; off += 512u * 16u; asm volatile("" : "+v"(off)); }
    }
};
struct EpiBf16 {
    static constexpr bool PERM = true;
    bf16_t* O; int ldc; float sc;
    __device__ __forceinline__ bool keep(const Unit&) const { return false; }
    __device__ __forceinline__ void operator()(f32x4 (&acc)[2][2][4][2], const Unit& u, int wr, int wc, int fr, int fq) const {
        const int row0 = u.pm * BM + wr * 64 + fr, col0 = u.pn * BM + wc * 32 + 8 * fq;
        EPI_FOR_AI_M { bf16_t* rowp = O + (size_t)(row0 + ai * HALF + m * 16) * ldc + col0;
#pragma unroll
            for (int bj = 0; bj < 2; ++bj) *(u32x4*)(rowp + bj * HALF) = pack8(acc[ai][bj][m][0] * sc, acc[ai][bj][m][1] * sc); }
    }
};
struct EpiOutProj {
    static constexpr bool PERM = true;
    unsigned char* O; const u32x4* GT;
    __device__ __forceinline__ bool keep(const Unit& u) const { return u.aux != 2; }
    __device__ __forceinline__ void operator()(f32x4 (&acc)[2][2][4][2], const Unit& u, int wr, int wc, int fr, int fq) const {
        const int row0 = u.pm * BM + wr * 64 + fr, col0 = u.pn * BM + wc * 32 + 8 * fq; const int sub = u.aux;
        const u32x4* ga = GT + ((size_t)(u.pm * 12 + sub * 4 + u.pn) * 8) * 512 + (wr * 4 + wc) * 64 + (fq * 16 + fr);
        const u32x4* gb = ga + (sub != 2 ? (size_t)4 * 8 * 512 : 0);
#pragma unroll
        for (int ai = 0; ai < 2; ++ai) {
            u32x2 wa[4][2], wb[4][2];
#pragma unroll
            for (int m = 0; m < 4; ++m) { const int fi = (ai * 4 + m) * 512; const u32x4 qa = ga[fi], qb = gb[fi];
                wa[m][0].x = qa.x; wa[m][0].y = qa.y; wa[m][1].x = qa.z; wa[m][1].y = qa.w; wb[m][0].x = qb.x; wb[m][0].y = qb.y; wb[m][1].x = qb.z; wb[m][1].y = qb.w; }
#pragma unroll
            for (int m = 0; m < 4; ++m) { const size_t row = (size_t)(row0 + ai * HALF + m * 16);
#pragma unroll
                for (int bj = 0; bj < 2; ++bj) {
                    f32x4 a0, a1;
#pragma unroll
                    for (int j = 0; j < 4; ++j) { a0[j] = (float)((wa[m][bj].x >> (8 * j)) & 0xffu); a1[j] = (float)((wa[m][bj].y >> (8 * j)) & 0xffu); }
                    if (sub != 2) {
#pragma unroll
                        for (int j = 0; j < 4; ++j) { a0[j] *= __builtin_amdgcn_rcpf((float)((wb[m][bj].x >> (8 * j)) & 0xffu)); a1[j] *= __builtin_amdgcn_rcpf((float)((wb[m][bj].y >> (8 * j)) & 0xffu)); } }
                    acc[ai][bj][m][0] = acc[ai][bj][m][0] * a0; acc[ai][bj][m][1] = acc[ai][bj][m][1] * a1;
                    if (sub == 2) { constexpr float sc = M8_SCALE / (O8_SCALE * W8_SCALE * 255.f); const f32x4 v0 = acc[ai][bj][m][0] * sc, v1 = acc[ai][bj][m][1] * sc;
                        u32x2 w; w.x = pack4_e4m3(v0[0], v0[1], v0[2], v0[3]); w.y = pack4_e4m3(v1[0], v1[1], v1[2], v1[3]); *(u32x2*)(O + row * D + col0 + bj * HALF) = w; } } }
        }
    }
};
struct EpiY {
    static constexpr bool PERM = true;
    bf16_t* Z; const bf16_t* XB;
    __device__ __forceinline__ bool keep(const Unit&) const { return false; }
    __device__ __forceinline__ void operator()(f32x4 (&acc)[2][2][4][2], const Unit& u, int wr, int wc, int fr, int fq) const {
        const int row0 = u.pm * BM + wr * 64 + fr, col0 = u.pn * BM + wc * 32 + 8 * fq;
        u32x4 xv[2][4][2];
#pragma unroll
        for (int ai = 0; ai < 2; ++ai)
#pragma unroll
            for (int m = 0; m < 4; ++m) { const size_t off = (size_t)(row0 + ai * HALF + m * 16) * D + col0;
#pragma unroll
                for (int bj = 0; bj < 2; ++bj) xv[ai][m][bj] = *(const u32x4*)(XB + off + bj * HALF); }
#pragma unroll
        for (int ai = 0; ai < 2; ++ai)
#pragma unroll
            for (int m = 0; m < 4; ++m) { const size_t off = (size_t)(row0 + ai * HALF + m * 16) * D + col0;
#pragma unroll
                for (int bj = 0; bj < 2; ++bj) { f32x4 x0, x1; unpack8(xv[ai][m][bj], x0, x1);
                    *(u32x4*)(Z + off + bj * HALF) = pack8(x0 * ALPHA + acc[ai][bj][m][0] * (1.f / (M8_SCALE * W8_SCALE)), x1 * ALPHA + acc[ai][bj][m][1] * (1.f / (M8_SCALE * W8_SCALE))); } }
    }
};
struct EpiRouter {
    static constexpr bool PERM = true;
    float* logits;
    __device__ __forceinline__ bool keep(const Unit&) const { return false; }
    __device__ __forceinline__ void operator()(f32x4 (&acc)[2][2][4][2], const Unit& u, int wr, int wc, int fr, int fq) const {
        const int row0 = u.pm * BM + wr * 64 + fr, c8 = wc * 32 + 8 * fq;
        EPI_FOR_AI_M { float* rowp = logits + (size_t)(row0 + ai * HALF + m * 16) * NE + c8;
#pragma unroll
            for (int bj = 0; bj < 2; ++bj) { *(f32x4*)(rowp + bj * HALF) = acc[ai][bj][m][0]; *(f32x4*)(rowp + bj * HALF + 4) = acc[ai][bj][m][1]; } }
    }
};
struct EpiShared8 {
    static constexpr bool PERM = true;
    unsigned char* HS;
    __device__ __forceinline__ bool keep(const Unit&) const { return false; }
    __device__ __forceinline__ void operator()(f32x4 (&acc)[2][2][4][2], const Unit& u, int wr, int wc, int fr, int fq) const {
        const int row0 = u.pm * BM + wr * 64 + fr, c8 = wc * 32 + 8 * fq;
        EPI_FOR_AI_M { f32x4 h0, h1;
#pragma unroll
            for (int j = 0; j < 4; ++j) { h0[j] = silu_mul(acc[ai][0][m][0][j] * W8_INV, acc[ai][1][m][0][j] * (W8_INV * H8_SCALE)); h1[j] = silu_mul(acc[ai][0][m][1][j] * W8_INV, acc[ai][1][m][1][j] * (W8_INV * H8_SCALE)); }
            u32x2 w; w.x = pack4_e4m3(h0[0], h0[1], h0[2], h0[3]); w.y = pack4_e4m3(h1[0], h1[1], h1[2], h1[3]);
            *(u32x2*)(HS + (size_t)(row0 + ai * HALF + m * 16) * EFF + u.pn * HALF + c8) = w; }
    }
};
struct EpiExpGU {
    static constexpr bool PERM = true;
    bf16_t* H;
    __device__ __forceinline__ bool keep(const Unit&) const { return false; }
    __device__ __forceinline__ void operator()(f32x4 (&acc)[2][2][4][2], const Unit& u, int wr, int wc, int fr, int fq) const {
        const int c8 = wc * 32 + 8 * fq;
        EPI_FOR_AI_M { const int rl = ai * HALF + wr * 64 + m * 16 + fr; f32x4 h0, h1;
#pragma unroll
            for (int j = 0; j < 4; ++j) { h0[j] = silu_mul(acc[ai][0][m][0][j], acc[ai][1][m][0][j]); h1[j] = silu_mul(acc[ai][0][m][1][j], acc[ai][1][m][1][j]); }
            if (rl < u.nr) *(u32x4*)(H + (size_t)(u.pm + rl) * EFF + u.pn * HALF + c8) = pack8(h0, h1); }
    }
};
struct EpiExpGU8 {
    static constexpr bool PERM = true;
    unsigned char* H;
    __device__ __forceinline__ bool keep(const Unit&) const { return false; }
    __device__ __forceinline__ void operator()(f32x4 (&acc)[2][2][4][2], const Unit& u, int wr, int wc, int fr, int fq) const {
        const int c8 = wc * 32 + 8 * fq;
        EPI_FOR_AI_M { const int rl = ai * HALF + wr * 64 + m * 16 + fr; f32x4 h0, h1;
#pragma unroll
            for (int j = 0; j < 4; ++j) { h0[j] = silu_mul(acc[ai][0][m][0][j] * W8_INV, acc[ai][1][m][0][j] * (W8_INV * H8_SCALE)); h1[j] = silu_mul(acc[ai][0][m][1][j] * W8_INV, acc[ai][1][m][1][j] * (W8_INV * H8_SCALE)); }
            if (rl < u.nr) { u32x2 w; w.x = pack4_e4m3(h0[0], h0[1], h0[2], h0[3]); w.y = pack4_e4m3(h1[0], h1[1], h1[2], h1[3]);
                *(u32x2*)(H + (size_t)(u.pm + rl) * EFF + u.pn * HALF + c8) = w; } }
    }
};
__device__ __forceinline__ unsigned pack4_fp8(const f32x4& v) {
    const float a = fminf(fmaxf(v[0] * YS_SCALE, -448.f), 448.f), b = fminf(fmaxf(v[1] * YS_SCALE, -448.f), 448.f), c = fminf(fmaxf(v[2] * YS_SCALE, -448.f), 448.f), d = fminf(fmaxf(v[3] * YS_SCALE, -448.f), 448.f);
    unsigned w = __builtin_amdgcn_cvt_pk_fp8_f32(a, b, 0u, false); return __builtin_amdgcn_cvt_pk_fp8_f32(c, d, w, true);
}
struct EpiExpDown {
    static constexpr bool PERM = true;
    unsigned char* Y; float sc;
    __device__ __forceinline__ bool keep(const Unit&) const { return false; }
    __device__ __forceinline__ void operator()(f32x4 (&acc)[2][2][4][2], const Unit& u, int wr, int wc, int fr, int fq) const {
        const int col0 = u.pn * BM + wc * 32 + 8 * fq;
        EPI_FOR_AI_M { const int rl = ai * HALF + wr * 64 + m * 16 + fr;
            if (rl < u.nr) { unsigned char* rowp = Y + (size_t)(u.pm + rl) * D + col0;
#pragma unroll
                for (int bj = 0; bj < 2; ++bj) { u32x2 w; w.x = pack4_fp8(acc[ai][bj][m][0] * sc); w.y = pack4_fp8(acc[ai][bj][m][1] * sc); *(u32x2*)(rowp + bj * HALF) = w; } } }
    }
};
struct ExpertOrder {
    const PG8_LAS int* offs; const PG8_LAS int* cnt; const PG8_LAS unsigned short* tmap;
    int nN, nwg, G, c; unsigned A; const int* rows; unsigned arow; unsigned Bb, bexp, bstep;
    __device__ __forceinline__ bool next(int i, Unit& u) const {
        const long L = (long)i * G + c; if (L >= nwg) return false;
        int wgid = (int)L; { const int q = nwg / NXCD, r = nwg % NXCD, xcd = wgid % NXCD, off = wgid / NXCD; wgid = (xcd < r ? xcd * (q + 1) : r * (q + 1) + (xcd - r) * q) + off; }
        const int tile = wgid / nN; u.pn = wgid % nN;
        const int tm = __builtin_amdgcn_readfirstlane((int)tmap[tile]); const int e = tm >> 7, ti = tm & 127;
        const int ce = __builtin_amdgcn_readfirstlane(cnt[e]), oe = __builtin_amdgcn_readfirstlane(offs[e]);
        u.aux = e; u.pm = oe + 256 * ti; u.nr = (ce - 256 * ti) < 256 ? (ce - 256 * ti) : 256;
        u.A = rows ? A : A + (unsigned)u.pm * arow; u.B = Bb + (unsigned)u.aux * bexp + (unsigned)u.pn * bstep; return true;
    }
    __device__ __forceinline__ int row_index(const Unit& u, int r) const { return rows[u.pm + r]; }
};
__device__ __forceinline__ int build_tile_map(const unsigned* counts, PG8_LAS int* tab, int tid) {
    PG8_LAS int* offs = tab; PG8_LAS int* cnt = tab + 256; PG8_LAS unsigned short* tmap = (PG8_LAS unsigned short*)(tab + 512); PG8_LAS int* tot = tab + 512 + 640;
    if (tid < 256) cnt[tid] = (int)__hip_atomic_load(&counts[tid], __ATOMIC_RELAXED, __HIP_MEMORY_SCOPE_AGENT);
    __syncthreads();
    if (tid < 256) { int o = 0, t0 = 0; for (int j = 0; j < tid; ++j) { o += cnt[j]; t0 += (cnt[j] + 255) >> 8; }
        offs[tid] = o; const int nt = (cnt[tid] + 255) >> 8;
        for (int i = 0; i < nt; ++i) tmap[t0 + i] = (unsigned short)((tid << 7) | i);
        if (tid == 255) tot[0] = t0 + nt; }
    __syncthreads();
    return tot[0];
}

__device__ __forceinline__ void down_phase(PG8_LAS unsigned char* lds, unsigned char* wsbase, const PG8_LAS int* offs, const PG8_LAS int* cnt, const PG8_LAS int* srt, const int G, const int c, const unsigned Abase, const unsigned Bbase, const unsigned Ybase, const unsigned dump0, const float sc, const int wave, const int probe  ) {
    const __amdgpu_buffer_rsrc_t rsrc = __builtin_amdgcn_make_buffer_rsrc((void*)wsbase, 0, 0x7fffffff, 0x00020000);
    const int tid = otid(wave), wid = wave, lane = tid & 63, wr = wid >> 2, wc = wid & 3, fr = lane & 15, fq = lane >> 4;
    constexpr unsigned ROWB = EFF;
    unsigned voffA[2];
#pragma unroll
    for (int i = 0; i < 2; ++i) { int R, C; stage_rc(tid * 16 + i * 8192, R, C); voffA[i] = (unsigned)R * ROWB + (unsigned)C * 2u; }
    const unsigned ldsw = (unsigned)wid * 1024u, ldsb = (unsigned)(size_t)lds;
    const int aoff8 = lds_byte(wr * 64 + fr, fq * 16);
#define DN_LOAD(ldsoff, goff, voff) do { _Pragma("unroll") for (int _i = 0; _i < 2; ++_i) \
        asm volatile("s_mov_b32 m0, %0\n\ts_nop 0\n\tbuffer_load_dwordx4 %1, %2, %3 offen lds" :: "s"(ldsb + (unsigned)(ldsoff) + ldsw + (unsigned)(_i * 8192)), "v"((voff)[_i]), "s"(rsrc), "s"((unsigned)(goff)) : "m0", "memory"); } while (0)
#define DN_STAGE_A(st) do { if (probe == 3) break; const int _s = (st) < nst ? (st) : nst - 1; const unsigned _g = arow0 + (unsigned)_s * (128u * ROWB); const unsigned _l = (unsigned)((st) & 3) * 32768u; \
        DN_LOAD(_l, _g, voffA); DN_LOAD(_l + 16384u, _g + 128u, voffA); } while (0)
#define DN_WAIT(n) asm volatile("s_waitcnt vmcnt(" #n ")" ::: "memory")
#define DN_BAR __builtin_amdgcn_s_barrier()
    for (int it = 0;; ++it) {
        const int L = it * G + c; if (L >= NE * 4) break;
        int e, pn;
        if (G == 256) { const int g = (c & 7) + 8 * (c >> 5); pn = (c >> 3) & 3; e = __builtin_amdgcn_readfirstlane(srt[it * 64 + ((it & 1) ? 63 - g : g)]); }
        else { const int x = L & 7, j = L >> 3; e = ((j >> 2) << 3) | x; pn = j & 3; }
        const int ce = __builtin_amdgcn_readfirstlane(cnt[e]), oe = __builtin_amdgcn_readfirstlane(offs[e]);
        if (ce <= 0) continue;
        const int nst = (ce + 127) >> 7;
        const unsigned arow0 = Abase + (unsigned)oe * ROWB;
        const unsigned b0 = Bbase + (unsigned)e * (unsigned)(D * EFF) + (unsigned)pn * (256u * ROWB);
        unsigned voffB[2]; int boff8;
        { const int t2 = otid(wave), l2 = t2 & 63;
#pragma unroll
          for (int i = 0; i < 2; ++i) { int R, C; stage_rc(t2 * 16 + i * 8192, R, C); const int Rb = (R >> 5) * 64 + 16 * ((R & 15) >> 2) + 4 * ((R >> 4) & 1) + (R & 3); voffB[i] = (unsigned)Rb * ROWB + (unsigned)C * 2u; }
          boff8 = lds_byte(wc * 32 + (l2 & 15), (l2 >> 4) * 16); }
#pragma unroll
        for (int b = 0; b < 2; ++b)
#pragma unroll
            for (int h = 0; h < 2; ++h) DN_LOAD(65536u + (unsigned)(b * 2 + h) * 16384u, b0 + (unsigned)h * (8u * ROWB) + (unsigned)b * 128u, voffB);
        DN_STAGE_A(0); DN_STAGE_A(1);
        DN_WAIT(8); DN_BAR;
        i32x8 Bf[2][2][2];
#pragma unroll
        for (int b = 0; b < 2; ++b)
#pragma unroll
            for (int bj = 0; bj < 2; ++bj)
#pragma unroll
                for (int n = 0; n < 2; ++n) Bf[b][bj][n] = *(const PG8_LAS i32x8_a16*)(lds + 65536 + (b * 2 + bj) * 16384 + boff8 + n * 2048);
        asm volatile("s_waitcnt lgkmcnt(0)" ::: "memory");
#pragma unroll
        for (int b = 0; b < 2; ++b)
#pragma unroll
            for (int bj = 0; bj < 2; ++bj)
#pragma unroll
                for (int n = 0; n < 2; ++n) asm volatile("" : "+v"(Bf[b][bj][n]));
        DN_BAR;
        DN_STAGE_A(2); DN_STAGE_A(3);
        f32x4 acc[2][4][2];
#pragma unroll
        for (int bj = 0; bj < 2; ++bj)
#pragma unroll
            for (int m = 0; m < 4; ++m)
#pragma unroll
                for (int n = 0; n < 2; ++n) acc[bj][m][n] = (f32x4){0.f, 0.f, 0.f, 0.f};
#define DN_MFMA(st) do { const int _q = (st) & 3; const f32x4 _z = {0.f, 0.f, 0.f, 0.f}; if (probe == 2) { _Pragma("unroll") for (int bj = 0; bj < 2; ++bj) _Pragma("unroll") for (int m = 0; m < 4; ++m) _Pragma("unroll") for (int n = 0; n < 2; ++n) acc[bj][m][n] = _z; break; } \
        { i32x8 At[4]; \
          _Pragma("unroll") for (int m = 0; m < 4; ++m) At[m] = *(const PG8_LAS i32x8_a16*)(lds + _q * 32768 + aoff8 + m * 2048); \
          __builtin_amdgcn_s_setprio(1); \
          _Pragma("unroll") for (int bj = 0; bj < 2; ++bj) _Pragma("unroll") for (int m = 0; m < 4; ++m) _Pragma("unroll") for (int n = 0; n < 2; ++n) \
              acc[bj][m][n] = __builtin_amdgcn_mfma_scale_f32_16x16x128_f8f6f4(Bf[0][bj][n], At[m], _z, 0, 0, 0, 0x7F7F7F7F, 0, 0x7F7F7F7F);     \
          __builtin_amdgcn_s_setprio(0); __builtin_amdgcn_sched_barrier(0); } \
        { i32x8 At[4]; \
          _Pragma("unroll") for (int m = 0; m < 4; ++m) At[m] = *(const PG8_LAS i32x8_a16*)(lds + _q * 32768 + 16384 + aoff8 + m * 2048); \
          __builtin_amdgcn_s_setprio(1); \
          _Pragma("unroll") for (int bj = 0; bj < 2; ++bj) _Pragma("unroll") for (int m = 0; m < 4; ++m) _Pragma("unroll") for (int n = 0; n < 2; ++n) \
              acc[bj][m][n] = __builtin_amdgcn_mfma_scale_f32_16x16x128_f8f6f4(Bf[1][bj][n], At[m], acc[bj][m][n], 0, 0, 0, 0x7F7F7F7F, 0, 0x7F7F7F7F); \
          __builtin_amdgcn_s_setprio(0); __builtin_amdgcn_sched_barrier(0); } } while (0)
#define DN_EPI(st) do { const int _l = lane_id(), _fr = _l & 15, _fq = _l >> 4;     \
        const int _r0 = (st) * 128 + wr * 64 + _fr; const unsigned _y0 = Ybase + (unsigned)(oe + _r0) * (unsigned)D + (unsigned)(pn * 256 + wc * 64 + 16 * _fq); const unsigned dump = dump0 + (unsigned)(wid * 64 + _l) * 16u; \
        _Pragma("unroll") for (int m = 0; m < 4; ++m) { const bool _ok = (_r0 + 16 * m) < ce && probe != 1; u32x4 w; \
            { const f32x4 v0 = acc[0][m][0] * sc, v1 = acc[0][m][1] * sc, v2 = acc[1][m][0] * sc, v3 = acc[1][m][1] * sc; \
              w.x = pack4_e4m3(v0[0], v0[1], v0[2], v0[3]); w.y = pack4_e4m3(v1[0], v1[1], v1[2], v1[3]); w.z = pack4_e4m3(v2[0], v2[1], v2[2], v2[3]); w.w = pack4_e4m3(v3[0], v3[1], v3[2], v3[3]); } \
            const unsigned _o = _ok ? _y0 + (unsigned)(16 * m) * (unsigned)D : dump; \
            __builtin_amdgcn_raw_buffer_store_b128(w, rsrc, (int)_o, 0, 0); } } while (0)
#define DN_STEP_HEAD(s) do { if ((s) >= 4) DN_WAIT(20); else if ((s) == 3) DN_WAIT(16); else if ((s) == 2) DN_WAIT(12); else if ((s) == 1) DN_WAIT(8); else DN_WAIT(12);     \
            DN_BAR; \
            if ((s) >= 1) DN_STAGE_A((s) + 3);                           } while (0)
        if (wr == 0) {
            for (int s = 0; s < nst; ++s) { DN_STEP_HEAD(s); DN_MFMA(s); DN_BAR; DN_EPI(s); }
        } else {
            for (int s = 0; s < nst; ++s) { DN_STEP_HEAD(s); if (s >= 1) { DN_EPI(s - 1); } DN_BAR; DN_MFMA(s); }
            DN_EPI(nst - 1);
        }
#undef DN_STEP_HEAD
        DN_WAIT(0); DN_BAR;
    }
#undef DN_LOAD
#undef DN_STAGE_A
#undef DN_WAIT
#undef DN_BAR
#undef DN_MFMA
#undef DN_EPI
}
}
namespace att {
#define ALAS __attribute__((address_space(3)))
typedef short s16x4 __attribute__((ext_vector_type(4)));
constexpr int KSLOT = 16384, VSLOT = 16384, LDS_K = 0, LDS_V = 2 * KSLOT, LDS_FLAG = 4 * KSLOT;
enum { SB = 0, SWA = 1, MEM = 2 };
__device__ __forceinline__ int crow(int r, int hi) { return (r & 3) + 8 * (r >> 2) + 4 * hi; }
__device__ __forceinline__ unsigned cvtpk(float lo, float hi) { typedef float f2 __attribute__((ext_vector_type(2))); typedef __bf16 b2 __attribute__((ext_vector_type(2))); f2 v = {lo, hi}; b2 b = __builtin_convertvector(v, b2); return __builtin_bit_cast(unsigned, b); }
__device__ __forceinline__ float xhalf(float v) { return __shfl_xor(v, 32); }
__device__ __forceinline__ s16x4 vtr(const ALAS char* p) { typedef short v4i16_t __attribute__((ext_vector_type(4))); return __builtin_bit_cast(s16x4, __builtin_amdgcn_ds_read_tr16_b64_v4i16((ALAS v4i16_t*)p)); }

__device__ __forceinline__ void att_bar() { asm volatile("s_waitcnt lgkmcnt(0)" ::: "memory"); __builtin_amdgcn_s_barrier(); asm volatile("" ::: "memory"); }
template <int HD> struct Stage { u32x4 k[HD / 64], v[HD / 64]; };
template <int HD> __device__ __forceinline__ void tile_load(Stage<HD>& s, const bf16* Kb, const bf16* Vb, int pitch, int kv0, int wid, int lane) {
#pragma unroll
    for (int i = 0; i < HD / 64; ++i) { const int p = wid + 8 * i;
        s.k[i] = *(const u32x4*)(Kb + (size_t)(kv0 + lane) * pitch + p * 8);
        s.v[i] = *(const u32x4*)(Vb + (size_t)(kv0 + 16 * (p & 3) + (lane >> 2)) * pitch + (p >> 2) * 32 + (lane & 3) * 8); }
}
template <int HD> __device__ __forceinline__ void tile_store(const Stage<HD>& s, ALAS char* lds, int slot, int wid, int lane) {
#pragma unroll
    for (int i = 0; i < HD / 64; ++i) { const int p = wid + 8 * i;
        *(ALAS u32x4*)(lds + LDS_K + slot * KSLOT + p * 1024 + lane * 16) = s.k[i];
        *(ALAS u32x4*)(lds + LDS_V + slot * VSLOT + p * 1024 + lane * 16) = s.v[i]; }
}
template <int HD> __device__ __forceinline__ void qkt(f32x16& p0, f32x16& p1, const ALAS char* Kslot, const bf16x8* qr, int r32, int hi) {
    const ALAS char* kb = Kslot + hi * 1024 + r32 * 16;
#pragma unroll
    for (int r = 0; r < 16; ++r) { p0[r] = 0.f; p1[r] = 0.f; }
#pragma unroll
    for (int h0 = 0; h0 < HD / 16; h0 += 4) {
        bf16x8 kf[8];
#pragma unroll
        for (int d = 0; d < 4; ++d) { kf[2 * d] = *(const ALAS bf16x8*)(kb + (h0 + d) * 2048); kf[2 * d + 1] = *(const ALAS bf16x8*)(kb + (h0 + d) * 2048 + 512); }
        __builtin_amdgcn_sched_barrier(0);
#pragma unroll
        for (int d = 0; d < 4; ++d) { p0 = __builtin_amdgcn_mfma_f32_32x32x16_bf16(kf[2 * d], qr[h0 + d], p0, 0, 0, 0); p1 = __builtin_amdgcn_mfma_f32_32x32x16_bf16(kf[2 * d + 1], qr[h0 + d], p1, 0, 0, 0); }
        __builtin_amdgcn_sched_barrier(0);
    }
}
template <int HD> __device__ __forceinline__ void pvT(f32x16* oT, const ALAS char* Vslot, const u32x4* pw, int lane) {
    const int hi = lane >> 5;
    const ALAS char* vb = Vslot + ((lane >> 4) & 1) * 32 + (lane & 3) * 8 + (4 * hi + ((lane & 15) >> 2)) * 64;
#pragma unroll
    for (int dd = 0; dd < HD / 32; dd += 2) {
        s16x4 lo[2][4], h4[2][4];
#pragma unroll
        for (int e = 0; e < 2; ++e)
#pragma unroll
            for (int ks = 0; ks < 4; ++ks) { lo[e][ks] = vtr(vb + (dd + e) * 4096 + ks * 1024); h4[e][ks] = vtr(vb + (dd + e) * 4096 + ks * 1024 + 512); }
        __builtin_amdgcn_sched_barrier(0);
#pragma unroll
        for (int ks = 0; ks < 4; ++ks)
#pragma unroll
            for (int e = 0; e < 2; ++e) {
                const bf16x8 vf = (bf16x8){lo[e][ks][0], lo[e][ks][1], lo[e][ks][2], lo[e][ks][3], h4[e][ks][0], h4[e][ks][1], h4[e][ks][2], h4[e][ks][3]};
                oT[dd + e] = __builtin_amdgcn_mfma_f32_32x32x16_bf16(vf, __builtin_bit_cast(bf16x8, pw[ks]), oT[dd + e], 0, 0, 0); }
        __builtin_amdgcn_sched_barrier(0);
    }
}
__device__ __forceinline__ void pack_p(u32x4* pw, const f32x16& p0, const f32x16& p1) {
#pragma unroll
    for (int i = 0; i < 4; ++i) { pw[0][i] = cvtpk(p0[2 * i], p0[2 * i + 1]); pw[1][i] = cvtpk(p0[8 + 2 * i], p0[9 + 2 * i]); pw[2][i] = cvtpk(p1[2 * i], p1[2 * i + 1]); pw[3][i] = cvtpk(p1[8 + 2 * i], p1[9 + 2 * i]); }
}
__device__ __forceinline__ void sb_tile(f32x16& p0, f32x16& p1, float& Pc, bool masked, int qpos, int kv0, int hi) {
    float gm[32];
#pragma unroll
    for (int r = 0; r < 32; ++r) { const float z = fminf(r < 16 ? p0[r] : p1[r - 16], 100.f);
        const float e = __builtin_amdgcn_exp2f(z); float g = __builtin_amdgcn_rcpf(1.f + e), bt = e * g;
        if (masked) { const int kv = kv0 + crow(r & 15, hi) + (r >> 4) * 32; const bool ok = kv < qpos; g = ok ? g : 1.f; bt = ok ? bt : 0.f; }
        gm[r] = g; if (r < 16) p0[r] = bt; else p1[r - 16] = bt; }
    float suf[9]; suf[8] = 1.f;
#pragma unroll
    for (int g = 7; g >= 0; --g) suf[g] = suf[g + 1] * ((gm[4 * g] * gm[4 * g + 1]) * (gm[4 * g + 2] * gm[4 * g + 3]));
    float psuf[9]; psuf[8] = 1.f;
#pragma unroll
    for (int g = 0; g < 8; ++g) psuf[g] = xhalf(suf[g]);
#pragma unroll
    for (int g = 0; g < 8; ++g) {
        float run = Pc * suf[g + 1] * (hi ? psuf[g + 1] : psuf[g]);
#pragma unroll
        for (int i = 3; i >= 0; --i) { const int r = 4 * g + i;
            if (r < 16) p0[r] *= run; else p1[r - 16] *= run;
            run *= gm[r]; } }
    Pc *= suf[0] * psuf[0];
}

template <int MODE, int ND> __device__ __forceinline__ void soft_tile_(f32x16& p0, f32x16& p1, float& m, float& l, f32x16 (&oT)[ND], float slope, int qpos, int kv0, int hi) {
    float rm = -1e30f;
    if (MODE == SWA) {
#pragma unroll
        for (int r = 0; r < 32; ++r) { const int kv = kv0 + crow(r & 15, hi) + (r >> 4) * 32; const int dist = qpos - kv; const bool valid = dist >= 0 && dist < 128;
            const float z = (r < 16 ? p0[r] : p1[r - 16]) - slope * (float)dist; const float zz = valid ? z : -1e30f;
            if (r < 16) p0[r] = zz; else p1[r - 16] = zz; rm = fmaxf(rm, zz); }
    } else {
#pragma unroll
        for (int r = 0; r < 16; ++r) rm = fmaxf(rm, fmaxf(p0[r], p1[r]));
    }
    rm = fmaxf(rm, xhalf(rm));
    const float mn = fmaxf(m, rm), f = __builtin_amdgcn_exp2f(m - mn); m = mn;
    float ps = 0.f;
#pragma unroll
    for (int r = 0; r < 16; ++r) { p0[r] = __builtin_amdgcn_exp2f(p0[r] - mn); p1[r] = __builtin_amdgcn_exp2f(p1[r] - mn); ps += p0[r] + p1[r]; }
    ps += xhalf(ps);
    l = l * f + ps;
#pragma unroll
    for (int d0 = 0; d0 < ND; ++d0)
#pragma unroll
        for (int r = 0; r < 16; ++r) oT[d0][r] *= f;
}
template <int MODE> __device__ __forceinline__ void soft_tile(f32x16& p0, f32x16& p1, float& m, float& l, f32x16 (&oT)[2], float slope, int qpos, int kv0, int hi) { soft_tile_<MODE, 2>(p0, p1, m, l, oT, slope, qpos, kv0, hi); }
template <int MODE> __device__ __forceinline__ void soft_tile(f32x16& p0, f32x16& p1, float& m, float& l, f32x16 (&oT)[4], float slope, int qpos, int kv0, int hi) { soft_tile_<MODE, 4>(p0, p1, m, l, oT, slope, qpos, kv0, hi); }

struct Params { const bf16* projb; const bf16* mkvb; const float* sinks; unsigned char* osb; unsigned char* osw; unsigned char* om; };

template <int MODE> __device__ __forceinline__ void unit(ALAS char* lds, const Params& P, int b, int h, int qb, const int wid) {
    constexpr int HD = (MODE == MEM) ? 128 : 64;
    const int tid = otid(wid), lane = tid & 63, r32 = lane & 31, hi = lane >> 5;
    const int hq = (MODE == SWA) ? 4 * h + (wid >> 1) : h;
    const int q0 = (MODE == SWA) ? qb * 64 : qb * 256, qw0 = (MODE == SWA) ? q0 + 32 * (wid & 1) : q0 + 32 * wid, qpos = qw0 + r32;
    const bf16* Qb; const bf16* Kb; const bf16* Vb; unsigned char* Ob; int kpitch;
    if (MODE == SB)       { Qb = P.projb + (size_t)b * SEQ * IN_COLS + OFF_QSB + h * 64; Kb = P.projb + (size_t)b * SEQ * IN_COLS + OFF_KSB + h * 64; Vb = P.projb + (size_t)b * SEQ * IN_COLS + OFF_VSB + h * 64; Ob = P.osb + (size_t)b * SEQ * 512 + h * 64; kpitch = IN_COLS; }
    else if (MODE == SWA) { Qb = P.projb + (size_t)b * SEQ * IN_COLS + OFF_QSW + hq * 64; Kb = P.projb + (size_t)b * SEQ * IN_COLS + OFF_KSW + h * 64; Vb = P.projb + (size_t)b * SEQ * IN_COLS + OFF_VSW + h * 64; Ob = P.osw + (size_t)b * SEQ * 512 + hq * 64; kpitch = IN_COLS; }
    else                  { Qb = P.projb + (size_t)b * SEQ * IN_COLS + OFF_QM + h * 128; Kb = P.mkvb + (size_t)b * MEM_LEN * 1024 + h * 128; Vb = P.mkvb + (size_t)b * MEM_LEN * 1024 + 512 + h * 128; Ob = P.om + (size_t)b * SEQ * 512 + h * 128; kpitch = 1024; }
    int jlo, jhi;
    if (MODE == SB) { jlo = 0; jhi = 4 * qb + 3; } else if (MODE == SWA) { jlo = qb - 2; if (jlo < 0) jlo = 0; jhi = qb; } else { jlo = 0; jhi = 3; }
    const int ntile = jhi - jlo + 1, dj = (MODE == SB) ? -1 : 1, jfirst = (MODE == SB) ? jhi : jlo;
    Stage<HD> stA, stB;
    tile_load<HD>(stA, Kb, Vb, kpitch, jfirst * 64, wid, lane);
    tile_load<HD>(stB, Kb, Vb, kpitch, (jfirst + (ntile > 1 ? dj : 0)) * 64, wid, lane);
    bf16x8 qr[HD / 16];
#pragma unroll
    for (int d0 = 0; d0 < HD / 16; ++d0) qr[d0] = *(const bf16x8*)(Qb + (size_t)qpos * IN_COLS + d0 * 16 + hi * 8);
    f32x16 oT[HD / 32];
#pragma unroll
    for (int d0 = 0; d0 < HD / 32; ++d0)
#pragma unroll
        for (int r = 0; r < 16; ++r) oT[d0][r] = 0.f;
    float C = 1.f;
    float m = (MODE == SWA) ? P.sinks[hq] * LOG2E : -1e30f, l = (MODE == SWA) ? 1.f : 0.f;
    const float slope = (MODE == SWA) ? exp2f(-(float)(hq + 1)) * LOG2E : 0.f;
    tile_store<HD>(stA, lds, 0, wid, lane);
#pragma unroll
    for (int d0 = 0; d0 < HD / 16; ++d0) asm volatile("" : "+v"(qr[d0]));
    att_bar();
    bool stop = false;
    ALAS unsigned* dflag = (ALAS unsigned*)(lds + LDS_FLAG + 64);
#define ATT_STEP(it, SLOT, ST_LOAD, ST_STORE) do { \
        const int j = jfirst + (it) * dj, kv0 = j * 64; \
        tile_load<HD>(ST_LOAD, Kb, Vb, kpitch, ((it) + 2 < ntile ? j + 2 * dj : j) * 64, wid, lane);     \
        bool active = true; \
        if (MODE == SB) active = (kv0 <= qw0 + 30) && !__all(C == 0.f);     \
        else if (MODE == SWA) active = (kv0 <= qw0 + 31) && (kv0 + 63 >= qw0 - 127); \
        if (active) { \
            f32x16 p0, p1; \
            qkt<HD>(p0, p1, lds + LDS_K + (SLOT) * KSLOT, qr, r32, hi); \
            if (MODE == SB) { sb_tile(p0, p1, C, kv0 + 63 >= qw0, qpos, kv0, hi); } \
            else { soft_tile<MODE>(p0, p1, m, l, oT, slope, qpos, kv0, hi); } \
            u32x4 pw[4]; pack_p(pw, p0, p1); \
            pvT<HD>(oT, lds + LDS_V + (SLOT) * VSLOT, pw, lane); \
        } \
        tile_store<HD>(ST_STORE, lds, (SLOT) ^ 1, wid, lane); \
        if (MODE == SB) { const int wdone = __all(C == 0.f) ? 1 : 0; if (lane == 0) dflag[((it) & 1) * 8 + wid] = (unsigned)wdone; \
                          att_bar(); \
                          const ALAS u32x4* df = (const ALAS u32x4*)(dflag + ((it) & 1) * 8); const u32x4 f0 = df[0], f1 = df[1]; \
                          if ((f0.x & f0.y & f0.z & f0.w & f1.x & f1.y & f1.z & f1.w) != 0u) stop = true; } \
        else att_bar(); \
    } while (0)
    for (int it = 0; it < ntile && !stop; it += 2) {
        ATT_STEP(it, 0, stA, stB);
        if (stop || it + 1 >= ntile) break;
        ATT_STEP(it + 1, 1, stB, stA);
    }
#undef ATT_STEP
    const float inv = (MODE == SB) ? O8_SCALE : O8_SCALE / l;
    unsigned char* orow = Ob + (size_t)qpos * 512 + 32 * hi;
#pragma unroll
    for (int dp = 0; dp < HD / 64; ++dp) { u32x4 w0, w1; unsigned pk[8];
#pragma unroll
        for (int g = 0; g < 4; ++g) {
            const unsigned P_ = pack4_e4m3(oT[2 * dp][4 * g] * inv, oT[2 * dp][4 * g + 1] * inv, oT[2 * dp][4 * g + 2] * inv, oT[2 * dp][4 * g + 3] * inv);
            const unsigned Q_ = pack4_e4m3(oT[2 * dp + 1][4 * g] * inv, oT[2 * dp + 1][4 * g + 1] * inv, oT[2 * dp + 1][4 * g + 2] * inv, oT[2 * dp + 1][4 * g + 3] * inv);
            const auto sw = __builtin_amdgcn_permlane32_swap(P_, Q_, false, false);
            pk[2 * g] = sw[0]; pk[2 * g + 1] = sw[1]; }
        w0.x = pk[0]; w0.y = pk[1]; w0.z = pk[2]; w0.w = pk[3]; w1.x = pk[4]; w1.y = pk[5]; w1.z = pk[6]; w1.w = pk[7];
        *(u32x4*)(orow + 64 * dp) = w0; *(u32x4*)(orow + 64 * dp + 16) = w1; }
}

constexpr int NUNITS = 2560;
__device__ __forceinline__ void phase(ALAS char* lds, const Params& P, unsigned* queue, int ulo, int uhi, const int wave) {
    volatile ALAS int* flag = (volatile ALAS int*)(lds + LDS_FLAG);
    if (is_t0(wave)) { flag[0] = (int)atomicAdd(queue, 1u); }
    __syncthreads();
    int u = ulo + flag[0];
    for (int k = 0;; ++k) {
        if (u >= uhi) break;
        int tnext = 0; if (is_t0(wave)) tnext = (int)atomicAdd(queue, 1u);
        if (u < 512) { const int qb = u >> 5, bh = u & 31; unit<MEM>(lds, P, bh >> 2, bh & 3, qb, wave); }
        else if (u < 1536) { const int v = u - 512, qb = 15 - (v >> 6), bh = v & 63; unit<SB>(lds, P, bh >> 3, bh & 7, qb, wave); }
        else { const int v = u - 1536, qb = v >> 4, bh = v & 15; unit<SWA>(lds, P, bh >> 1, bh & 1, qb, wave); }
        if (is_t0(wave)) flag[(k + 1) & 1] = tnext;
        __syncthreads();
        u = ulo + flag[(k + 1) & 1];
    }
}
}
constexpr int NWAVES = 8;
constexpr int RING_BYTES = 131072, LDSCTL_OFF = RING_BYTES, MISC_OFF = LDSCTL_OFF + 320, BIAS_OFF = RING_BYTES + 1024  , LDS_BYTES = 147456;
constexpr int NPHASE = 12;
#ifndef CONV_CONTIG
#define CONV_CONTIG 0
#endif
#ifndef NCONV_WG
#define NCONV_WG 88
#endif
constexpr int NCONV = NCONV_WG;
#define GAS __attribute__((address_space(1)))
#define LAS __attribute__((address_space(3)))

#define XB_TMO      128
#define XB_XCNT(j)  (256  + 64 * (j))
#define XB_XSUB(j)  (1280 + 64 * (j))
#define XB_XGEN(j)  (2304 + 64 * (j))
#define XB_TOP      3328
#define XB_TOPGEN   3392
#define XCD_BAR_WORDS 3456
#define XB_SPIN_CAP (1u << 18)
__device__ __forceinline__ unsigned xb_ld(unsigned* p)              { return __hip_atomic_load(p, __ATOMIC_RELAXED, __HIP_MEMORY_SCOPE_AGENT); }
__device__ __forceinline__ unsigned xb_add(unsigned* p, unsigned v) { return __hip_atomic_fetch_add(p, v, __ATOMIC_RELAXED, __HIP_MEMORY_SCOPE_AGENT); }
__device__ __forceinline__ unsigned xb_xcc_id() { return (unsigned)__builtin_amdgcn_s_getreg((3 << 11) | 20) & 0xFu; }
#define XB_SPIN(cond, bar) do { unsigned _sp = 0; while (cond) { __builtin_amdgcn_s_sleep(1); \
    if ((++_sp & 255u) == 0u) { if (xb_ld(&(bar)[XB_TMO])) break; if (_sp > XB_SPIN_CAP) { atomicAdd(&(bar)[XB_TMO], 1u); break; } } } } while (0)
struct XcdBarrier { unsigned* bar; unsigned x; volatile LAS unsigned* st; int wave; };
__device__ __forceinline__ XcdBarrier xcd_barrier_post(unsigned* bar, volatile LAS unsigned* st, int wave) {
    XcdBarrier b; b.bar = bar; b.x = xb_xcc_id(); b.st = st; b.wave = wave;
    if (is_t0(wave)) (void)xb_add(&bar[XB_XCNT(b.x)], 1u);
    return b;
}
__device__ __forceinline__ void xcd_barrier_complete(unsigned* bar, unsigned x, unsigned& nloc, unsigned& nx) {
    const unsigned G = gridDim.x * gridDim.y * gridDim.z;
    unsigned sum, cnt, mine, sp = 0u;
    for (;;) {
        sum = 0u; cnt = 0u; mine = 0u;
#pragma unroll
        for (unsigned j = 0; j < 16; ++j) { const unsigned c = xb_ld(&bar[XB_XCNT(j)]); sum += c; cnt += (c > 0u) ? 1u : 0u; mine = (j == x) ? c : mine; }
        if (sum == G) break;
        __builtin_amdgcn_s_sleep(1);
        if ((++sp & 255u) == 0u) { if (xb_ld(&bar[XB_TMO])) break; if (sp > XB_SPIN_CAP) { atomicAdd(&bar[XB_TMO], 1u); break; } }
    }
    nloc = mine > 0u ? mine : 1u; nx = cnt > 0u ? cnt : 1u;
}
__device__ __forceinline__ void xcd_barrier(const XcdBarrier& b) {
    asm volatile("s_waitcnt vmcnt(0)" ::: "memory");
    __syncthreads();
    if (is_t0(b.wave)) {
        unsigned* bar = b.bar;
        __builtin_amdgcn_s_waitcnt(0);
        unsigned nloc = b.st[0], nx = b.st[1];
        if (nloc == 0u) { xcd_barrier_complete(bar, b.x, nloc, nx); b.st[0] = nloc; b.st[1] = nx; }
        const unsigned old = xb_add(&bar[XB_XSUB(b.x)], 1u);
        const unsigned gen = old / nloc;
        if (old + 1u == (gen + 1u) * nloc) {
            __builtin_amdgcn_fence(__ATOMIC_RELEASE, "agent");
            asm volatile("s_waitcnt vmcnt(0)" ::: "memory");
            const unsigned og = xb_add(&bar[XB_TOP], 1u);
            const unsigned tg = og / nx;
            if (og + 1u == (tg + 1u) * nx) xb_add(&bar[XB_TOPGEN], 1u);
            else XB_SPIN(xb_ld(&bar[XB_TOPGEN]) == tg, bar);
            __builtin_amdgcn_fence(__ATOMIC_ACQUIRE, "agent");
            xb_add(&bar[XB_XGEN(b.x)], 1u);
            asm volatile("s_waitcnt vmcnt(0)" ::: "memory");
        } else {
            XB_SPIN(xb_ld(&bar[XB_XGEN(b.x)]) == gen, bar);
            __builtin_amdgcn_fence(__ATOMIC_ACQUIRE, "agent");
            asm volatile("s_waitcnt vmcnt(0)" ::: "memory");
        }
    }
    __syncthreads();
}

struct TrItem { f32x4 v[8]; bf16* dst; int K; unsigned char* dst8; };
__device__ __forceinline__ void tr_issue(TrItem& t, const float* W, int K, int N, bf16* WT, int dst_row0, int k0, int n0, int lane, unsigned char* WT8 = nullptr) {
    const float* wp = W + (size_t)(k0 + (lane >> 3)) * N + n0 + 4 * (lane & 7);
#pragma unroll
    for (int i = 0; i < 8; ++i) t.v[i] = __builtin_nontemporal_load((const f32x4*)(wp + (size_t)(8 * i) * N));
    t.dst = WT + (size_t)dst_row0 * K + k0; t.K = K; t.dst8 = WT8 ? WT8 + (size_t)dst_row0 * K + k0 : nullptr;
}
__device__ __forceinline__ void tr_finish(const TrItem& t, LAS float* scr, int lane) {
#pragma unroll
    for (int i = 0; i < 8; ++i) { LAS float* p = scr + (8 * i + (lane >> 3)) * 33 + 4 * (lane & 7); p[0] = t.v[i][0]; p[1] = t.v[i][1]; p[2] = t.v[i][2]; p[3] = t.v[i][3]; }
    asm volatile("s_waitcnt lgkmcnt(0)" ::: "memory");
    const int c = lane & 7;
    if (t.dst8) {
#pragma unroll
        for (int j = 0; j < 4; ++j) { const int n = (lane >> 3) + 8 * j; const LAS float* s = scr + (8 * c) * 33 + n;
            u32x2 o; o.x = pack4_e4m3(s[0 * 33] * W8_SCALE, s[1 * 33] * W8_SCALE, s[2 * 33] * W8_SCALE, s[3 * 33] * W8_SCALE); o.y = pack4_e4m3(s[4 * 33] * W8_SCALE, s[5 * 33] * W8_SCALE, s[6 * 33] * W8_SCALE, s[7 * 33] * W8_SCALE);
            __builtin_nontemporal_store(o, (u32x2*)(t.dst8 + (size_t)n * t.K + 8 * c)); }
    } else {
#pragma unroll
    for (int j = 0; j < 4; ++j) { const int n = (lane >> 3) + 8 * j; const LAS float* s = scr + (8 * c) * 33 + n;
        u32x4 o; o.x = pk2(s[0 * 33], s[1 * 33]); o.y = pk2(s[2 * 33], s[3 * 33]); o.z = pk2(s[4 * 33], s[5 * 33]); o.w = pk2(s[6 * 33], s[7 * 33]);
        __builtin_nontemporal_store(o, (u32x4*)(t.dst + (size_t)n * t.K + 8 * c)); }
    }
    asm volatile("s_waitcnt lgkmcnt(0)" ::: "memory");
}
__device__ __forceinline__ void p0_transpose_item(const float* W, int K, int N, bf16* WT, int dst_row0, LAS float* scr, int k0, int n0, int lane, unsigned char* WT8 = nullptr) {
    TrItem t; tr_issue(t, W, K, N, WT, dst_row0, k0, n0, lane, WT8); tr_finish(t, scr, lane);
}
__device__ __forceinline__ int map_gu(int n0) { return n0 < EFF ? 256 * (n0 >> 7) + (n0 & 127) : 256 * ((n0 - EFF) >> 7) + 128 + ((n0 - EFF) & 127); }

struct Args {
    const float *x, *mem, *w_in, *b_gate, *w_mem_kv, *sinks, *w_o_sb, *w_o_swa, *w_o_mem, *w_out, *ln1_g, *ln1_b, *w_router, *router_bias, *w_e_gu, *w_e_down, *w_s_gu, *w_s_down, *ln2_g, *ln2_b;
    float* out; unsigned char* ws; int ph_lo, ph_hi, li, pad;
};

__global__ void __launch_bounds__(NWAVES * 64, 2) mega_fwd(Args a) {
    extern __shared__ __attribute__((aligned(16))) unsigned char lds_raw[];
    LAS unsigned char* lds = (LAS unsigned char*)lds_raw;
    volatile LAS unsigned* MISC = (volatile LAS unsigned*)(lds + MISC_OFF);
    const int wave = __builtin_amdgcn_readfirstlane((int)threadIdx.x >> 6);
    const int G = gridDim.x, bx = blockIdx.x;
    const int vcu = (G % 8 == 0) ? (bx % 8) * (G / 8) + bx / 8 : bx;
    const int gw = vcu * NWAVES + wave, NGW = G * NWAVES;
    unsigned char* ws = a.ws;
    unsigned* ctl = (unsigned*)(ws + WS_CTL);
    for (int u = otid(wave); u < (LDS_BYTES - LDSCTL_OFF) / 4; u += NWAVES * 64) ((LAS unsigned*)(lds + LDSCTL_OFF))[u] = 0u;
    __syncthreads();
    XcdBarrier bar = xcd_barrier_post(ctl + CW_BAR + a.li * XCD_BAR_WORDS, MISC + 8, wave);
    const int lo = a.ph_lo, hi = a.ph_hi;
#define IN(k) (lo <= (k) && (k) < hi)
#define SEAM(k) do { if (IN(k) && IN((k) + 1)) xcd_barrier(bar); } while (0)
#define PH_BEGIN(k) if (IN(k)) { const int tid = otid(wave), lane = tid & 63; (void)tid; (void)lane;
#define PH_END(k) } SEAM(k);
    bf16* WIN_T = (bf16*)(ws + WS_WIN_T); bf16* WMKV_T = (bf16*)(ws + WS_WMKV_T); bf16* WOSB_T = (bf16*)(ws + WS_WOSB_T); bf16* WOSW_T = (bf16*)(ws + WS_WOSW_T); bf16* WOM_T = (bf16*)(ws + WS_WOM_T);
    bf16* WOUT_T = (bf16*)(ws + WS_WOUT_T); bf16* WRS_T = (bf16*)(ws + WS_WRS_T); bf16* WSD_T = (bf16*)(ws + WS_WSD_T); bf16* WEGU_T = (bf16*)(ws + WS_WEGU_T); bf16* WED_T = (bf16*)(ws + WS_WED_T);
    bf16* XB = (bf16*)(ws + WS_XB); bf16* MEMB = (bf16*)(ws + WS_MEMB); bf16* MKVB = (bf16*)(ws + WS_MKVB); bf16* PROJB = (bf16*)(ws + WS_PROJB);
    bf16* OSB = (bf16*)(ws + WS_OSB); bf16* OSW = (bf16*)(ws + WS_OSW); bf16* OM = (bf16*)(ws + WS_OM); bf16* MERGED = (bf16*)(ws + WS_MERGED);
    bf16* Z = (bf16*)(ws + WS_Z); bf16* X1B = (bf16*)(ws + WS_X1B); float* LOGITS = (float*)(ws + WS_LOGITS); bf16* HS = (bf16*)(ws + WS_HS); bf16* SHOUT = (bf16*)(ws + WS_SHOUT);
    int* IDX = (int*)(ws + WS_ROUTE + RT_IDX); float* WGT = (float*)(ws + WS_ROUTE + RT_WGT); int* POS = (int*)(ws + WS_ROUTE + RT_POS); int* STOK = (int*)(ws + WS_ROUTE + RT_STOK);
    int* TILES = (int*)(ws + WS_ROUTE + RT_TILES); int* TILES64 = (int*)(ws + WS_ROUTE + RT_TILES64);
    unsigned char* XB8 = ws + WS_XB8; unsigned char* X1B8 = ws + WS_X1B8; unsigned char* WG8_T = ws + WS_WG8_T;
    bf16* HBUF = (bf16*)(ws + WS_HBUF); unsigned char* YS = (unsigned char*)(ws + WS_YS);

    PH_BEGIN(0)
        LAS float* scr = (LAS float*)(lds + wave * 16384);
        constexpr int I_IN = 16 * 184, I_MKV = 16 * 32, I_O = 8 * 32, I_OUT = 16 * 32, I_SGU = 16 * 16, I_R = 16 * 8, I_SD = 4 * 32, I_EGU = 16 * 16, I_ED = 4 * 32;
        constexpr int SMALL = I_IN + I_MKV + 3 * I_O + I_OUT + I_SGU + I_R + I_SD, NITEMS = SMALL;
        for (int it = gw; it < SMALL; it += NGW) {
            int r = it;
            if (r < I_IN) { const int nb = r % 184, kb = r / 184;
                if (nb < 88) p0_transpose_item(a.w_in, D, IN_COLS, WIN_T, 32 * nb, scr, 64 * kb, 32 * nb, lane);
                else p0_transpose_item(a.w_in, D, IN_COLS, WIN_T, 32 * (nb - 88), scr, 64 * kb, 32 * nb, lane, WG8_T);
                continue; } r -= I_IN;
            if (r < I_MKV) { p0_transpose_item(a.w_mem_kv, D, 1024, WMKV_T, 32 * (r % 32), scr, 64 * (r / 32), 32 * (r % 32), lane); continue; } r -= I_MKV;
            if (r < I_O) { p0_transpose_item(a.w_o_sb, 512, D, WOSB_T, 32 * (r % 32), scr, 64 * (r / 32), 32 * (r % 32), lane, (unsigned char*)WOSB_T); continue; } r -= I_O;
            if (r < I_O) { p0_transpose_item(a.w_o_swa, 512, D, WOSW_T, 32 * (r % 32), scr, 64 * (r / 32), 32 * (r % 32), lane, (unsigned char*)WOSW_T); continue; } r -= I_O;
            if (r < I_O) { p0_transpose_item(a.w_o_mem, 512, D, WOM_T, 32 * (r % 32), scr, 64 * (r / 32), 32 * (r % 32), lane, (unsigned char*)WOM_T); continue; } r -= I_O;
            if (r < I_OUT) { p0_transpose_item(a.w_out, D, D, WOUT_T, 32 * (r % 32), scr, 64 * (r / 32), 32 * (r % 32), lane, (unsigned char*)WOUT_T); continue; } r -= I_OUT;
            if (r < I_SGU) { p0_transpose_item(a.w_s_gu, D, 512, WRS_T, map_gu(32 * (r % 16)), scr, 64 * (r / 16), 32 * (r % 16), lane, (unsigned char*)WRS_T); continue; } r -= I_SGU;
            if (r < I_R) { p0_transpose_item(a.w_router, D, NE, WRS_T, 512 + 32 * (r % 8), scr, 64 * (r / 8), 32 * (r % 8), lane); continue; } r -= I_R;
            p0_transpose_item(a.w_s_down, EFF, D, WSD_T, 32 * (r % 32), scr, 64 * (r / 32), 32 * (r % 32), lane, (unsigned char*)WSD_T);
        }
        thin::cvt_rows(a.x, XB, XB8, T, gw, NGW, lane);
        thin::cvt_rows(a.mem, MEMB, nullptr, MROWS, gw, NGW, lane);
    PH_END(0)
    PH_BEGIN(1)
        const int GG = G - NCONV;
        if (bx >= GG) {
            LAS float* scr = (LAS float*)(lds + wave * 16384);
            constexpr int I_EGU = 16 * 16, I_ED = 4 * 32;
            const int cw = (bx - GG) * NWAVES + wave, ncw = NCONV * NWAVES;
            constexpr int NIT = NE * (I_EGU + I_ED);
#define EXP_ISSUE(t, r_) do { const int ri_ = (r_) < NIT ? (r_) : rlast;     \
                const bool gu = ri_ < NE * I_EGU; const int r2 = gu ? ri_ : ri_ - NE * I_EGU; const int per = gu ? I_EGU : I_ED, nbs = gu ? 16 : 32; \
                const int e = r2 / per, q = r2 % per, kb = q / nbs, nb = q % nbs; \
                const float* W = gu ? a.w_e_gu + (size_t)e * D * 512 : a.w_e_down + (size_t)e * EFF * D; \
                unsigned char* W8 = gu ? (unsigned char*)WEGU_T + (size_t)e * 512 * D : (unsigned char*)WED_T + (size_t)e * D * EFF; \
                tr_issue(t, W, gu ? D : EFF, gu ? 512 : D, WEGU_T, gu ? map_gu(32 * nb) : 32 * nb, 64 * kb, 32 * nb, lane, W8); } while (0)
            TrItem tA, tB, tC;
            const int nmine = (NIT - cw + ncw - 1) / ncw, rlast = cw + (nmine - 1) * ncw;
            int r = cw;
            EXP_ISSUE(tA, r); EXP_ISSUE(tB, r + ncw);
            for (; r < NIT; r += 3 * ncw) {
                EXP_ISSUE(tC, r + 2 * ncw); tr_finish(tA, scr, lane);
                EXP_ISSUE(tA, r + 3 * ncw); tr_finish(tB, scr, lane);
                EXP_ISSUE(tB, r + 4 * ncw); tr_finish(tC, scr, lane);
            }
#undef EXP_ISSUE
        } else {
        LAS float* bias_lds = (LAS float*)(lds + BIAS_OFF);
        for (int i = tid; i < 3 * D; i += NWAVES * 64) bias_lds[i] = a.b_gate[i] * -LOG2E - LOG2_255;
        __syncthreads();
        { pg8::GridOrder S; S.init(T, OFF_GATE, D, GG, bx, 1); S.A0 = (unsigned)WS_XB; S.B0 = (unsigned)WS_WIN_T;
          pg8::EpiProj E{PROJB};
          pg8::gemm_phase<pg8::EpiProj, pg8::GridOrder, false>(lds, ws, D, S, E, wave); }
        { pg8::GridOrder S; S.init(T, 3 * D, D / 2, GG, (bx + GG - 64) % GG, 1); S.A0 = (unsigned)WS_XB8; S.B0 = (unsigned)WS_WG8_T;
          pg8::EpiGate8 E{bias_lds, ws + WS_GT};
          pg8::gemm_phase<pg8::EpiGate8, pg8::GridOrder, false, false, true>(lds, ws, D / 2, S, E, wave); }
        { pg8::GridOrder S; S.init(MROWS, 1024, D, GG, GG - 1 - bx, 1); S.A0 = (unsigned)WS_MEMB; S.B0 = (unsigned)WS_WMKV_T;
          pg8::EpiBf16 E{MKVB, 1024, 1.f};
          pg8::gemm_phase<pg8::EpiBf16, pg8::GridOrder, false>(lds, ws, D, S, E, wave); }
        }
    PH_END(1)
    PH_BEGIN(2)
        const att::Params P{PROJB, MKVB, a.sinks, (unsigned char*)OSB, (unsigned char*)OSW, (unsigned char*)OM};
        att::phase((LAS char*)lds, P, ctl + CW_QUEUE + 64 * (a.li & 15), a.pad == 1 ? 512 : (a.pad == 2 ? 1536 : 0), a.pad == 3 ? 512 : (a.pad == 1 ? 1536 : att::NUNITS), wave);
    PH_END(2)
    PH_BEGIN(3)
        pg8::GridOrder S; S.init(T, D, 512 / 2, G, bx, 3);
        S.A0 = (unsigned)WS_OSB; S.B0 = (unsigned)WS_WOSB_T; S.asub = (unsigned)(WS_OSW - WS_OSB); S.bsub = (unsigned)(WS_WOSW_T - WS_WOSB_T);
        pg8::EpiOutProj E{(unsigned char*)MERGED, (const u32x4*)(ws + WS_GT)};
        pg8::gemm_phase<pg8::EpiOutProj, pg8::GridOrder, false, false, true>(lds, ws, 512 / 2, S, E, wave);
    PH_END(3)
    PH_BEGIN(4)
        pg8::GridOrder S; S.init(T, D, D / 2, G, bx, 1); S.A0 = (unsigned)WS_MERGED; S.B0 = (unsigned)WS_WOUT_T;
        pg8::EpiY E{Z, XB};
        pg8::gemm_phase<pg8::EpiY, pg8::GridOrder, false, false, true>(lds, ws, D / 2, S, E, wave);
    PH_END(4)
    PH_BEGIN(5) thin::ln1_rows(Z, a.ln1_g, a.ln1_b, X1B, X1B8, gw, NGW, lane); PH_END(5)
    PH_BEGIN(6)
        const bool split = (G % 16 == 0); const int Gs = split ? G / 2 : G, cs = split ? (((bx >> 4) << 3) | (bx & 7)) : bx, side = (bx >> 3) & 1;
        if (!split || side == 0) { pg8::GridOrder S; S.init(T, NE, D, Gs, cs, 1); S.A0 = (unsigned)WS_X1B; S.B0 = (unsigned)(WS_WRS_T + (size_t)512 * D * 2);
            pg8::EpiRouter E{LOGITS};
            pg8::gemm_phase<pg8::EpiRouter, pg8::GridOrder, false>(lds, ws, D, S, E, wave); }
        if (!split || side == 1) { pg8::GridOrder S; S.init(T, 2 * EFF, D / 2, Gs, cs, 1); S.A0 = (unsigned)WS_X1B8; S.B0 = (unsigned)WS_WRS_T;
            pg8::EpiShared8 E{(unsigned char*)HS};
            pg8::gemm_phase<pg8::EpiShared8, pg8::GridOrder, false, false, true>(lds, ws, D / 2, S, E, wave); }
    PH_END(6)
    PH_BEGIN(7) thin::route(LOGITS, a.router_bias, IDX, WGT, ctl + CW_COUNTS, (LAS int*)lds, bx, G, tid); PH_END(7)
    PH_BEGIN(8) thin::scan_scatter(ctl + CW_COUNTS, ctl + CW_CURSOR, IDX, POS, STOK, TILES, TILES64, (LAS int*)lds, bx, G, tid); PH_END(8)
    PH_BEGIN(9)
        { LAS int* tab = (LAS int*)(lds + BIAS_OFF);
          const int ntiles = __builtin_amdgcn_readfirstlane(pg8::build_tile_map(ctl + CW_COUNTS, tab, tid));
          pg8::ExpertOrder S; S.offs = tab; S.cnt = tab + 256; S.tmap = (const LAS unsigned short*)(tab + 512); S.nN = 2; S.nwg = ntiles * 2; S.G = G; S.c = bx; S.A = (unsigned)WS_X1B8; S.rows = STOK; S.arow = 0; S.Bb = (unsigned)WS_WEGU_T; S.bexp = (unsigned)(512 * D); S.bstep = (unsigned)(256 * D);
          pg8::EpiExpGU8 E{(unsigned char*)HBUF};
          pg8::gemm_phase<pg8::EpiExpGU8, pg8::ExpertOrder, true, false, true>(lds, ws, D / 2, S, E, wave); }
        { pg8::GridOrder S; S.init(T, D, EFF / 2, G, bx, 1); S.A0 = (unsigned)WS_HS; S.B0 = (unsigned)WS_WSD_T;
          pg8::EpiBf16 E{SHOUT, D, 1.f / (W8_SCALE * H8_SCALE)};
          int Kh = EFF / 2; asm volatile("" : "+s"(Kh));
          pg8::gemm_phase<pg8::EpiBf16, pg8::GridOrder, false, false, true>(lds, ws, Kh, S, E, wave); }
    PH_END(9)
    PH_BEGIN(10)
        LAS int* tab = (LAS int*)(lds + BIAS_OFF);
        (void)pg8::build_tile_map(ctl + CW_COUNTS, tab, tid);
        LAS int* srt = tab + 1280;
        if (tid < NE) { const int ce = tab[256 + tid]; int rk = 0; for (int j = 0; j < NE; ++j) { const int cj = tab[256 + j]; rk += (cj > ce || (cj == ce && j < tid)) ? 1 : 0; } srt[rk] = tid; }
        __syncthreads();
        pg8::down_phase(lds, ws, tab, tab + 256, srt, G, bx, (unsigned)WS_HBUF, (unsigned)WS_WED_T, (unsigned)WS_YS, (unsigned)(WS_CTL + 768 * 1024), YS_SCALE / (W8_SCALE * H8_SCALE), wave, HYBRID ? a.pad : 0);
    PH_END(10)
    PH_BEGIN(11) thin::final_rows(X1B, SHOUT, YS, POS, WGT, a.ln2_g, a.ln2_b, a.out, gw, NGW, lane); PH_END(11)
#undef IN
#undef SEAM
#undef PH_BEGIN
#undef PH_END
}
extern "C" void kernel_launch(void* const* d_in, const int* in_sizes, int n_in, void* d_out, int out_size, void* d_ws, size_t ws_size, hipStream_t stream) {
    static int grid = 0;
    if (grid == 0) {
        if (n_in != 20 || in_sizes[0] != T * D || out_size != T * D || ws_size < WS_END) { fprintf(stderr, "kernel_launch: unexpected problem shape / workspace (%d inputs, ws %zu)\n", n_in, ws_size); grid = -1; return; }
        int dev = 0, cus = 0;
        if (hipGetDevice(&dev) != hipSuccess || hipDeviceGetAttribute(&cus, hipDeviceAttributeMultiprocessorCount, dev) != hipSuccess) { grid = -1; return; }
        if (hipFuncSetAttribute((const void*)mega_fwd, hipFuncAttributeMaxDynamicSharedMemorySize, LDS_BYTES) != hipSuccess) { fprintf(stderr, "kernel_launch: hipFuncSetAttribute failed\n"); grid = -1; return; }
        (void)hipGetLastError();
        grid = cus;
    }
    if (grid < 0) return;
    (void)hipMemsetAsync((char*)d_ws + WS_CTL, 0, CTL_ZERO_BYTES, stream);
    Args a{};
    const float** f = (const float**)&a;
    for (int i = 0; i < 20; ++i) f[i] = (const float*)d_in[i];
    a.out = (float*)d_out; a.ws = (unsigned char*)d_ws;
#if HYBRID
#ifndef PROBE_ATT_MODE
#define PROBE_ATT_MODE 0
#endif
    unsigned char* ws = (unsigned char*)d_ws;
    bf16* XB = (bf16*)(ws + WS_XB); bf16* MEMB = (bf16*)(ws + WS_MEMB); bf16* MKVB = (bf16*)(ws + WS_MKVB); bf16* PROJB = (bf16*)(ws + WS_PROJB);
    bf16* OSB = (bf16*)(ws + WS_OSB); bf16* OSW = (bf16*)(ws + WS_OSW); bf16* OM = (bf16*)(ws + WS_OM); bf16* MERGED = (bf16*)(ws + WS_MERGED);
    bf16* Z = (bf16*)(ws + WS_Z); bf16* X1B = (bf16*)(ws + WS_X1B); float* LOGITS = (float*)(ws + WS_LOGITS); bf16* HS = (bf16*)(ws + WS_HS); bf16* SHOUT = (bf16*)(ws + WS_SHOUT);
    int* STOK = (int*)(ws + WS_ROUTE + RT_STOK); int* TILES64 = (int*)(ws + WS_ROUTE + RT_TILES64);
    bf16* HBUF = (bf16*)(ws + WS_HBUF); bf16* YS = (bf16*)(ws + WS_YS);
    float* SCR = (float*)(ws + WS_YS);
    static const int opt[NPHASE] = HYBRID_OPT;
#ifdef PROBE_REPS
    static const int reps[NPHASE] = PROBE_REPS;
#else
    static const int reps[NPHASE] = {1, 1, 1, 1, 1, 1, 1, 1, 1, 1, 1, 1};
#endif
    int li = 0;
    for (int p = 0; p < NPHASE; ++p) {
        if (opt[p]) { for (int r = 0; r < reps[p]; ++r) { a.ph_lo = p; a.ph_hi = p + 1; a.li = (li++) & 15; a.pad = (r + 1 < reps[p]) ? PROBE_ATT_MODE : 0;     hipLaunchKernelGGL(mega_fwd, dim3(grid), dim3(NWAVES * 64), LDS_BYTES, stream, a); }
#ifdef ATT_DIFF_TEST
        if (p == 2 && opt[p]) {
            bf16* nsb = (bf16*)(ws + WS_YS); bf16* nsw = nsb + (size_t)T * 512; bf16* nm = nsw + (size_t)T * 512;
            nv::k_sb_attn<<<BATCH * 8 * (SEQ / 64), 64, 0, stream>>>(PROJB, nsb);
            nv::k_swa_attn<<<BATCH * 8 * (SEQ / 64), 64, 0, stream>>>(PROJB, a.sinks, nsw);
            nv::k_mem_attn<<<BATCH * 4 * 2 * (SEQ / 64), 64, 0, stream>>>(PROJB, MKVB, nm);
            unsigned* cw = (unsigned*)(ws + WS_CTL);
            nv::k_maxdiff<<<1024, 256, 0, stream>>>(OSB, nsb, (size_t)T * 512, cw + (ATT_DIFF_TEST == 1 ? 900 : 910));
            nv::k_maxdiff<<<1024, 256, 0, stream>>>(OSW, nsw, (size_t)T * 512, cw + (ATT_DIFF_TEST == 2 ? 900 : 911));
            nv::k_maxdiff<<<1024, 256, 0, stream>>>(OM, nm, (size_t)T * 512, cw + (ATT_DIFF_TEST == 3 ? 900 : 912));
        }
        if (p == NPHASE - 1) nv::k_scale_out<<<1024, 256, 0, stream>>>((float*)d_out, (size_t)T * D, (const unsigned*)(ws + WS_CTL) + 900);
#endif
            continue; }
        switch (p) {
        case 1:
            nv::k_gemm<nv::M_PROJ><<<dim3(IN_COLS / 64, T / 64), 256, 0, stream>>>(XB, D, a.w_in, IN_COLS, PROJB, IN_COLS, D, nullptr, 0, a.b_gate, nullptr);
            nv::k_gemm<nv::M_BF16><<<dim3(1024 / 64, MROWS / 64), 256, 0, stream>>>(MEMB, D, a.w_mem_kv, 1024, MKVB, 1024, D, nullptr, 0, nullptr, nullptr);
            break;
        case 2:
            nv::k_sb_attn<<<BATCH * 8 * (SEQ / 64), 64, 0, stream>>>(PROJB, OSB);
            nv::k_swa_attn<<<BATCH * 8 * (SEQ / 64), 64, 0, stream>>>(PROJB, a.sinks, OSW);
            nv::k_mem_attn<<<BATCH * 4 * 2 * (SEQ / 64), 64, 0, stream>>>(PROJB, MKVB, OM);
            break;
        case 3:
            nv::k_gemm<nv::M_GSET><<<dim3(D / 64, T / 64), 256, 0, stream>>>(OSB, 512, a.w_o_sb, D, nullptr, 0, 512, PROJB + OFF_GATE, IN_COLS, nullptr, SCR);
            nv::k_gemm<nv::M_GADD><<<dim3(D / 64, T / 64), 256, 0, stream>>>(OSW, 512, a.w_o_swa, D, nullptr, 0, 512, PROJB + OFF_GATE + D, IN_COLS, nullptr, SCR);
            nv::k_gemm<nv::M_GFIN><<<dim3(D / 64, T / 64), 256, 0, stream>>>(OM, 512, a.w_o_mem, D, MERGED, D, 512, PROJB + OFF_GATE + 2 * D, IN_COLS, nullptr, SCR);
            break;
        case 4:
            nv::k_gemm<nv::M_Y><<<dim3(D / 64, T / 64), 256, 0, stream>>>(MERGED, D, a.w_out, D, Z, D, D, a.x, D, nullptr, nullptr);
            break;
        case 6:
            nv::k_gemm<nv::M_F32><<<dim3(NE / 64, T / 64), 256, 0, stream>>>(X1B, D, a.w_router, NE, LOGITS, NE, D, nullptr, 0, nullptr, nullptr);
            nv::k_gu<<<dim3(EFF / 64, T / 64), 256, 0, stream>>>(X1B, nullptr, nullptr, a.w_s_gu, 0, HS);
            break;
        case 9:
            nv::k_gu<<<dim3(EFF / 64, MAXT64), 256, 0, stream>>>(X1B, STOK, TILES64, a.w_e_gu, (size_t)D * 2 * EFF, HBUF);
            nv::k_down<false><<<dim3(D / 64, T / 64), 256, 0, stream>>>(HS, nullptr, a.w_s_down, 0, SHOUT);
            break;
        case 10:
            nv::k_down<true><<<dim3(D / 64, MAXT64), 256, 0, stream>>>(HBUF, TILES64, a.w_e_down, (size_t)EFF * D, YS);
            break;
        default: break;
        }
    }
#else
    a.ph_lo = 0; a.ph_hi = NPHASE; a.li = 0;
    hipLaunchKernelGGL(mega_fwd, dim3(grid), dim3(NWAVES * 64), LDS_BYTES, stream, a);
#endif
}
```

```cpp
#define HYBRID 0
#include <hip/hip_runtime.h>
#include <stdint.h>
#include <math.h>
#include <cstdio>

constexpr int D = 1024, BATCH = 8, SEQ = 4096, T = BATCH * SEQ;
constexpr int MEM_LEN = 256, MROWS = BATCH * MEM_LEN;
constexpr int IN_COLS = 5888;
constexpr int OFF_QSB = 0, OFF_KSB = 512, OFF_VSB = 1024, OFF_QSW = 1536, OFF_KSW = 2048, OFF_VSW = 2176, OFF_QM = 2304, OFF_GATE = 2816;
constexpr int NE = 256, TOPK = 8, EFF = 256;
constexpr float LN_EPS = 1e-5f;
constexpr float ALPHA = 1.189207115002721f;
constexpr int NSLOT = T * TOPK;
constexpr float LOG2E = 1.4426950408889634f;
constexpr float LOG2_255 = 7.994353436858858f, GATE_TMAX = 7.988684686772166f - 7.994353436858858f;
constexpr float QS64 = 0.125f * LOG2E;
constexpr float QS128 = 0.08838834764831845f * LOG2E;

constexpr float W8_SCALE = 64.f, W8_INV = 1.f / 64.f;
constexpr float O8_SCALE = 16.f, M8_SCALE = 16.f;
constexpr float H8_SCALE = 16.f;
constexpr float YS_SCALE = 16.f, YS_INV = 1.f / 16.f;
constexpr size_t MiB = 1u << 20;
constexpr size_t WS_CTL = 0, CTL_ZERO_BYTES = 1 * MiB;
constexpr size_t WS_WIN_T = 2 * MiB, WS_WMKV_T = 14 * MiB, WS_WOSB_T = 16 * MiB, WS_WOSW_T = 17 * MiB, WS_WOM_T = 18 * MiB, WS_WOUT_T = 19 * MiB, WS_WRS_T = 21 * MiB, WS_WSD_T = 23 * MiB;
constexpr size_t WS_WEGU_T = 24 * MiB, WS_WED_T = 280 * MiB;
constexpr size_t WS_XB = 408 * MiB, WS_MEMB = 472 * MiB, WS_MKVB = 476 * MiB, WS_PROJB = 480 * MiB;
constexpr size_t WS_OSB = 848 * MiB, WS_OSW = 880 * MiB, WS_OM = 912 * MiB, WS_MERGED = 944 * MiB, WS_Z = 1008 * MiB, WS_X1B = 1136 * MiB, WS_LOGITS = 1200 * MiB, WS_HS = 1232 * MiB, WS_SHOUT = 1248 * MiB;
constexpr size_t WS_XB8 = 1920 * MiB, WS_X1B8 = 1952 * MiB, WS_WG8_T = 1984 * MiB;
constexpr size_t WS_STOK2 = (1728 + 96) * MiB;
constexpr size_t WS_GT = 1728 * MiB;
constexpr size_t WS_ROUTE = 1312 * MiB, WS_HBUF = 1328 * MiB, WS_YS = 1460 * MiB, WS_END = 1988 * MiB;
constexpr size_t RT_IDX = 0, RT_WGT = 1 * MiB, RT_POS = 2 * MiB, RT_STOK = 3 * MiB  , RT_TILES = 5 * MiB  , RT_TILES64 = 6 * MiB  ;
constexpr int MAXT256 = NSLOT / 256 + NE;
constexpr int MAXT64 = NSLOT / 64 + NE;
constexpr int CW_COUNTS = 1024, CW_CURSOR = 1280, CW_QUEUE = 1536  , CW_BAR = 4096;

typedef unsigned short bf16;
typedef short bf16x8 __attribute__((ext_vector_type(8)));
typedef float f32x4 __attribute__((ext_vector_type(4)));
typedef float f32x16 __attribute__((ext_vector_type(16)));
typedef unsigned u32x4 __attribute__((ext_vector_type(4)));
typedef unsigned u32x2 __attribute__((ext_vector_type(2)));

__device__ __forceinline__ unsigned f2bf(float f) { unsigned u = __builtin_bit_cast(unsigned, f); return (u + 0x7fffu + ((u >> 16) & 1u)) >> 16; }
__device__ __forceinline__ unsigned pk2(float lo, float hi) { return f2bf(lo) | (f2bf(hi) << 16); }
__device__ __forceinline__ float bf2f(unsigned b) { return __builtin_bit_cast(float, b << 16); }
__device__ __forceinline__ float bflo(unsigned w) { return __builtin_bit_cast(float, w << 16); }
__device__ __forceinline__ float bfhi(unsigned w) { return __builtin_bit_cast(float, w & 0xffff0000u); }
__device__ __forceinline__ unsigned pack4_e4m3(float a, float b, float c, float d) {
    a = __builtin_amdgcn_fmed3f(a, -448.f, 448.f); b = __builtin_amdgcn_fmed3f(b, -448.f, 448.f); c = __builtin_amdgcn_fmed3f(c, -448.f, 448.f); d = __builtin_amdgcn_fmed3f(d, -448.f, 448.f);
    const unsigned w = __builtin_amdgcn_cvt_pk_fp8_f32(a, b, 0u, false); return __builtin_amdgcn_cvt_pk_fp8_f32(c, d, w, true);
}
__device__ __forceinline__ float wave_sum(float v) {
#pragma unroll
    for (int o = 1; o < 64; o <<= 1) v += __shfl_xor(v, o);
    return v;
}
__device__ __forceinline__ float sigmoidf_(float z) { return 1.f / (1.f + __expf(-z)); }
__device__ __forceinline__ float gate_sig(float z) { z = fminf(fmaxf(z, -30.f), 30.f); return __builtin_amdgcn_rcpf(1.f + __expf(-z)); }

__device__ __forceinline__ int lane_id() { int l; asm volatile("v_mbcnt_lo_u32_b32 %0, -1, 0\n\tv_mbcnt_hi_u32_b32 %0, -1, %0" : "=v"(l)); return l; }
__device__ __forceinline__ int otid(int wave) { int t = (wave << 6) | lane_id(); asm volatile("" : "+v"(t)); return t; }
__device__ __forceinline__ bool is_t0(int wave) { return wave == 0 && lane_id() == 0; }
namespace thin {
#define TLAS __attribute__((address_space(3)))
__device__ __forceinline__ void cvt_rows(const float* __restrict__ src, bf16* __restrict__ dst, unsigned char* __restrict__ dst8  , int rows, int gw, int ngw, int lane) {
    f32x4 cur[4], nxt[4];
    if (gw < rows) {
#pragma unroll
        for (int j = 0; j < 4; ++j) cur[j] = __builtin_nontemporal_load((const f32x4*)(src + (size_t)gw * D) + lane + 64 * j);
    }
    for (int r = gw; r < rows; r += ngw) {
        const int rn = (r + ngw < rows) ? r + ngw : r;
#pragma unroll
        for (int j = 0; j < 4; ++j) nxt[j] = __builtin_nontemporal_load((const f32x4*)(src + (size_t)rn * D) + lane + 64 * j);
        u32x2* d = (u32x2*)(dst + (size_t)r * D) + lane;
#pragma unroll
        for (int j = 0; j < 4; ++j) { u32x2 o; o.x = pk2(cur[j].x, cur[j].y); o.y = pk2(cur[j].z, cur[j].w); d[64 * j] = o; }
        if (dst8) { unsigned* d8 = (unsigned*)(dst8 + (size_t)r * D) + lane;
#pragma unroll
            for (int j = 0; j < 4; ++j) d8[64 * j] = pack4_e4m3(cur[j].x, cur[j].y, cur[j].z, cur[j].w); }
#pragma unroll
        for (int j = 0; j < 4; ++j) cur[j] = nxt[j];
    }
}
__device__ __forceinline__ void ln1_rows(const bf16* __restrict__ Z, const float* __restrict__ g, const float* __restrict__ bta, bf16* __restrict__ XB, unsigned char* __restrict__ XB8, int gw, int ngw, int lane) {
    u32x4 r0[2], r1[2], r2[2];
    const int ra = gw < T ? gw : T - 1, rb = gw + ngw < T ? gw + ngw : T - 1;
#pragma unroll
    for (int j = 0; j < 2; ++j) { r0[j] = __builtin_nontemporal_load((const u32x4*)(Z + (size_t)ra * D) + lane + 64 * j); r1[j] = __builtin_nontemporal_load((const u32x4*)(Z + (size_t)rb * D) + lane + 64 * j); }
    f32x4 gg[4], bb[4];
#pragma unroll
    for (int j = 0; j < 2; ++j) { gg[2 * j] = ((const f32x4*)g)[2 * lane + 128 * j]; gg[2 * j + 1] = ((const f32x4*)g)[2 * lane + 128 * j + 1]; bb[2 * j] = ((const f32x4*)bta)[2 * lane + 128 * j]; bb[2 * j + 1] = ((const f32x4*)bta)[2 * lane + 128 * j + 1]; }
    for (int r = gw; r < T; r += ngw) {
        const int rn = (r + 2 * ngw < T) ? r + 2 * ngw : r;
#pragma unroll
        for (int j = 0; j < 2; ++j) r2[j] = __builtin_nontemporal_load((const u32x4*)(Z + (size_t)rn * D) + lane + 64 * j);
        f32x4 v[4]; float s = 0.f;
#pragma unroll
        for (int j = 0; j < 2; ++j) { const u32x4 z = r0[j]; v[2 * j] = (f32x4){bflo(z.x), bfhi(z.x), bflo(z.y), bfhi(z.y)}; v[2 * j + 1] = (f32x4){bflo(z.z), bfhi(z.z), bflo(z.w), bfhi(z.w)}; }
#pragma unroll
        for (int j = 0; j < 4; ++j) s += (v[j].x + v[j].y) + (v[j].z + v[j].w);
        const float mean = wave_sum(s) * (1.f / D); float s2 = 0.f;
#pragma unroll
        for (int j = 0; j < 4; ++j) { v[j] = v[j] - mean; s2 += (v[j].x * v[j].x + v[j].y * v[j].y) + (v[j].z * v[j].z + v[j].w * v[j].w); }
        const float rstd = rsqrtf(wave_sum(s2) * (1.f / D) + LN_EPS);
        u32x4* xb = (u32x4*)(XB + (size_t)r * D) + lane;
        u32x2* x8 = (u32x2*)(XB8 + (size_t)r * D) + lane;
#pragma unroll
        for (int j = 0; j < 2; ++j) { const f32x4 o0 = v[2 * j] * rstd * gg[2 * j] + bb[2 * j], o1 = v[2 * j + 1] * rstd * gg[2 * j + 1] + bb[2 * j + 1];
            u32x4 w; w.x = pk2(o0.x, o0.y); w.y = pk2(o0.z, o0.w); w.z = pk2(o1.x, o1.y); w.w = pk2(o1.z, o1.w); xb[64 * j] = w;
            u32x2 q; q.x = pack4_e4m3(o0.x, o0.y, o0.z, o0.w); q.y = pack4_e4m3(o1.x, o1.y, o1.z, o1.w); x8[64 * j] = q; }
#pragma unroll
        for (int j = 0; j < 2; ++j) { r0[j] = r1[j]; r1[j] = r2[j]; }
    }
}
__device__ __forceinline__ void route(const float* __restrict__ logits, const float* __restrict__ rbias, int* __restrict__ er, float* __restrict__ wgt, unsigned* __restrict__ counts, int* __restrict__ stok2,
                                      TLAS int* hist  , int wg, int nwg, int tid) {
    TLAS int* base = hist + 256; TLAS int* rec = hist + 512;
    const int lane = tid & 63, wave = tid >> 6;
    if (tid < NE) hist[tid] = 0;
    __syncthreads();
    const int per = (T + nwg - 1) / nwg;
    const f32x4 rb = ((const f32x4*)rbias)[lane];
    constexpr int NT = 2;
    f32x4 lgn[NT];
#pragma unroll
    for (int u = 0; u < NT; ++u) { const int t0 = wg * per + wave * NT + u; lgn[u] = ((const f32x4*)(logits + (size_t)((wave * NT + u < per && t0 < T) ? t0 : wg * per) * NE))[lane]; }
    for (int i = wave * NT; i < per; i += 8 * NT) {
        int tok[NT]; bool live[NT]; f32x4 lg[NT];
#pragma unroll
        for (int u = 0; u < NT; ++u) { tok[u] = wg * per + i + u; live[u] = (i + u < per) && tok[u] < T; lg[u] = lgn[u];
            const int in_ = i + 8 * NT + u, tn = wg * per + in_; lgn[u] = ((const f32x4*)(logits + (size_t)((in_ < per && tn < T) ? tn : wg * per) * NE))[lane]; }
        float s[NT][4], c[NT][4];
#pragma unroll
        for (int u = 0; u < NT; ++u)
#pragma unroll
            for (int j = 0; j < 4; ++j) { s[u][j] = sigmoidf_(lg[u][j]); c[u][j] = s[u][j] + rb[j]; }
        float m1[NT], m2[NT];
#pragma unroll
        for (int u = 0; u < NT; ++u) { const float a = fmaxf(c[u][0], c[u][1]), b = fminf(c[u][0], c[u][1]), d = fmaxf(c[u][2], c[u][3]), e = fminf(c[u][2], c[u][3]); m1[u] = fmaxf(a, d); m2[u] = fmaxf(fminf(a, d), fmaxf(b, e)); }
#pragma unroll
        for (int off = 1; off < 8; off <<= 1)
#pragma unroll
            for (int u = 0; u < NT; ++u) { const float o1 = __shfl_xor(m1[u], off), o2 = __shfl_xor(m2[u], off); const float n1 = fmaxf(m1[u], o1), n2 = fmaxf(fminf(m1[u], o1), fmaxf(m2[u], o2)); m1[u] = n1; m2[u] = n2; }
        const int g = lane >> 3;
        float gs[NT]; int rank[NT];
#pragma unroll
        for (int u = 0; u < NT; ++u) { gs[u] = m1[u] + m2[u]; rank[u] = 0; }
#pragma unroll
        for (int j = 0; j < 8; ++j)
#pragma unroll
            for (int u = 0; u < NT; ++u) { const float gj = __shfl(gs[u], 8 * j); rank[u] += (gj > gs[u] || (gj == gs[u] && j < g)) ? 1 : 0; }
#pragma unroll
        for (int u = 0; u < NT; ++u) if (rank[u] >= 4) { c[u][0] = -INFINITY; c[u][1] = -INFINITY; c[u][2] = -INFINITY; c[u][3] = -INFINITY; }
        int myidx[NT]; float mysc[NT], ssum[NT];
#pragma unroll
        for (int u = 0; u < NT; ++u) { myidx[u] = 0; mysc[u] = 0.f; ssum[u] = 0.f; }
#pragma unroll
        for (int k = 0; k < 8; ++k) {
            float bv[NT]; int be[NT];
#pragma unroll
            for (int u = 0; u < NT; ++u) { bv[u] = c[u][0]; int bi = 0;
#pragma unroll
                for (int j = 1; j < 4; ++j) if (c[u][j] > bv[u]) { bv[u] = c[u][j]; bi = j; }
                be[u] = 4 * lane + bi; }
#pragma unroll
            for (int off = 1; off < 64; off <<= 1)
#pragma unroll
                for (int u = 0; u < NT; ++u) { const float ov = __shfl_xor(bv[u], off); const int oe = __shfl_xor(be[u], off); const bool take = ov > bv[u] || (ov == bv[u] && oe < be[u]); bv[u] = take ? ov : bv[u]; be[u] = take ? oe : be[u]; }
#pragma unroll
            for (int u = 0; u < NT; ++u) { const int wj = be[u] & 3, wl = be[u] >> 2;
                const float sloc = wj == 0 ? s[u][0] : (wj == 1 ? s[u][1] : (wj == 2 ? s[u][2] : s[u][3]));
                const float ssel = __shfl(sloc, wl);
                ssum[u] += ssel; if (lane == k) { myidx[u] = be[u]; mysc[u] = ssel; }
#pragma unroll
                for (int j = 0; j < 4; ++j) c[u][j] = (lane == wl && j == wj) ? -INFINITY : c[u][j]; }
        }
#pragma unroll
        for (int u = 0; u < NT; ++u)
            if (live[u] && lane < 8) { wgt[tok[u] * 8 + lane] = mysc[u] / ssum[u] * 2.5f;
                const int lr = __hip_atomic_fetch_add(&hist[myidx[u]], 1, __ATOMIC_RELAXED, __HIP_MEMORY_SCOPE_WORKGROUP); rec[(i + u) * 8 + lane] = (myidx[u] << 16) | lr; }
    }
    __syncthreads();
    if (tid < NE) base[tid] = hist[tid] > 0 ? (int)atomicAdd(&counts[tid], (unsigned)hist[tid]) : 0;
    __syncthreads();
    for (int sl = tid; sl < per * 8; sl += 512) { const int tk = wg * per + (sl >> 3);
        if (tk < T) { const int rc = rec[sl], e = rc >> 16, r = base[e] + (rc & 0xffff); er[tk * 8 + (sl & 7)] = (e << 16) | r; stok2[(size_t)e * T + r] = tk; } }
}
__device__ __forceinline__ void scan_scatter(const unsigned* __restrict__ counts, unsigned* __restrict__ cursor, const int* __restrict__ idx, int* __restrict__ pos_of, int* __restrict__ sorted_tok,
                                             int* __restrict__ tiles256, int* __restrict__ tiles64, TLAS int* lds, int wg, int nwg, int tid) {
    TLAS int* cnt = lds; TLAS int* offs = lds + 256; TLAS int* lcnt = lds + 512; TLAS int* base = lds + 768;
    if (tid < NE) { cnt[tid] = (int)__hip_atomic_load(&counts[tid], __ATOMIC_RELAXED, __HIP_MEMORY_SCOPE_AGENT); lcnt[tid] = 0; }
    __syncthreads();
    if (tid < NE) { int o = 0; for (int j = 0; j < tid; ++j) o += cnt[j]; offs[tid] = o; }
    __syncthreads();
    const int per = NSLOT / nwg;
    int myr[4], mye[4];
#pragma unroll
    for (int i = 0; i < 4; ++i) { const int li = tid + 512 * i; mye[i] = -1; myr[i] = 0;
        if (li < per) { const int e = idx[wg * per + li]; mye[i] = e; myr[i] = __hip_atomic_fetch_add(&lcnt[e], 1, __ATOMIC_RELAXED, __HIP_MEMORY_SCOPE_WORKGROUP); } }
    __syncthreads();
    if (tid < NE) { const int c = lcnt[tid]; base[tid] = offs[tid] + (c > 0 ? (int)atomicAdd(&cursor[tid], (unsigned)c) : 0); }
    __syncthreads();
#pragma unroll
    for (int i = 0; i < 4; ++i) { const int li = tid + 512 * i;
        if (li < per) { const int slot = wg * per + li; const int p = base[mye[i]] + myr[i]; pos_of[slot] = p; sorted_tok[p] = slot >> 3; } }
    if (wg == 0) {
        if (tid < 256) sorted_tok[NSLOT + tid] = 0;
        if (HYBRID && tid < NE) { const int c = cnt[tid], off = offs[tid];
            int t256 = 0, t64 = 0; for (int j = 0; j < tid; ++j) { t256 += (cnt[j] + 255) >> 8; t64 += (cnt[j] + 63) >> 6; }
            const int n256 = (c + 255) >> 8, n64 = (c + 63) >> 6;
            for (int i = 0; i < n256; ++i) { tiles256[t256 + i] = tid; tiles256[MAXT256 + t256 + i] = off + 256 * i; tiles256[2 * MAXT256 + t256 + i] = (c - 256 * i) < 256 ? (c - 256 * i) : 256; }
            for (int i = 0; i < n64; ++i) { tiles64[t64 + i] = tid; tiles64[MAXT64 + t64 + i] = off + 64 * i; tiles64[2 * MAXT64 + t64 + i] = (c - 64 * i) < 64 ? (c - 64 * i) : 64; }
            if (tid == NE - 1) { tiles256[3 * MAXT256] = t256 + n256; tiles64[3 * MAXT64] = t64 + n64; } }
    }
    __syncthreads();
}
__device__ __forceinline__ void final_rows(const bf16* __restrict__ X1, const unsigned char* __restrict__ SH  , const unsigned char* __restrict__ YS, const int* __restrict__ er, const TLAS int* offs  , const float* __restrict__ wgt,
                                           const float* __restrict__ g, const float* __restrict__ bta, float* __restrict__ out, int gw, int ngw, int lane) {
    typedef float f2_ __attribute__((ext_vector_type(2)));
    f32x4 gg[4], bb[4];
#pragma unroll
    for (int j = 0; j < 4; ++j) { gg[j] = ((const f32x4*)g)[lane + 64 * j]; bb[j] = ((const f32x4*)bta)[lane + 64 * j]; }
    const int l8 = lane & 7;
    unsigned slot_cur = 0u, slot_nxt = 0u;
#define FR_POS(row_) ({ const int e_ = er[(row_) * 8 + l8]; (unsigned)(offs[e_ >> 16] + (e_ & 0xffff)); })
    if (gw < T) slot_cur = (lane & 8) ? __float_as_uint(wgt[gw * 8 + l8]) : FR_POS(gw);
    for (int row = gw; row < T; row += ngw) {
        const int rn = (row + ngw < T) ? row + ngw : row;
        slot_nxt = (lane & 8) ? __float_as_uint(wgt[rn * 8 + l8]) : FR_POS(rn);
        unsigned yv[8][4];
#pragma unroll
        for (int k = 0; k < 8; ++k) { const int p = __builtin_amdgcn_readlane((int)slot_cur, k);
#pragma unroll
            for (int j = 0; j < 4; ++j) yv[k][j] = __builtin_nontemporal_load((const unsigned*)(YS + (size_t)p * D) + lane + 64 * j); }
        f32x4 v[4];
#pragma unroll
        for (int j = 0; j < 4; ++j) { const u32x2 a = ((const u32x2*)(X1 + (size_t)row * D))[lane + 64 * j]; const unsigned s8 = ((const unsigned*)(SH + (size_t)row * D))[lane + 64 * j];
            const f2_ slo = __builtin_amdgcn_cvt_pk_f32_fp8(s8, false), shi = __builtin_amdgcn_cvt_pk_f32_fp8(s8, true);
            v[j].x = ALPHA * bflo(a.x) + slo.x * YS_INV; v[j].y = ALPHA * bfhi(a.x) + slo.y * YS_INV; v[j].z = ALPHA * bflo(a.y) + shi.x * YS_INV; v[j].w = ALPHA * bfhi(a.y) + shi.y * YS_INV; }
#pragma unroll
        for (int k = 0; k < 8; ++k) { const float w = __uint_as_float((unsigned)__builtin_amdgcn_readlane((int)slot_cur, 8 + k)) * YS_INV;
#pragma unroll
            for (int j = 0; j < 4; ++j) { const f2_ lo = __builtin_amdgcn_cvt_pk_f32_fp8(yv[k][j], false), hi = __builtin_amdgcn_cvt_pk_f32_fp8(yv[k][j], true);
                v[j].x += w * lo.x; v[j].y += w * lo.y; v[j].z += w * hi.x; v[j].w += w * hi.y; } }
        float s = 0.f;
#pragma unroll
        for (int j = 0; j < 4; ++j) s += (v[j].x + v[j].y) + (v[j].z + v[j].w);
        const float mean = wave_sum(s) * (1.f / D); float s2 = 0.f;
#pragma unroll
        for (int j = 0; j < 4; ++j) { v[j] = v[j] - mean; s2 += (v[j].x * v[j].x + v[j].y * v[j].y) + (v[j].z * v[j].z + v[j].w * v[j].w); }
        const float rstd = rsqrtf(wave_sum(s2) * (1.f / D) + LN_EPS);
#pragma unroll
        for (int j = 0; j < 4; ++j) __builtin_nontemporal_store(v[j] * rstd * gg[j] + bb[j], (f32x4*)(out + (size_t)row * D) + lane + 64 * j);
        slot_cur = slot_nxt;
    }
#undef FR_POS
}
}
namespace pg8 {
#define PG8_LAS __attribute__((address_space(3)))
typedef unsigned short bf16_t;
typedef short bf16x8 __attribute__((ext_vector_type(8)));
typedef float f32x4 __attribute__((ext_vector_type(4)));
typedef float f32x2 __attribute__((ext_vector_type(2)));
typedef unsigned u32x4 __attribute__((ext_vector_type(4)));
typedef unsigned u32x2 __attribute__((ext_vector_type(2)));
constexpr int BM = 256, BK = 64, HALF = 128, HTB = HALF * BK * 2  , STAGE_BYTES = 8 * HTB, NXCD = 8, WGM = 8;

__host__ __device__ __forceinline__ int lds_byte(int r, int c) { const int st = (r >> 4) * 2 + (c >> 5), rr = r & 15, cc = c & 31, ob = rr * 64 + cc * 2; return st * 1024 + (ob ^ (((ob >> 9) & 1) << 5)); }
__host__ __device__ __forceinline__ void stage_rc(int b, int& R, int& C) { const int st = b / 1024, sb = b % 1024, swz = sb ^ (((sb >> 9) & 1) << 5); R = (st >> 1) * 16 + swz / 64; C = (st & 1) * 32 + (swz % 64) / 2; }
__host__ __device__ __forceinline__ int lds_byte8(int r, int ch) { const int rr = r & 15; return (r >> 4) * 2048 + (ch >> 2) * 1024 + (rr * 4 + (((ch & 3) + ((rr >> 2) & 1)) & 3)) * 16; }
__host__ __device__ __forceinline__ void stage_rc8(int b, int& R, int& C) { const int blk = b / 2048, unit = (b % 2048) / 1024, slot = (b % 1024) / 16, rr = slot >> 2, g = slot & 3; R = blk * 16 + rr; C = (unit * 4 + ((g - ((rr >> 2) & 1)) & 3)) * 8; }
__host__ __device__ __forceinline__ int perm32(int rho) { const int n = rho >> 4, i = rho & 15; return 8 * (i >> 2) + 4 * n + (i & 3); }

struct Unit { unsigned A; unsigned B; int pm, pn, aux, nr; };

__device__ __forceinline__ unsigned cvt_pk_bf16(float lo, float hi) { typedef __bf16 bf16x2_t __attribute__((ext_vector_type(2))); f32x2 v = {lo, hi}; bf16x2_t b = __builtin_convertvector(v, bf16x2_t); return __builtin_bit_cast(unsigned, b); }

typedef int i32x8 __attribute__((ext_vector_type(8)));
typedef i32x8 i32x8_a16 __attribute__((aligned(16)));
template <class Epi, class Sched, bool GATHER, bool GATHER_NR = false, bool F8 = false>
__device__ __forceinline__ void gemm_phase(PG8_LAS unsigned char* lds, const unsigned char* wsbase, const int K, const Sched& S, Epi& E, const int wave) {
    const __amdgpu_buffer_rsrc_t rsrc = __builtin_amdgcn_make_buffer_rsrc((void*)wsbase, 0, 0x7fffffff, 0x00020000);
    const int tid_ = otid(wave);
    const int tid = tid_, wid = wave, lane = tid & 63, wr = wid >> 2, wc = wid & 3, fr = lane & 15, fq = lane >> 4;
    const int nt = K / BK;
    unsigned voffA, voffB;
    { int R, C, Ra, Ca; stage_rc(tid * 16, R, C); if (F8) stage_rc8(tid * 16, Ra, Ca); else { Ra = R; Ca = C; } const int Rb = Epi::PERM ? ((R & ~31) + perm32(R & 31)) : R;
      voffA = (unsigned)(Ra * K + Ca) * 2u; voffB = (unsigned)(Rb * K + C) * 2u; }
    const unsigned rstep = 64u * (unsigned)K * 2u;
    const unsigned kstep = (unsigned)(BK * 2);
    const unsigned hstep = (unsigned)HALF * (unsigned)K * 2u;
    const unsigned ldsw = (unsigned)wid * 1024u, ldsb = (unsigned)(size_t)lds;
    const int aoff = lds_byte(wr * 64 + fr, fq * 8), boff = lds_byte(wc * 32 + fr, fq * 8);
#define PG8_SA(b, h) (((b) * 2 + (h)) * HTB)
#define PG8_SB(b, h) ((4 + (b) * 2 + (h)) * HTB)
#define PG8_STAGE(bufoff, gbase, voff) do { _Pragma("unroll") for (int _i = 0; _i < 2; ++_i) \
        asm volatile("s_mov_b32 m0, %0\n\ts_nop 0\n\tbuffer_load_dwordx4 %1, %2, %3 offen lds" :: "s"(ldsb + (unsigned)(bufoff) + ldsw + (unsigned)(_i * 8192)), "v"((voff)[_i]), "s"(rsrc), "s"((unsigned)(gbase)) : "m0", "memory"); } while (0)
#define PG8_STAGE1(bufoff, gbase, voff) do { _Pragma("unroll") for (int _i = 0; _i < 2; ++_i) \
        asm volatile("s_mov_b32 m0, %0\n\ts_nop 0\n\tbuffer_load_dwordx4 %1, %2, %3 offen lds" :: "s"(ldsb + (unsigned)(bufoff) + ldsw + (unsigned)(_i * 8192)), "v"(voff), "s"(rsrc), "s"((unsigned)(gbase) + (unsigned)_i * rstep) : "m0", "memory"); } while (0)
#define PG8_STAGE_A(bufoff, p, h, g) do { if (GATHER) PG8_STAGE(bufoff, p, (g)[h]); else PG8_STAGE1(bufoff, (p) + (h) * hstep, voffA); } while (0)
    const int aoff8 = lds_byte8(wr * 64 + fr, 2 * fq), aoff8h = lds_byte8(wr * 64 + fr, 2 * fq + 1), boff8 = lds_byte(wc * 32 + fr, fq * 16);
#define PG8_LD32(offl_, offh_) ({ union { i32x8 v; u32x4 h[2]; } u_; u_.h[0] = *(const PG8_LAS u32x4*)(lds + (offl_)); u_.h[1] = *(const PG8_LAS u32x4*)(lds + (offh_)); u_.v; })
#define PG8_LDA8(dst, b, h) do { _Pragma("unroll") for (int m = 0; m < 4; ++m) dst[m] = PG8_LD32(PG8_SA(b, h) + aoff8 + m * 2048, PG8_SA(b, h) + aoff8h + m * 2048); } while (0)
#define PG8_LDB8(dst, b, h) do { _Pragma("unroll") for (int n = 0; n < 2; ++n) dst[n] = *(const PG8_LAS i32x8_a16*)(lds + PG8_SB(b, h) + boff8 + n * 2048); } while (0)
#define PG8_MMA8(ai, bj, At, Bt) do { __builtin_amdgcn_s_setprio(1); _Pragma("unroll") for (int m = 0; m < 4; ++m) _Pragma("unroll") for (int n = 0; n < 2; ++n) \
        acc[ai][bj][m][n] = __builtin_amdgcn_mfma_scale_f32_16x16x128_f8f6f4(Bt[n], At[m], acc[ai][bj][m][n], 0, 0, 0, 0x7F7F7F7F, 0, 0x7F7F7F7F); __builtin_amdgcn_s_setprio(0); } while (0)
#define PG8_LDA(dst, b, h) do { _Pragma("unroll") for (int m = 0; m < 4; ++m) _Pragma("unroll") for (int k = 0; k < 2; ++k) dst[m][k] = *(const PG8_LAS bf16x8*)(lds + PG8_SA(b, h) + aoff + m * 2048 + k * 1024); } while (0)
#define PG8_LDB(dst, b, h) do { _Pragma("unroll") for (int n = 0; n < 2; ++n) _Pragma("unroll") for (int k = 0; k < 2; ++k) dst[n][k] = *(const PG8_LAS bf16x8*)(lds + PG8_SB(b, h) + boff + n * 2048 + k * 1024); } while (0)
#define PG8_MMA(ai, bj, At, Bt) do { __builtin_amdgcn_s_setprio(1); _Pragma("unroll") for (int m = 0; m < 4; ++m) _Pragma("unroll") for (int n = 0; n < 2; ++n) _Pragma("unroll") for (int k = 0; k < 2; ++k) \
        acc[ai][bj][m][n] = __builtin_amdgcn_mfma_f32_16x16x32_bf16(Bt[n][k], At[m][k], acc[ai][bj][m][n], 0, 0, 0); __builtin_amdgcn_s_setprio(0); } while (0)
#define PG8_WAIT_V(n) asm volatile("s_waitcnt vmcnt(" #n ")" ::: "memory")
#define PG8_WAIT_L(n) asm volatile("s_waitcnt lgkmcnt(" #n ")" ::: "memory")
#define PG8_BAR __builtin_amdgcn_s_barrier()
#define PG8_SCHED __builtin_amdgcn_sched_barrier(0)
#define PG8_GOFF(dst, u) do { if (GATHER) { _Pragma("unroll") for (int _i = 0; _i < 2; ++_i) { int _R, _C; if (F8) stage_rc8(tid * 16 + _i * 8192, _R, _C); else stage_rc(tid * 16 + _i * 8192, _R, _C); _Pragma("unroll") for (int _h = 0; _h < 2; ++_h) \
        dst[_h][_i] = (unsigned)(S.row_index((u), _R + _h * HALF) * K + _C) * 2u; } } } while (0)
    Unit cur, nxt; int ui = 0;
    if (!S.next(0, cur)) return;
    f32x4 acc[2][2][4][2];
#pragma unroll
    for (int a = 0; a < 2; ++a)
#pragma unroll
        for (int b = 0; b < 2; ++b)
#pragma unroll
            for (int m = 0; m < 4; ++m)
#pragma unroll
                for (int n = 0; n < 2; ++n) acc[a][b][m][n] = (f32x4){0.f, 0.f, 0.f, 0.f};
    bf16x8 At[4][2], B0[2][2], B1[2][2];
    i32x8 At8[4], B08[2], B18[2];
    unsigned curG[2][2] = {{0u, 0u}, {0u, 0u}}, nxtG[2][2] = {{0u, 0u}, {0u, 0u}};
    unsigned cA = cur.A, cB = cur.B;
    PG8_GOFF(curG, cur);
    PG8_STAGE1(PG8_SB(0, 0), cB, voffB); PG8_STAGE1(PG8_SB(0, 1), cB + hstep, voffB); PG8_STAGE_A(PG8_SA(0, 0), cA, 0, curG); PG8_STAGE_A(PG8_SA(0, 1), cA, 1, curG);
    if (wr == 1) PG8_BAR;
    PG8_WAIT_V(2); PG8_BAR;
    PG8_STAGE1(PG8_SB(1, 0), cB + kstep, voffB); PG8_STAGE_A(PG8_SA(1, 0), cA + kstep, 0, curG); PG8_STAGE1(PG8_SB(1, 1), cB + hstep + kstep, voffB);
    PG8_WAIT_V(6); PG8_BAR;
    for (;;) {
        const bool has_next = S.next(ui + 1, nxt);
        const unsigned nA = has_next ? nxt.A : cA, nB = has_next ? nxt.B : cB;
        if (GATHER) { if (has_next) PG8_GOFF(nxtG, nxt); else { _Pragma("unroll") for (int _h = 0; _h < 2; ++_h) _Pragma("unroll") for (int _i = 0; _i < 2; ++_i) nxtG[_h][_i] = curG[_h][_i]; } }
#pragma unroll 1
        for (int t = 0; t < nt; t += 2) {
            const bool last = (t == nt - 2);
            const unsigned a1 = cA + (unsigned)(t + 1) * kstep;
            const unsigned a2 = last ? nA : cA + (unsigned)(t + 2) * kstep, b2 = last ? nB : cB + (unsigned)(t + 2) * kstep;
            const unsigned a3 = a2 + kstep, b3 = b2 + kstep;
            if (F8) { PG8_LDB8(B08, 0, 0); PG8_LDB8(B18, 0, 1); PG8_SCHED; PG8_LDA8(At8, 0, 0); } else { PG8_LDB(B0, 0, 0); PG8_LDB(B1, 0, 1); PG8_SCHED; PG8_LDA(At, 0, 0); } PG8_STAGE_A(PG8_SA(1, 1), a1, 1, curG);
            if (GATHER) { if (last) { _Pragma("unroll") for (int _h = 0; _h < 2; ++_h) _Pragma("unroll") for (int _i = 0; _i < 2; ++_i) curG[_h][_i] = nxtG[_h][_i]; } }
            PG8_WAIT_V(8); PG8_WAIT_L(0); PG8_BAR; if (F8) { PG8_MMA8(0, 0, At8, B08); PG8_MMA8(0, 1, At8, B18); } else { PG8_MMA(0, 0, At, B0); PG8_MMA(0, 1, At, B1); } PG8_BAR; PG8_SCHED;
            if (F8) PG8_LDA8(At8, 0, 1); else PG8_LDA(At, 0, 1); PG8_STAGE1(PG8_SB(0, 0), b2, voffB); PG8_STAGE1(PG8_SB(0, 1), b2 + hstep, voffB); PG8_STAGE_A(PG8_SA(0, 0), a2, 0, curG);
            PG8_WAIT_V(8); PG8_WAIT_L(0); PG8_BAR; if (!GATHER_NR || cur.nr > HALF) { if (F8) { PG8_MMA8(1, 0, At8, B08); PG8_MMA8(1, 1, At8, B18); } else { PG8_MMA(1, 0, At, B0); PG8_MMA(1, 1, At, B1); } } PG8_BAR; PG8_SCHED;
            if (F8) { PG8_LDB8(B08, 1, 0); PG8_LDB8(B18, 1, 1); PG8_SCHED; PG8_LDA8(At8, 1, 0); } else { PG8_LDB(B0, 1, 0); PG8_LDB(B1, 1, 1); PG8_SCHED; PG8_LDA(At, 1, 0); } PG8_STAGE_A(PG8_SA(0, 1), a2, 1, curG);
            PG8_WAIT_V(8); PG8_WAIT_L(0); PG8_BAR; if (F8) { PG8_MMA8(0, 0, At8, B08); PG8_MMA8(0, 1, At8, B18); } else { PG8_MMA(0, 0, At, B0); PG8_MMA(0, 1, At, B1); } PG8_BAR; PG8_SCHED;
            if (F8) PG8_LDA8(At8, 1, 1); else PG8_LDA(At, 1, 1); PG8_STAGE1(PG8_SB(1, 0), b3, voffB); PG8_STAGE1(PG8_SB(1, 1), b3 + hstep, voffB); PG8_STAGE_A(PG8_SA(1, 0), a3, 0, curG);
            PG8_WAIT_V(8); PG8_WAIT_L(0); PG8_BAR; if (!GATHER_NR || cur.nr > HALF) { if (F8) { PG8_MMA8(1, 0, At8, B08); PG8_MMA8(1, 1, At8, B18); } else { PG8_MMA(1, 0, At, B0); PG8_MMA(1, 1, At, B1); } } PG8_BAR; PG8_SCHED;
        }
        if (wr == 0) PG8_BAR;
        { const int l2 = lane_id();
          E(acc, cur, wr, wc, l2 & 15, l2 >> 4); }
        if (!has_next) break;
        if (!E.keep(cur)) {
#pragma unroll
        for (int a = 0; a < 2; ++a)
#pragma unroll
            for (int b = 0; b < 2; ++b)
#pragma unroll
                for (int m = 0; m < 4; ++m)
#pragma unroll
                    for (int n = 0; n < 2; ++n) acc[a][b][m][n] = (f32x4){0.f, 0.f, 0.f, 0.f};
        }
        cur = nxt; cA = nA; cB = nB; ++ui;
        if (wr == 1) PG8_BAR;
    }
    PG8_WAIT_V(0);
    PG8_BAR;
#undef PG8_SA
#undef PG8_SB
#undef PG8_STAGE
#undef PG8_STAGE1
#undef PG8_STAGE_A
#undef PG8_LDA
#undef PG8_LDA8
#undef PG8_LD32
#undef PG8_LDB8
#undef PG8_MMA8
#undef PG8_LDB
#undef PG8_MMA
#undef PG8_WAIT_V
#undef PG8_WAIT_L
#undef PG8_BAR
#undef PG8_SCHED
#undef PG8_GOFF
}

struct GridOrder {
    unsigned A0, B0, asub, bsub; int nsub, nM, nN, nwg, G, c; unsigned astep, bstep;
    __device__ __forceinline__ void init(int M, int N, int K, int G_, int c_, int nsub_) { nM = M / BM; nN = N / BM; nwg = nM * nN; G = G_; c = c_; nsub = nsub_; astep = (unsigned)BM * (unsigned)K * 2u; bstep = astep; asub = 0; bsub = 0; }
    __device__ __forceinline__ bool next(int i, Unit& u) const {
        const int sub = i % nsub; const long L = (long)(i / nsub) * G + c; if (L >= nwg) return false;
        int wgid = (int)L; { const int q = nwg / NXCD, r = nwg % NXCD, xcd = wgid % NXCD, off = wgid / NXCD; wgid = (xcd < r ? xcd * (q + 1) : r * (q + 1) + (xcd - r) * q) + off; }
        const int nig = WGM * nN, gid = wgid / nig, fm = gid * WGM, gsz = (nM - fm) < WGM ? (nM - fm) : WGM;
        u.pm = fm + ((wgid % nig) % gsz); u.pn = (wgid % nig) / gsz; u.aux = sub; u.nr = BM;
        const unsigned a_ = A0 + (unsigned)sub * asub, b_ = B0 + (unsigned)sub * bsub;
        u.A = a_ + (unsigned)u.pm * astep; u.B = b_ + (unsigned)u.pn * bstep; return true;
    }
    __device__ __forceinline__ int row_index(const Unit&, int r) const { return r; }
};
}
namespace pg8 {
#define EPI_FOR_AI_M _Pragma("unroll") for (int ai = 0; ai < 2; ++ai) _Pragma("unroll") for (int m = 0; m < 4; ++m)
__device__ __forceinline__ u32x4 pack8(const f32x4& v0, const f32x4& v1) { u32x4 w; w.x = cvt_pk_bf16(v0[0], v0[1]); w.y = cvt_pk_bf16(v0[2], v0[3]); w.z = cvt_pk_bf16(v1[0], v1[1]); w.w = cvt_pk_bf16(v1[2], v1[3]); return w; }
__device__ __forceinline__ void unpack8(const u32x4& w, f32x4& v0, f32x4& v1) { v0 = (f32x4){bflo(w.x), bfhi(w.x), bflo(w.y), bfhi(w.y)}; v1 = (f32x4){bflo(w.z), bfhi(w.z), bflo(w.w), bfhi(w.w)}; }
__device__ __forceinline__ float silu_mul(float g, float u) { return g * u * __builtin_amdgcn_rcpf(1.f + __expf(-g)); }
__device__ __forceinline__ f32x4 silu_mul8(const f32x4& ga, const f32x4& ua) {
    constexpr float C1 = (W8_SCALE * W8_SCALE) / H8_SCALE;
    const f32x4 t = ga * (-W8_INV * LOG2E); f32x4 e;
#pragma unroll
    for (int j = 0; j < 4; ++j) e[j] = __builtin_amdgcn_exp2f(t[j]);
    const f32x4 d = e * C1 + C1; f32x4 r;
#pragma unroll
    for (int j = 0; j < 4; ++j) r[j] = __builtin_amdgcn_rcpf(d[j]);
    return (ga * ua) * r;
}

struct EpiProj {
    static constexpr bool PERM = true;
    bf16_t* O;
    __device__ __forceinline__ bool keep(const Unit&) const { return false; }
    __device__ __forceinline__ void operator()(f32x4 (&acc)[2][2][4][2], const Unit& u, int wr, int wc, int fr, int fq) const {
        const int row0 = u.pm * BM + wr * 64 + fr, col0 = u.pn * BM + wc * 32 + 8 * fq;
        const int pn = u.pn;
        const float sc = (pn < 2 || pn == 6 || pn == 7) ? QS64 : ((pn == 9 || pn == 10) ? QS128 : 1.f);
        EPI_FOR_AI_M { bf16_t* rowp = O + (size_t)(row0 + ai * HALF + m * 16) * IN_COLS + col0;
#pragma unroll
            for (int bj = 0; bj < 2; ++bj) *(u32x4*)(rowp + bj * HALF) = pack8(acc[ai][bj][m][0] * sc, acc[ai][bj][m][1] * sc); }
    }
};
struct EpiGate8 {
    static constexpr bool PERM = true;
    const PG8_LAS float* b_gate; unsigned char* GT;
    __device__ __forceinline__ bool keep(const Unit&) const { return false; }
    __device__ __forceinline__ void operator()(f32x4 (&acc)[2][2][4][2], const Unit& u, int wr, int wc, int fr, int fq) const {
        const int col0 = u.pn * BM + wc * 32 + 8 * fq;
        f32x4 bv[2][2];
#pragma unroll
        for (int bj = 0; bj < 2; ++bj)
#pragma unroll
            for (int n = 0; n < 2; ++n) bv[bj][n] = *(const PG8_LAS f32x4*)(b_gate + col0 + bj * HALF + 4 * n);
        unsigned char* tile = GT + ((size_t)(u.pm * 12 + u.pn) * 8) * 512 * 16;
        unsigned off = (unsigned)((wr * 4 + wc) * 64 + (fq * 16 + fr)) * 16u;
        EPI_FOR_AI_M { u32x4 w; w.x = 0u; w.y = 0u; w.z = 0u; w.w = 0u;
#pragma unroll
            for (int j = 0; j < 4; ++j) {
                const f32x4 t0 = acc[ai][0][m][0] * (-W8_INV * LOG2E) + bv[0][0], t1 = acc[ai][0][m][1] * (-W8_INV * LOG2E) + bv[0][1], t2 = acc[ai][1][m][0] * (-W8_INV * LOG2E) + bv[1][0], t3 = acc[ai][1][m][1] * (-W8_INV * LOG2E) + bv[1][1];
                w.x = __builtin_amdgcn_cvt_pk_u8_f32(__builtin_amdgcn_rcpf((1.f / 255.f) + __builtin_amdgcn_exp2f(__builtin_amdgcn_fmed3f(t0[j], -30.f * LOG2E - LOG2_255, GATE_TMAX))), (unsigned)j, w.x);
                w.y = __builtin_amdgcn_cvt_pk_u8_f32(__builtin_amdgcn_rcpf((1.f / 255.f) + __builtin_amdgcn_exp2f(__builtin_amdgcn_fmed3f(t1[j], -30.f * LOG2E - LOG2_255, GATE_TMAX))), (unsigned)j, w.y);
                w.z = __builtin_amdgcn_cvt_pk_u8_f32(__builtin_amdgcn_rcpf((1.f / 255.f) + __builtin_amdgcn_exp2f(__builtin_amdgcn_fmed3f(t2[j], -30.f * LOG2E - LOG2_255, GATE_TMAX))), (unsigned)j, w.z);
                w.w = __builtin_amdgcn_cvt_pk_u8_f32(__builtin_amdgcn_rcpf((1.f / 255.f) + __builtin_amdgcn_exp2f(__builtin_amdgcn_fmed3f(t3[j], -30.f * LOG2E - LOG2_255, GATE_TMAX))), (unsigned)j, w.w); }
            *(u32x4*)(tile + off) = w; off += 512u * 16u; asm volatile("" : "+v"(off)); }
    }
};
struct EpiBf16 {
    static constexpr bool PERM = true;
    bf16_t* O; int ldc; float sc;
    __device__ __forceinline__ bool keep(const Unit&) const { return false; }
    __device__ __forceinline__ void operator()(f32x4 (&acc)[2][2][4][2], const Unit& u, int wr, int wc, int fr, int fq) const {
        const int row0 = u.pm * BM + wr * 64 + fr, col0 = u.pn * BM + wc * 32 + 8 * fq;
        EPI_FOR_AI_M { bf16_t* rowp = O + (size_t)(row0 + ai * HALF + m * 16) * ldc + col0;
#pragma unroll
            for (int bj = 0; bj < 2; ++bj) *(u32x4*)(rowp + bj * HALF) = pack8(acc[ai][bj][m][0] * sc, acc[ai][bj][m][1] * sc); }
    }
};
struct EpiOutProj {
    static constexpr bool PERM = true;
    unsigned char* O; const u32x4* GT;
    __device__ __forceinline__ bool keep(const Unit& u) const { return u.aux != 2; }
    __device__ __forceinline__ void operator()(f32x4 (&acc)[2][2][4][2], const Unit& u, int wr, int wc, int fr, int fq) const {
        const int row0 = u.pm * BM + wr * 64 + fr, col0 = u.pn * BM + wc * 32 + 8 * fq; const int sub = u.aux;
        const u32x4* ga = GT + ((size_t)(u.pm * 12 + sub * 4 + u.pn) * 8) * 512 + (wr * 4 + wc) * 64 + (fq * 16 + fr);
        const u32x4* gb = ga + (sub != 2 ? (size_t)4 * 8 * 512 : 0);
#pragma unroll
        for (int ai = 0; ai < 2; ++ai) {
            u32x2 wa[4][2], wb[4][2];
#pragma unroll
            for (int m = 0; m < 4; ++m) { const int fi = (ai * 4 + m) * 512; const u32x4 qa = ga[fi], qb = gb[fi];
                wa[m][0].x = qa.x; wa[m][0].y = qa.y; wa[m][1].x = qa.z; wa[m][1].y = qa.w; wb[m][0].x = qb.x; wb[m][0].y = qb.y; wb[m][1].x = qb.z; wb[m][1].y = qb.w; }
#pragma unroll
            for (int m = 0; m < 4; ++m) { const size_t row = (size_t)(row0 + ai * HALF + m * 16);
#pragma unroll
                for (int bj = 0; bj < 2; ++bj) {
                    f32x4 a0, a1;
#pragma unroll
                    for (int j = 0; j < 4; ++j) { a0[j] = (float)((wa[m][bj].x >> (8 * j)) & 0xffu); a1[j] = (float)((wa[m][bj].y >> (8 * j)) & 0xffu); }
                    if (sub != 2) {
#pragma unroll
                        for (int j = 0; j < 4; ++j) { a0[j] *= __builtin_amdgcn_rcpf((float)((wb[m][bj].x >> (8 * j)) & 0xffu)); a1[j] *= __builtin_amdgcn_rcpf((float)((wb[m][bj].y >> (8 * j)) & 0xffu)); } }
                    acc[ai][bj][m][0] = acc[ai][bj][m][0] * a0; acc[ai][bj][m][1] = acc[ai][bj][m][1] * a1;
                    if (sub == 2) { constexpr float sc = M8_SCALE / (O8_SCALE * W8_SCALE * 255.f); const f32x4 v0 = acc[ai][bj][m][0] * sc, v1 = acc[ai][bj][m][1] * sc;
                        u32x2 w; w.x = pack4_e4m3(v0[0], v0[1], v0[2], v0[3]); w.y = pack4_e4m3(v1[0], v1[1], v1[2], v1[3]); *(u32x2*)(O + row * D + col0 + bj * HALF) = w; } } }
        }
    }
};
struct EpiY {
    static constexpr bool PERM = true;
    bf16_t* Z; const bf16_t* XB;
    __device__ __forceinline__ bool keep(const Unit&) const { return false; }
    __device__ __forceinline__ void operator()(f32x4 (&acc)[2][2][4][2], const Unit& u, int wr, int wc, int fr, int fq) const {
        const int row0 = u.pm * BM + wr * 64 + fr, col0 = u.pn * BM + wc * 32 + 8 * fq;
        u32x4 xv[2][4][2];
#pragma unroll
        for (int ai = 0; ai < 2; ++ai)
#pragma unroll
            for (int m = 0; m < 4; ++m) { const size_t off = (size_t)(row0 + ai * HALF + m * 16) * D + col0;
#pragma unroll
                for (int bj = 0; bj < 2; ++bj) xv[ai][m][bj] = *(const u32x4*)(XB + off + bj * HALF); }
#pragma unroll
        for (int ai = 0; ai < 2; ++ai)
#pragma unroll
            for (int m = 0; m < 4; ++m) { const size_t off = (size_t)(row0 + ai * HALF + m * 16) * D + col0;
#pragma unroll
                for (int bj = 0; bj < 2; ++bj) { f32x4 x0, x1; unpack8(xv[ai][m][bj], x0, x1);
                    *(u32x4*)(Z + off + bj * HALF) = pack8(x0 * ALPHA + acc[ai][bj][m][0] * (1.f / (M8_SCALE * W8_SCALE)), x1 * ALPHA + acc[ai][bj][m][1] * (1.f / (M8_SCALE * W8_SCALE))); } }
    }
};
struct EpiRouter {
    static constexpr bool PERM = true;
    float* logits;
    __device__ __forceinline__ bool keep(const Unit&) const { return false; }
    __device__ __forceinline__ void operator()(f32x4 (&acc)[2][2][4][2], const Unit& u, int wr, int wc, int fr, int fq) const {
        const int row0 = u.pm * BM + wr * 64 + fr, c8 = wc * 32 + 8 * fq;
        EPI_FOR_AI_M { float* rowp = logits + (size_t)(row0 + ai * HALF + m * 16) * NE + c8;
#pragma unroll
            for (int bj = 0; bj < 2; ++bj) { *(f32x4*)(rowp + bj * HALF) = acc[ai][bj][m][0]; *(f32x4*)(rowp + bj * HALF + 4) = acc[ai][bj][m][1]; } }
    }
};
struct EpiShared8 {
    static constexpr bool PERM = true;
    unsigned char* HS;
    __device__ __forceinline__ bool keep(const Unit&) const { return false; }
    __device__ __forceinline__ void operator()(f32x4 (&acc)[2][2][4][2], const Unit& u, int wr, int wc, int fr, int fq) const {
        const int row0 = u.pm * BM + wr * 64 + fr, c8 = wc * 32 + 8 * fq;
        EPI_FOR_AI_M { f32x4 h0, h1;
            h0 = silu_mul8(acc[ai][0][m][0], acc[ai][1][m][0]); h1 = silu_mul8(acc[ai][0][m][1], acc[ai][1][m][1]);
            u32x2 w; w.x = pack4_e4m3(h0[0], h0[1], h0[2], h0[3]); w.y = pack4_e4m3(h1[0], h1[1], h1[2], h1[3]);
            *(u32x2*)(HS + (size_t)(row0 + ai * HALF + m * 16) * EFF + u.pn * HALF + c8) = w; }
    }
};
struct EpiExpGU {
    static constexpr bool PERM = true;
    bf16_t* H;
    __device__ __forceinline__ bool keep(const Unit&) const { return false; }
    __device__ __forceinline__ void operator()(f32x4 (&acc)[2][2][4][2], const Unit& u, int wr, int wc, int fr, int fq) const {
        const int c8 = wc * 32 + 8 * fq;
        EPI_FOR_AI_M { const int rl = ai * HALF + wr * 64 + m * 16 + fr; f32x4 h0, h1;
#pragma unroll
            for (int j = 0; j < 4; ++j) { h0[j] = silu_mul(acc[ai][0][m][0][j], acc[ai][1][m][0][j]); h1[j] = silu_mul(acc[ai][0][m][1][j], acc[ai][1][m][1][j]); }
            if (rl < u.nr) *(u32x4*)(H + (size_t)(u.pm + rl) * EFF + u.pn * HALF + c8) = pack8(h0, h1); }
    }
};
struct EpiExpGU8 {
    static constexpr bool PERM = true;
    unsigned char* H;
    __device__ __forceinline__ bool keep(const Unit&) const { return false; }
    __device__ __forceinline__ void operator()(f32x4 (&acc)[2][2][4][2], const Unit& u, int wr, int wc, int fr, int fq) const {
        const int c8 = wc * 32 + 8 * fq;
        EPI_FOR_AI_M { const int rl = ai * HALF + wr * 64 + m * 16 + fr; f32x4 h0, h1;
            h0 = silu_mul8(acc[ai][0][m][0], acc[ai][1][m][0]); h1 = silu_mul8(acc[ai][0][m][1], acc[ai][1][m][1]);
            if (rl < u.nr) { u32x2 w; w.x = pack4_e4m3(h0[0], h0[1], h0[2], h0[3]); w.y = pack4_e4m3(h1[0], h1[1], h1[2], h1[3]);
                *(u32x2*)(H + (size_t)(u.pm + rl) * EFF + u.pn * HALF + c8) = w; } }
    }
};
__device__ __forceinline__ unsigned pack4_fp8(const f32x4& v) {
    const float a = fminf(fmaxf(v[0] * YS_SCALE, -448.f), 448.f), b = fminf(fmaxf(v[1] * YS_SCALE, -448.f), 448.f), c = fminf(fmaxf(v[2] * YS_SCALE, -448.f), 448.f), d = fminf(fmaxf(v[3] * YS_SCALE, -448.f), 448.f);
    unsigned w = __builtin_amdgcn_cvt_pk_fp8_f32(a, b, 0u, false); return __builtin_amdgcn_cvt_pk_fp8_f32(c, d, w, true);
}
struct EpiExpDown {
    static constexpr bool PERM = true;
    unsigned char* Y; float sc;
    __device__ __forceinline__ bool keep(const Unit&) const { return false; }
    __device__ __forceinline__ void operator()(f32x4 (&acc)[2][2][4][2], const Unit& u, int wr, int wc, int fr, int fq) const {
        const int col0 = u.pn * BM + wc * 32 + 8 * fq;
        EPI_FOR_AI_M { const int rl = ai * HALF + wr * 64 + m * 16 + fr;
            if (rl < u.nr) { unsigned char* rowp = Y + (size_t)(u.pm + rl) * D + col0;
#pragma unroll
                for (int bj = 0; bj < 2; ++bj) { u32x2 w; w.x = pack4_fp8(acc[ai][bj][m][0] * sc); w.y = pack4_fp8(acc[ai][bj][m][1] * sc); *(u32x2*)(rowp + bj * HALF) = w; } } }
    }
};
struct ExpertOrder {
    const PG8_LAS int* offs; const PG8_LAS int* cnt; const PG8_LAS unsigned short* tmap;
    int nN, nwg, G, c; unsigned A; const int* rows; unsigned arow; unsigned Bb, bexp, bstep;
    __device__ __forceinline__ bool next(int i, Unit& u) const {
        const long L = (long)i * G + c; if (L >= nwg) return false;
        int wgid = (int)L; { const int q = nwg / NXCD, r = nwg % NXCD, xcd = wgid % NXCD, off = wgid / NXCD; wgid = (xcd < r ? xcd * (q + 1) : r * (q + 1) + (xcd - r) * q) + off; }
        const int tile = wgid / nN; u.pn = wgid % nN;
        const int tm = __builtin_amdgcn_readfirstlane((int)tmap[tile]); const int e = tm >> 7, ti = tm & 127;
        const int ce = __builtin_amdgcn_readfirstlane(cnt[e]), oe = __builtin_amdgcn_readfirstlane(offs[e]);
        u.aux = e; u.pm = oe + 256 * ti; u.nr = (ce - 256 * ti) < 256 ? (ce - 256 * ti) : 256;
        u.A = rows ? A : A + (unsigned)u.pm * arow; u.B = Bb + (unsigned)u.aux * bexp + (unsigned)u.pn * bstep; return true;
    }
    __device__ __forceinline__ int row_index(const Unit& u, int r) const { const int rc = r < u.nr ? r : u.nr - 1; return rows[(size_t)u.aux * T + (u.pm - offs[u.aux]) + rc]; }
};
__device__ __forceinline__ int build_tile_map(const unsigned* counts, PG8_LAS int* tab, int tid) {
    PG8_LAS int* offs = tab; PG8_LAS int* cnt = tab + 256; PG8_LAS unsigned short* tmap = (PG8_LAS unsigned short*)(tab + 512); PG8_LAS int* tot = tab + 512 + 640;
    if (tid < 256) cnt[tid] = (int)__hip_atomic_load(&counts[tid], __ATOMIC_RELAXED, __HIP_MEMORY_SCOPE_AGENT);
    __syncthreads();
    if (tid < 64) {
        int c[4], t[4], sc = 0, st = 0;
#pragma unroll
        for (int j = 0; j < 4; ++j) { c[j] = cnt[4 * tid + j]; t[j] = (c[j] + 255) >> 8; sc += c[j]; st += t[j]; }
        int isc = sc, ist = st;
#pragma unroll
        for (int off = 1; off < 64; off <<= 1) { const int a = __shfl_up(isc, off), b = __shfl_up(ist, off); if (tid >= off) { isc += a; ist += b; } }
        int o = isc - sc, t0 = ist - st;
#pragma unroll
        for (int j = 0; j < 4; ++j) { offs[4 * tid + j] = o;
            for (int i = 0; i < t[j]; ++i) tmap[t0 + i] = (unsigned short)(((4 * tid + j) << 7) | i);
            o += c[j]; t0 += t[j]; }
        if (tid == 63) tot[0] = ist;
    }
    __syncthreads();
    return tot[0];
}

__device__ __forceinline__ void down_phase(PG8_LAS unsigned char* lds, unsigned char* wsbase, const PG8_LAS int* offs, const PG8_LAS int* cnt, const PG8_LAS int* srt, const int G, const int c, const unsigned Abase_r, const unsigned Bbase_r, const unsigned Ybase_r, const unsigned Abase_s, const unsigned Bbase_s, const unsigned Ybase_s  , const unsigned dump0, const float sc, const int wave, const int probe  ) {
    const __amdgpu_buffer_rsrc_t rsrc = __builtin_amdgcn_make_buffer_rsrc((void*)wsbase, 0, 0x7fffffff, 0x00020000);
    const int tid = otid(wave), wid = wave, lane = tid & 63, wr = wid >> 2, wc = wid & 3, fr = lane & 15, fq = lane >> 4;
    constexpr unsigned ROWB = EFF;
    unsigned voffA[2];
#pragma unroll
    for (int i = 0; i < 2; ++i) { int R, C; stage_rc8(tid * 16 + i * 8192, R, C); voffA[i] = (unsigned)R * ROWB + (unsigned)C * 2u; }
    const unsigned ldsw = (unsigned)wid * 1024u, ldsb = (unsigned)(size_t)lds;
    const int aoff8 = lds_byte8(wr * 64 + fr, 2 * fq), aoff8h = lds_byte8(wr * 64 + fr, 2 * fq + 1);
#define DN_LD32(offl_, offh_) ({ union { i32x8 v; u32x4 h[2]; } u_; u_.h[0] = *(const PG8_LAS u32x4*)(lds + (offl_)); u_.h[1] = *(const PG8_LAS u32x4*)(lds + (offh_)); u_.v; })
#define DN_LOAD(ldsoff, goff, voff) do { _Pragma("unroll") for (int _i = 0; _i < 2; ++_i) \
        asm volatile("s_mov_b32 m0, %0\n\ts_nop 0\n\tbuffer_load_dwordx4 %1, %2, %3 offen lds" :: "s"(ldsb + (unsigned)(ldsoff) + ldsw + (unsigned)(_i * 8192)), "v"((voff)[_i]), "s"(rsrc), "s"((unsigned)(goff)) : "m0", "memory"); } while (0)
#define DN_STAGE_A(st) do { if (probe == 3) break; const int _s = (st) < nst ? (st) : nst - 1; const unsigned _g = arow0 + (unsigned)_s * (128u * ROWB); const unsigned _l = (unsigned)((st) & 3) * 32768u; \
        DN_LOAD(_l, _g, voffA); DN_LOAD(_l + 16384u, _g + 128u, voffA); } while (0)
#define DN_WAIT(n) asm volatile("s_waitcnt vmcnt(" #n ")" ::: "memory")
#define DN_BAR __builtin_amdgcn_s_barrier()
    for (int it = 0;; ++it) {
        constexpr int NSH = (T / 512) * 4;
        const int L = it * G + c; if (L >= NE * 4 + NSH) break;
        const bool sh = L >= NE * 4;
        int e, pn;
        if (sh) { if (G == 256) { e = (c & 7) + 8 * (c >> 5); pn = (c >> 3) & 3; } else { e = (L - NE * 4) >> 2; pn = (L - NE * 4) & 3; } }
        else if (G == 256) { const int g = (c & 7) + 8 * (c >> 5); pn = (c >> 3) & 3; e = __builtin_amdgcn_readfirstlane(srt[it * 64 + ((it & 1) ? 63 - g : g)]); }
        else { const int x = L & 7, j = L >> 3; e = ((j >> 2) << 3) | x; pn = j & 3; }
        const int ce = sh ? 512 : __builtin_amdgcn_readfirstlane(cnt[e]), oe = sh ? 512 * e : __builtin_amdgcn_readfirstlane(offs[e]);
        if (ce <= 0) continue;
        const int nst = (ce + 127) >> 7;
        const unsigned Ybase = sh ? Ybase_s : Ybase_r;
        const unsigned arow0 = (sh ? Abase_s : Abase_r) + (unsigned)oe * ROWB;
        const unsigned b0 = (sh ? Bbase_s : Bbase_r + (unsigned)e * (unsigned)(D * EFF)) + (unsigned)pn * (256u * ROWB);
        unsigned voffB[2]; int boff8, boff8h;
        { const int t2 = otid(wave), l2 = t2 & 63;
#pragma unroll
          for (int i = 0; i < 2; ++i) { int R, C; stage_rc8(t2 * 16 + i * 8192, R, C); const int Rb = (R >> 5) * 64 + 16 * ((R & 15) >> 2) + 4 * ((R >> 4) & 1) + (R & 3); voffB[i] = (unsigned)Rb * ROWB + (unsigned)C * 2u; }
          boff8 = lds_byte8(wc * 32 + (l2 & 15), 2 * (l2 >> 4)); boff8h = lds_byte8(wc * 32 + (l2 & 15), 2 * (l2 >> 4) + 1); }
#pragma unroll
        for (int b = 0; b < 2; ++b)
#pragma unroll
            for (int h = 0; h < 2; ++h) DN_LOAD(65536u + (unsigned)(b * 2 + h) * 16384u, b0 + (unsigned)h * (8u * ROWB) + (unsigned)b * 128u, voffB);
        DN_STAGE_A(0); DN_STAGE_A(1);
        DN_WAIT(8); DN_BAR;
        i32x8 Bf[2][2][2];
#pragma unroll
        for (int b = 0; b < 2; ++b)
#pragma unroll
            for (int bj = 0; bj < 2; ++bj)
#pragma unroll
                for (int n = 0; n < 2; ++n) Bf[b][bj][n] = DN_LD32(65536 + (b * 2 + bj) * 16384 + boff8 + n * 2048, 65536 + (b * 2 + bj) * 16384 + boff8h + n * 2048);
        asm volatile("s_waitcnt lgkmcnt(0)" ::: "memory");
#pragma unroll
        for (int b = 0; b < 2; ++b)
#pragma unroll
            for (int bj = 0; bj < 2; ++bj)
#pragma unroll
                for (int n = 0; n < 2; ++n) asm volatile("" : "+v"(Bf[b][bj][n]));
        DN_BAR;
        DN_STAGE_A(2); DN_STAGE_A(3);
        f32x4 acc[2][4][2];
#pragma unroll
        for (int bj = 0; bj < 2; ++bj)
#pragma unroll
            for (int m = 0; m < 4; ++m)
#pragma unroll
                for (int n = 0; n < 2; ++n) acc[bj][m][n] = (f32x4){0.f, 0.f, 0.f, 0.f};
#define DN_MFMA(st) do { const int _q = (st) & 3; const f32x4 _z = {0.f, 0.f, 0.f, 0.f}; if (probe == 2) { _Pragma("unroll") for (int bj = 0; bj < 2; ++bj) _Pragma("unroll") for (int m = 0; m < 4; ++m) _Pragma("unroll") for (int n = 0; n < 2; ++n) acc[bj][m][n] = _z; break; } \
        { i32x8 At[4]; \
          _Pragma("unroll") for (int m = 0; m < 4; ++m) At[m] = DN_LD32(_q * 32768 + aoff8 + m * 2048, _q * 32768 + aoff8h + m * 2048); \
          __builtin_amdgcn_s_setprio(1); \
          _Pragma("unroll") for (int bj = 0; bj < 2; ++bj) _Pragma("unroll") for (int m = 0; m < 4; ++m) _Pragma("unroll") for (int n = 0; n < 2; ++n) \
              acc[bj][m][n] = __builtin_amdgcn_mfma_scale_f32_16x16x128_f8f6f4(Bf[0][bj][n], At[m], _z, 0, 0, 0, 0x79797979  , 0, 0x7F7F7F7F);     \
          __builtin_amdgcn_s_setprio(0); __builtin_amdgcn_sched_barrier(0); } \
        { i32x8 At[4]; \
          _Pragma("unroll") for (int m = 0; m < 4; ++m) At[m] = DN_LD32(_q * 32768 + 16384 + aoff8 + m * 2048, _q * 32768 + 16384 + aoff8h + m * 2048); \
          __builtin_amdgcn_s_setprio(1); \
          _Pragma("unroll") for (int bj = 0; bj < 2; ++bj) _Pragma("unroll") for (int m = 0; m < 4; ++m) _Pragma("unroll") for (int n = 0; n < 2; ++n) \
              acc[bj][m][n] = __builtin_amdgcn_mfma_scale_f32_16x16x128_f8f6f4(Bf[1][bj][n], At[m], acc[bj][m][n], 0, 0, 0, 0x79797979  , 0, 0x7F7F7F7F); \
          __builtin_amdgcn_s_setprio(0); __builtin_amdgcn_sched_barrier(0); } } while (0)
#define DN_EPI(st) do { const int _l = lane_id(), _fr = _l & 15, _fq = _l >> 4;     \
        const int _r0 = (st) * 128 + wr * 64 + _fr; const unsigned _y0 = Ybase + (unsigned)(oe + _r0) * (unsigned)D + (unsigned)(pn * 256 + wc * 64 + 16 * _fq); const unsigned dump = dump0 + (unsigned)(wid * 64 + _l) * 16u; \
        _Pragma("unroll") for (int m = 0; m < 4; ++m) { const bool _ok = (_r0 + 16 * m) < ce && probe != 1; u32x4 w; \
            { const f32x4 v0 = acc[0][m][0], v1 = acc[0][m][1], v2 = acc[1][m][0], v3 = acc[1][m][1]; \
              w.x = pack4_e4m3(v0[0], v0[1], v0[2], v0[3]); w.y = pack4_e4m3(v1[0], v1[1], v1[2], v1[3]); w.z = pack4_e4m3(v2[0], v2[1], v2[2], v2[3]); w.w = pack4_e4m3(v3[0], v3[1], v3[2], v3[3]); } \
            const unsigned _o = _ok ? _y0 + (unsigned)(16 * m) * (unsigned)D : dump; \
            __builtin_amdgcn_raw_buffer_store_b128(w, rsrc, (int)_o, 0, 0); } } while (0)
#define DN_STEP_HEAD(s) do { if ((s) >= 4) DN_WAIT(20); else if ((s) == 3) DN_WAIT(16); else if ((s) == 2) DN_WAIT(12); else if ((s) == 1) DN_WAIT(8); else DN_WAIT(12);     \
            DN_BAR; \
            if ((s) >= 1) DN_STAGE_A((s) + 3);                           } while (0)
        if (wr == 0) {
            for (int s = 0; s < nst; ++s) { DN_STEP_HEAD(s); DN_MFMA(s); DN_BAR; DN_EPI(s); }
        } else {
            for (int s = 0; s < nst; ++s) { DN_STEP_HEAD(s); if (s >= 1) { DN_EPI(s - 1); } DN_BAR; DN_MFMA(s); }
            DN_EPI(nst - 1);
        }
#undef DN_STEP_HEAD
        DN_WAIT(0); DN_BAR;
    }
#undef DN_LOAD
#undef DN_LD32
#undef DN_STAGE_A
#undef DN_WAIT
#undef DN_BAR
#undef DN_MFMA
#undef DN_EPI
}
}
namespace att {
#define ALAS __attribute__((address_space(3)))
typedef short s16x4 __attribute__((ext_vector_type(4)));
constexpr int KSLOT = 16384, VSLOT = 16384, LDS_K = 0, LDS_V = 2 * KSLOT, LDS_FLAG = 4 * KSLOT;
enum { SB = 0, SWA = 1, MEM = 2 };
__device__ __forceinline__ int crow(int r, int hi) { return (r & 3) + 8 * (r >> 2) + 4 * hi; }
__device__ __forceinline__ unsigned cvtpk(float lo, float hi) { typedef float f2 __attribute__((ext_vector_type(2))); typedef __bf16 b2 __attribute__((ext_vector_type(2))); f2 v = {lo, hi}; b2 b = __builtin_convertvector(v, b2); return __builtin_bit_cast(unsigned, b); }
__device__ __forceinline__ float xhalf(float v) { return __shfl_xor(v, 32); }
__device__ __forceinline__ s16x4 vtr(const ALAS char* p) { typedef short v4i16_t __attribute__((ext_vector_type(4))); return __builtin_bit_cast(s16x4, __builtin_amdgcn_ds_read_tr16_b64_v4i16((ALAS v4i16_t*)p)); }

__device__ __forceinline__ void att_bar() { asm volatile("s_waitcnt lgkmcnt(0)" ::: "memory"); __builtin_amdgcn_s_barrier(); asm volatile("" ::: "memory"); }
template <int HD> struct Stage { u32x4 k[HD / 64], v[HD / 64]; };
template <int HD> __device__ __forceinline__ void tile_load(Stage<HD>& s, const bf16* Kb, const bf16* Vb, int pitch, int kv0, int wid, int lane) {
#pragma unroll
    for (int i = 0; i < HD / 64; ++i) { const int p = wid + 8 * i;
        s.k[i] = *(const u32x4*)(Kb + (size_t)(kv0 + lane) * pitch + p * 8);
        s.v[i] = *(const u32x4*)(Vb + (size_t)(kv0 + 16 * (p & 3) + (lane >> 2)) * pitch + (p >> 2) * 32 + (lane & 3) * 8); }
}
template <int HD> __device__ __forceinline__ void tile_store(const Stage<HD>& s, ALAS char* lds, int slot, int wid, int lane) {
#pragma unroll
    for (int i = 0; i < HD / 64; ++i) { const int p = wid + 8 * i;
        *(ALAS u32x4*)(lds + LDS_K + slot * KSLOT + p * 1024 + lane * 16) = s.k[i];
        *(ALAS u32x4*)(lds + LDS_V + slot * VSLOT + p * 1024 + lane * 16) = s.v[i]; }
}
template <int HD> __device__ __forceinline__ void qkt(f32x16& p0, f32x16& p1, const ALAS char* Kslot, const bf16x8* qr, int r32, int hi) {
    const ALAS char* kb = Kslot + hi * 1024 + r32 * 16;
#pragma unroll
    for (int r = 0; r < 16; ++r) { p0[r] = 0.f; p1[r] = 0.f; }
#pragma unroll
    for (int h0 = 0; h0 < HD / 16; h0 += 4) {
        bf16x8 kf[8];
#pragma unroll
        for (int d = 0; d < 4; ++d) { kf[2 * d] = *(const ALAS bf16x8*)(kb + (h0 + d) * 2048); kf[2 * d + 1] = *(const ALAS bf16x8*)(kb + (h0 + d) * 2048 + 512); }
        __builtin_amdgcn_sched_barrier(0);
#pragma unroll
        for (int d = 0; d < 4; ++d) { p0 = __builtin_amdgcn_mfma_f32_32x32x16_bf16(kf[2 * d], qr[h0 + d], p0, 0, 0, 0); p1 = __builtin_amdgcn_mfma_f32_32x32x16_bf16(kf[2 * d + 1], qr[h0 + d], p1, 0, 0, 0); }
        __builtin_amdgcn_sched_barrier(0);
    }
}
template <int HD> __device__ __forceinline__ void pvT(f32x16* oT, const ALAS char* Vslot, const u32x4* pw, int lane) {
    const int hi = lane >> 5;
    const ALAS char* vb = Vslot + ((lane >> 4) & 1) * 32 + (lane & 3) * 8 + (4 * hi + ((lane & 15) >> 2)) * 64;
#pragma unroll
    for (int dd = 0; dd < HD / 32; dd += 2) {
        s16x4 lo[2][4], h4[2][4];
#pragma unroll
        for (int e = 0; e < 2; ++e)
#pragma unroll
            for (int ks = 0; ks < 4; ++ks) { lo[e][ks] = vtr(vb + (dd + e) * 4096 + ks * 1024); h4[e][ks] = vtr(vb + (dd + e) * 4096 + ks * 1024 + 512); }
        __builtin_amdgcn_sched_barrier(0);
#pragma unroll
        for (int ks = 0; ks < 4; ++ks)
#pragma unroll
            for (int e = 0; e < 2; ++e) {
                const bf16x8 vf = (bf16x8){lo[e][ks][0], lo[e][ks][1], lo[e][ks][2], lo[e][ks][3], h4[e][ks][0], h4[e][ks][1], h4[e][ks][2], h4[e][ks][3]};
                oT[dd + e] = __builtin_amdgcn_mfma_f32_32x32x16_bf16(vf, __builtin_bit_cast(bf16x8, pw[ks]), oT[dd + e], 0, 0, 0); }
        __builtin_amdgcn_sched_barrier(0);
    }
}
__device__ __forceinline__ void pack_p(u32x4* pw, const f32x16& p0, const f32x16& p1) {
#pragma unroll
    for (int i = 0; i < 4; ++i) { pw[0][i] = cvtpk(p0[2 * i], p0[2 * i + 1]); pw[1][i] = cvtpk(p0[8 + 2 * i], p0[9 + 2 * i]); pw[2][i] = cvtpk(p1[2 * i], p1[2 * i + 1]); pw[3][i] = cvtpk(p1[8 + 2 * i], p1[9 + 2 * i]); }
}
__device__ __forceinline__ void sb_tile(f32x16& p0, f32x16& p1, float& Pc, bool masked, int qpos, int kv0, int hi) {
    float gm[32];
#pragma unroll
    for (int r = 0; r < 32; ++r) { const float z = fminf(r < 16 ? p0[r] : p1[r - 16], 100.f);
        const float e = __builtin_amdgcn_exp2f(z); float g = __builtin_amdgcn_rcpf(1.f + e), bt = e * g;
        if (masked) { const int kv = kv0 + crow(r & 15, hi) + (r >> 4) * 32; const bool ok = kv < qpos; g = ok ? g : 1.f; bt = ok ? bt : 0.f; }
        gm[r] = g; if (r < 16) p0[r] = bt; else p1[r - 16] = bt; }
    float suf[9]; suf[8] = 1.f;
#pragma unroll
    for (int g = 7; g >= 0; --g) suf[g] = suf[g + 1] * ((gm[4 * g] * gm[4 * g + 1]) * (gm[4 * g + 2] * gm[4 * g + 3]));
    float psuf[9]; psuf[8] = 1.f;
#pragma unroll
    for (int g = 0; g < 8; ++g) psuf[g] = xhalf(suf[g]);
#pragma unroll
    for (int g = 0; g < 8; ++g) {
        float run = Pc * suf[g + 1] * (hi ? psuf[g + 1] : psuf[g]);
#pragma unroll
        for (int i = 3; i >= 0; --i) { const int r = 4 * g + i;
            if (r < 16) p0[r] *= run; else p1[r - 16] *= run;
            run *= gm[r]; } }
    Pc *= suf[0] * psuf[0];
}

template <int MODE, int ND> __device__ __forceinline__ void soft_tile_(f32x16& p0, f32x16& p1, float& m, float& l, f32x16 (&oT)[ND], float slope, int qpos, int kv0, int hi) {
    float rm = -1e30f;
    if (MODE == SWA) {
#pragma unroll
        for (int r = 0; r < 32; ++r) { const int kv = kv0 + crow(r & 15, hi) + (r >> 4) * 32; const int dist = qpos - kv; const bool valid = dist >= 0 && dist < 128;
            const float z = (r < 16 ? p0[r] : p1[r - 16]) - slope * (float)dist; const float zz = valid ? z : -1e30f;
            if (r < 16) p0[r] = zz; else p1[r - 16] = zz; rm = fmaxf(rm, zz); }
    } else {
#pragma unroll
        for (int r = 0; r < 16; ++r) rm = fmaxf(rm, fmaxf(p0[r], p1[r]));
    }
    rm = fmaxf(rm, xhalf(rm));
    const float mn = fmaxf(m, rm), f = __builtin_amdgcn_exp2f(m - mn); m = mn;
    float ps = 0.f;
#pragma unroll
    for (int r = 0; r < 16; ++r) { p0[r] = __builtin_amdgcn_exp2f(p0[r] - mn); p1[r] = __builtin_amdgcn_exp2f(p1[r] - mn); ps += p0[r] + p1[r]; }
    ps += xhalf(ps);
    l = l * f + ps;
#pragma unroll
    for (int d0 = 0; d0 < ND; ++d0)
#pragma unroll
        for (int r = 0; r < 16; ++r) oT[d0][r] *= f;
}
template <int MODE> __device__ __forceinline__ void soft_tile(f32x16& p0, f32x16& p1, float& m, float& l, f32x16 (&oT)[2], float slope, int qpos, int kv0, int hi) { soft_tile_<MODE, 2>(p0, p1, m, l, oT, slope, qpos, kv0, hi); }
template <int MODE> __device__ __forceinline__ void soft_tile(f32x16& p0, f32x16& p1, float& m, float& l, f32x16 (&oT)[4], float slope, int qpos, int kv0, int hi) { soft_tile_<MODE, 4>(p0, p1, m, l, oT, slope, qpos, kv0, hi); }

struct Params { const bf16* projb; const bf16* mkvb; const float* sinks; unsigned char* osb; unsigned char* osw; unsigned char* om; };

template <int MODE> __device__ __forceinline__ void unit(ALAS char* lds, const Params& P, int b, int h, int qb, const int wid) {
    constexpr int HD = (MODE == MEM) ? 128 : 64;
    const int tid = otid(wid), lane = tid & 63, r32 = lane & 31, hi = lane >> 5;
    const int hq = (MODE == SWA) ? 4 * h + (wid >> 1) : h;
    const int q0 = (MODE == SWA) ? qb * 64 : qb * 256, qw0 = (MODE == SWA) ? q0 + 32 * (wid & 1) : q0 + 32 * wid, qpos = qw0 + r32;
    const bf16* Qb; const bf16* Kb; const bf16* Vb; unsigned char* Ob; int kpitch;
    if (MODE == SB)       { Qb = P.projb + (size_t)b * SEQ * IN_COLS + OFF_QSB + h * 64; Kb = P.projb + (size_t)b * SEQ * IN_COLS + OFF_KSB + h * 64; Vb = P.projb + (size_t)b * SEQ * IN_COLS + OFF_VSB + h * 64; Ob = P.osb + (size_t)b * SEQ * 512 + h * 64; kpitch = IN_COLS; }
    else if (MODE == SWA) { Qb = P.projb + (size_t)b * SEQ * IN_COLS + OFF_QSW + hq * 64; Kb = P.projb + (size_t)b * SEQ * IN_COLS + OFF_KSW + h * 64; Vb = P.projb + (size_t)b * SEQ * IN_COLS + OFF_VSW + h * 64; Ob = P.osw + (size_t)b * SEQ * 512 + hq * 64; kpitch = IN_COLS; }
    else                  { Qb = P.projb + (size_t)b * SEQ * IN_COLS + OFF_QM + h * 128; Kb = P.mkvb + (size_t)b * MEM_LEN * 1024 + h * 128; Vb = P.mkvb + (size_t)b * MEM_LEN * 1024 + 512 + h * 128; Ob = P.om + (size_t)b * SEQ * 512 + h * 128; kpitch = 1024; }
    int jlo, jhi;
    if (MODE == SB) { jlo = 0; jhi = 4 * qb + 3; } else if (MODE == SWA) { jlo = qb - 2; if (jlo < 0) jlo = 0; jhi = qb; } else { jlo = 0; jhi = 3; }
    const int ntile = jhi - jlo + 1, dj = (MODE == SB) ? -1 : 1, jfirst = (MODE == SB) ? jhi : jlo;
    Stage<HD> stA, stB;
    tile_load<HD>(stA, Kb, Vb, kpitch, jfirst * 64, wid, lane);
    tile_load<HD>(stB, Kb, Vb, kpitch, (jfirst + (ntile > 1 ? dj : 0)) * 64, wid, lane);
    bf16x8 qr[HD / 16];
#pragma unroll
    for (int d0 = 0; d0 < HD / 16; ++d0) qr[d0] = *(const bf16x8*)(Qb + (size_t)qpos * IN_COLS + d0 * 16 + hi * 8);
    f32x16 oT[HD / 32];
#pragma unroll
    for (int d0 = 0; d0 < HD / 32; ++d0)
#pragma unroll
        for (int r = 0; r < 16; ++r) oT[d0][r] = 0.f;
    float C = 1.f;
    float m = (MODE == SWA) ? P.sinks[hq] * LOG2E : -1e30f, l = (MODE == SWA) ? 1.f : 0.f;
    const float slope = (MODE == SWA) ? exp2f(-(float)(hq + 1)) * LOG2E : 0.f;
    tile_store<HD>(stA, lds, 0, wid, lane);
#pragma unroll
    for (int d0 = 0; d0 < HD / 16; ++d0) asm volatile("" : "+v"(qr[d0]));
    att_bar();
    bool stop = false;
    ALAS unsigned* dflag = (ALAS unsigned*)(lds + LDS_FLAG + 64);
#define ATT_STEP(it, SLOT, ST_LOAD, ST_STORE) do { \
        const int j = jfirst + (it) * dj, kv0 = j * 64; \
        tile_load<HD>(ST_LOAD, Kb, Vb, kpitch, ((it) + 2 < ntile ? j + 2 * dj : j) * 64, wid, lane);     \
        bool active = true; \
        if (MODE == SB) active = (kv0 <= qw0 + 30) && !__all(C == 0.f);     \
        else if (MODE == SWA) active = (kv0 <= qw0 + 31) && (kv0 + 63 >= qw0 - 127); \
        if (active) { \
            f32x16 p0, p1; \
            qkt<HD>(p0, p1, lds + LDS_K + (SLOT) * KSLOT, qr, r32, hi); \
            if (MODE == SB) { sb_tile(p0, p1, C, kv0 + 63 >= qw0, qpos, kv0, hi); } \
            else { soft_tile<MODE>(p0, p1, m, l, oT, slope, qpos, kv0, hi); } \
            u32x4 pw[4]; pack_p(pw, p0, p1); \
            pvT<HD>(oT, lds + LDS_V + (SLOT) * VSLOT, pw, lane); \
        } \
        tile_store<HD>(ST_STORE, lds, (SLOT) ^ 1, wid, lane); \
        if (MODE == SB) { const int wdone = __all(C == 0.f) ? 1 : 0; if (lane == 0) dflag[((it) & 1) * 8 + wid] = (unsigned)wdone; \
                          att_bar(); \
                          const ALAS u32x4* df = (const ALAS u32x4*)(dflag + ((it) & 1) * 8); const u32x4 f0 = df[0], f1 = df[1]; \
                          if ((f0.x & f0.y & f0.z & f0.w & f1.x & f1.y & f1.z & f1.w) != 0u) stop = true; } \
        else att_bar(); \
    } while (0)
    for (int it = 0; it < ntile && !stop; it += 2) {
        ATT_STEP(it, 0, stA, stB);
        if (stop || it + 1 >= ntile) break;
        ATT_STEP(it + 1, 1, stB, stA);
    }
#undef ATT_STEP
    const float inv = (MODE == SB) ? O8_SCALE : O8_SCALE / l;
    unsigned char* orow = Ob + (size_t)qpos * 512 + 32 * hi;
#pragma unroll
    for (int dp = 0; dp < HD / 64; ++dp) { u32x4 w0, w1; unsigned pk[8];
#pragma unroll
        for (int g = 0; g < 4; ++g) {
            const unsigned P_ = pack4_e4m3(oT[2 * dp][4 * g] * inv, oT[2 * dp][4 * g + 1] * inv, oT[2 * dp][4 * g + 2] * inv, oT[2 * dp][4 * g + 3] * inv);
            const unsigned Q_ = pack4_e4m3(oT[2 * dp + 1][4 * g] * inv, oT[2 * dp + 1][4 * g + 1] * inv, oT[2 * dp + 1][4 * g + 2] * inv, oT[2 * dp + 1][4 * g + 3] * inv);
            const auto sw = __builtin_amdgcn_permlane32_swap(P_, Q_, false, false);
            pk[2 * g] = sw[0]; pk[2 * g + 1] = sw[1]; }
        w0.x = pk[0]; w0.y = pk[1]; w0.z = pk[2]; w0.w = pk[3]; w1.x = pk[4]; w1.y = pk[5]; w1.z = pk[6]; w1.w = pk[7];
        *(u32x4*)(orow + 64 * dp) = w0; *(u32x4*)(orow + 64 * dp + 16) = w1; }
}

constexpr int NUNITS = 2560;
__device__ __forceinline__ void phase(ALAS char* lds, const Params& P, unsigned* queue, int ulo, int uhi, const int wave) {
    volatile ALAS int* flag = (volatile ALAS int*)(lds + LDS_FLAG);
    if (is_t0(wave)) { flag[0] = (int)atomicAdd(queue, 1u); }
    __syncthreads();
    int u = ulo + flag[0];
    for (int k = 0;; ++k) {
        if (u >= uhi) break;
        int tnext = 0; if (is_t0(wave)) tnext = (int)atomicAdd(queue, 1u);
        if (u < 512) { const int qb = u >> 5, bh = u & 31; unit<MEM>(lds, P, bh >> 2, bh & 3, qb, wave); }
        else if (u < 1536) { const int v = u - 512, qb = 15 - (v >> 6), bh = v & 63; unit<SB>(lds, P, bh >> 3, bh & 7, qb, wave); }
        else { const int v = u - 1536, qb = v >> 4, bh = v & 15; unit<SWA>(lds, P, bh >> 1, bh & 1, qb, wave); }
        if (is_t0(wave)) flag[(k + 1) & 1] = tnext;
        __syncthreads();
        u = ulo + flag[(k + 1) & 1];
    }
}
}
constexpr int NWAVES = 8;
constexpr int RING_BYTES = 131072, LDSCTL_OFF = RING_BYTES, MISC_OFF = LDSCTL_OFF + 320, BIAS_OFF = RING_BYTES + 1024  , LDS_BYTES = 147456;
constexpr int NPHASE = 12;
#ifndef CONV_CONTIG
#define CONV_CONTIG 0
#endif
#ifndef NCONV_WG
#define NCONV_WG 80
#endif
constexpr int NCONV = NCONV_WG;
#define GAS __attribute__((address_space(1)))
#define LAS __attribute__((address_space(3)))

#define XB_TMO      128
#define XB_XCNT(j)  (256  + 64 * (j))
#define XB_XSUB(j)  (1280 + 64 * (j))
#define XB_XGEN(j)  (2304 + 64 * (j))
#define XB_TOP      3328
#define XB_TOPGEN   3392
#define XCD_BAR_WORDS 3456
#define XB_SPIN_CAP (1u << 18)
__device__ __forceinline__ unsigned xb_ld(unsigned* p)              { return __hip_atomic_load(p, __ATOMIC_RELAXED, __HIP_MEMORY_SCOPE_AGENT); }
__device__ __forceinline__ unsigned xb_add(unsigned* p, unsigned v) { return __hip_atomic_fetch_add(p, v, __ATOMIC_RELAXED, __HIP_MEMORY_SCOPE_AGENT); }
__device__ __forceinline__ unsigned xb_xcc_id() { return (unsigned)__builtin_amdgcn_s_getreg((3 << 11) | 20) & 0xFu; }
#define XB_SPIN(cond, bar) do { unsigned _sp = 0; while (cond) { __builtin_amdgcn_s_sleep(1); \
    if ((++_sp & 255u) == 0u) { if (xb_ld(&(bar)[XB_TMO])) break; if (_sp > XB_SPIN_CAP) { atomicAdd(&(bar)[XB_TMO], 1u); break; } } } } while (0)
struct XcdBarrier { unsigned* bar; unsigned x; volatile LAS unsigned* st; int wave; };
__device__ __forceinline__ XcdBarrier xcd_barrier_post(unsigned* bar, volatile LAS unsigned* st, int wave) {
    XcdBarrier b; b.bar = bar; b.x = xb_xcc_id(); b.st = st; b.wave = wave;
    if (is_t0(wave)) (void)xb_add(&bar[XB_XCNT(b.x)], 1u);
    return b;
}
__device__ __forceinline__ void xcd_barrier_complete(unsigned* bar, unsigned x, unsigned& nloc, unsigned& nx) {
    const unsigned G = gridDim.x * gridDim.y * gridDim.z;
    unsigned sum, cnt, mine, sp = 0u;
    for (;;) {
        sum = 0u; cnt = 0u; mine = 0u;
#pragma unroll
        for (unsigned j = 0; j < 16; ++j) { const unsigned c = xb_ld(&bar[XB_XCNT(j)]); sum += c; cnt += (c > 0u) ? 1u : 0u; mine = (j == x) ? c : mine; }
        if (sum == G) break;
        __builtin_amdgcn_s_sleep(1);
        if ((++sp & 255u) == 0u) { if (xb_ld(&bar[XB_TMO])) break; if (sp > XB_SPIN_CAP) { atomicAdd(&bar[XB_TMO], 1u); break; } }
    }
    nloc = mine > 0u ? mine : 1u; nx = cnt > 0u ? cnt : 1u;
}
__device__ __forceinline__ void xcd_barrier(const XcdBarrier& b) {
    asm volatile("s_waitcnt vmcnt(0)" ::: "memory");
    __syncthreads();
    if (is_t0(b.wave)) {
        unsigned* bar = b.bar;
        __builtin_amdgcn_s_waitcnt(0);
        unsigned nloc = b.st[0], nx = b.st[1];
        if (nloc == 0u) { xcd_barrier_complete(bar, b.x, nloc, nx); b.st[0] = nloc; b.st[1] = nx; }
        const unsigned old = xb_add(&bar[XB_XSUB(b.x)], 1u);
        const unsigned gen = old / nloc;
        if (old + 1u == (gen + 1u) * nloc) {
            __builtin_amdgcn_fence(__ATOMIC_RELEASE, "agent");
            asm volatile("s_waitcnt vmcnt(0)" ::: "memory");
            const unsigned og = xb_add(&bar[XB_TOP], 1u);
            const unsigned tg = og / nx;
            if (og + 1u == (tg + 1u) * nx) xb_add(&bar[XB_TOPGEN], 1u);
            else XB_SPIN(xb_ld(&bar[XB_TOPGEN]) == tg, bar);
            __builtin_amdgcn_fence(__ATOMIC_ACQUIRE, "agent");
            xb_add(&bar[XB_XGEN(b.x)], 1u);
            asm volatile("s_waitcnt vmcnt(0)" ::: "memory");
        } else {
            XB_SPIN(xb_ld(&bar[XB_XGEN(b.x)]) == gen, bar);
            __builtin_amdgcn_fence(__ATOMIC_ACQUIRE, "agent");
            asm volatile("s_waitcnt vmcnt(0)" ::: "memory");
        }
    }
    __syncthreads();
}

struct TrItem { f32x4 v[8]; bf16* dst; int K; unsigned char* dst8; };
__device__ __forceinline__ void tr_issue(TrItem& t, const float* W, int K, int N, bf16* WT, int dst_row0, int k0, int n0, int lane, unsigned char* WT8 = nullptr) {
    const float* wp = W + (size_t)(k0 + (lane >> 3)) * N + n0 + 4 * (lane & 7);
#pragma unroll
    for (int i = 0; i < 8; ++i) t.v[i] = __builtin_nontemporal_load((const f32x4*)(wp + (size_t)(8 * i) * N));
    t.dst = WT + (size_t)dst_row0 * K + k0; t.K = K; t.dst8 = WT8 ? WT8 + (size_t)dst_row0 * K + k0 : nullptr;
}
__device__ __forceinline__ void tr_finish(const TrItem& t, LAS float* scr, int lane) {
#pragma unroll
    for (int i = 0; i < 8; ++i) { LAS float* p = scr + (8 * i + (lane >> 3)) * 33 + 4 * (lane & 7); p[0] = t.v[i][0]; p[1] = t.v[i][1]; p[2] = t.v[i][2]; p[3] = t.v[i][3]; }
    asm volatile("s_waitcnt lgkmcnt(0)" ::: "memory");
    const int c = lane & 7;
    if (t.dst8) {
#pragma unroll
        for (int j = 0; j < 4; ++j) { const int n = (lane >> 3) + 8 * j; const LAS float* s = scr + (8 * c) * 33 + n;
            u32x2 o; o.x = pack4_e4m3(s[0 * 33] * W8_SCALE, s[1 * 33] * W8_SCALE, s[2 * 33] * W8_SCALE, s[3 * 33] * W8_SCALE); o.y = pack4_e4m3(s[4 * 33] * W8_SCALE, s[5 * 33] * W8_SCALE, s[6 * 33] * W8_SCALE, s[7 * 33] * W8_SCALE);
            __builtin_nontemporal_store(o, (u32x2*)(t.dst8 + (size_t)n * t.K + 8 * c)); }
    } else {
#pragma unroll
    for (int j = 0; j < 4; ++j) { const int n = (lane >> 3) + 8 * j; const LAS float* s = scr + (8 * c) * 33 + n;
        u32x4 o; o.x = pk2(s[0 * 33], s[1 * 33]); o.y = pk2(s[2 * 33], s[3 * 33]); o.z = pk2(s[4 * 33], s[5 * 33]); o.w = pk2(s[6 * 33], s[7 * 33]);
        __builtin_nontemporal_store(o, (u32x4*)(t.dst + (size_t)n * t.K + 8 * c)); }
    }
    asm volatile("s_waitcnt lgkmcnt(0)" ::: "memory");
}
__device__ __forceinline__ void p0_transpose_item(const float* W, int K, int N, bf16* WT, int dst_row0, LAS float* scr, int k0, int n0, int lane, unsigned char* WT8 = nullptr) {
    TrItem t; tr_issue(t, W, K, N, WT, dst_row0, k0, n0, lane, WT8); tr_finish(t, scr, lane);
}
struct TrItem8 { f32x4 v[16]; unsigned char* dst8; int K; };
__device__ __forceinline__ void tr8_issue(TrItem8& t, const float* W, int K, int N, unsigned char* WT8, int dst_row0, int k0, int n0, int lane) {
    const float* wp = W + (size_t)(k0 + (lane >> 3)) * N + n0 + 4 * (lane & 7);
#pragma unroll
    for (int i = 0; i < 16; ++i) t.v[i] = __builtin_nontemporal_load((const f32x4*)(wp + (size_t)(8 * i) * N));
    t.dst8 = WT8 + (size_t)dst_row0 * K + k0; t.K = K;
}
__device__ __forceinline__ void tr8_finish(const TrItem8& t, LAS float* scr, int lane) {
    const int r = lane >> 3, c = lane & 7;
#pragma unroll
    for (int i = 0; i < 16; ++i) { const int k = 8 * i + r, sw = (r ^ (i >> 1)) & 7; *(LAS f32x4*)(scr + k * 32 + ((c ^ sw) << 2)) = t.v[i]; }
    asm volatile("s_waitcnt lgkmcnt(0)" ::: "memory");
#pragma unroll
    for (int j = 0; j < 4; ++j) { const int n = r + 8 * j; float f[16];
#pragma unroll
        for (int kk = 0; kk < 16; ++kk) { const int k = 16 * c + kk, sw = ((kk & 7) ^ c) & 7; f[kk] = scr[k * 32 + ((((n >> 2) ^ sw) & 7) << 2) + (n & 3)] * W8_SCALE; }
        u32x4 o; o.x = pack4_e4m3(f[0], f[1], f[2], f[3]); o.y = pack4_e4m3(f[4], f[5], f[6], f[7]); o.z = pack4_e4m3(f[8], f[9], f[10], f[11]); o.w = pack4_e4m3(f[12], f[13], f[14], f[15]);
        __builtin_nontemporal_store(o, (u32x4*)(t.dst8 + (size_t)n * t.K + 16 * c)); }
    asm volatile("s_waitcnt lgkmcnt(0)" ::: "memory");
}
__device__ __forceinline__ int map_gu(int n0) { return n0 < EFF ? 256 * (n0 >> 7) + (n0 & 127) : 256 * ((n0 - EFF) >> 7) + 128 + ((n0 - EFF) & 127); }

struct Args {
    const float *x, *mem, *w_in, *b_gate, *w_mem_kv, *sinks, *w_o_sb, *w_o_swa, *w_o_mem, *w_out, *ln1_g, *ln1_b, *w_router, *router_bias, *w_e_gu, *w_e_down, *w_s_gu, *w_s_down, *ln2_g, *ln2_b;
    float* out; unsigned char* ws; int ph_lo, ph_hi, li, pad;
};

__global__ void __launch_bounds__(NWAVES * 64, 2) mega_fwd(Args a) {
    extern __shared__ __attribute__((aligned(16))) unsigned char lds_raw[];
    LAS unsigned char* lds = (LAS unsigned char*)lds_raw;
    volatile LAS unsigned* MISC = (volatile LAS unsigned*)(lds + MISC_OFF);
    const int wave = __builtin_amdgcn_readfirstlane((int)threadIdx.x >> 6);
    const int G = gridDim.x, bx = blockIdx.x;
    const int vcu = (G % 8 == 0) ? (bx % 8) * (G / 8) + bx / 8 : bx;
    const int gw = vcu * NWAVES + wave, NGW = G * NWAVES;
    unsigned char* ws = a.ws;
    unsigned* ctl = (unsigned*)(ws + WS_CTL);
    for (int u = otid(wave); u < (LDS_BYTES - LDSCTL_OFF) / 4; u += NWAVES * 64) ((LAS unsigned*)(lds + LDSCTL_OFF))[u] = 0u;
    __syncthreads();
    XcdBarrier bar = xcd_barrier_post(ctl + CW_BAR + a.li * XCD_BAR_WORDS, MISC + 8, wave);
    const int lo = a.ph_lo, hi = a.ph_hi;
#define IN(k) (lo <= (k) && (k) < hi)
#define SEAM(k) do { if (IN(k) && IN((k) + 1)) xcd_barrier(bar); } while (0)
#define PH_BEGIN(k) if (IN(k)) { const int tid = otid(wave), lane = tid & 63; (void)tid; (void)lane;
#define PH_END(k) } SEAM(k);
    bf16* WIN_T = (bf16*)(ws + WS_WIN_T); bf16* WMKV_T = (bf16*)(ws + WS_WMKV_T); bf16* WOSB_T = (bf16*)(ws + WS_WOSB_T); bf16* WOSW_T = (bf16*)(ws + WS_WOSW_T); bf16* WOM_T = (bf16*)(ws + WS_WOM_T);
    bf16* WOUT_T = (bf16*)(ws + WS_WOUT_T); bf16* WRS_T = (bf16*)(ws + WS_WRS_T); bf16* WSD_T = (bf16*)(ws + WS_WSD_T); bf16* WEGU_T = (bf16*)(ws + WS_WEGU_T); bf16* WED_T = (bf16*)(ws + WS_WED_T);
    bf16* XB = (bf16*)(ws + WS_XB); bf16* MEMB = (bf16*)(ws + WS_MEMB); bf16* MKVB = (bf16*)(ws + WS_MKVB); bf16* PROJB = (bf16*)(ws + WS_PROJB);
    bf16* OSB = (bf16*)(ws + WS_OSB); bf16* OSW = (bf16*)(ws + WS_OSW); bf16* OM = (bf16*)(ws + WS_OM); bf16* MERGED = (bf16*)(ws + WS_MERGED);
    bf16* Z = (bf16*)(ws + WS_Z); bf16* X1B = (bf16*)(ws + WS_X1B); float* LOGITS = (float*)(ws + WS_LOGITS); bf16* HS = (bf16*)(ws + WS_HS); bf16* SHOUT = (bf16*)(ws + WS_SHOUT);
    int* IDX = (int*)(ws + WS_ROUTE + RT_IDX); float* WGT = (float*)(ws + WS_ROUTE + RT_WGT); int* POS = (int*)(ws + WS_ROUTE + RT_POS); int* STOK = (int*)(ws + WS_ROUTE + RT_STOK);
    int* TILES = (int*)(ws + WS_ROUTE + RT_TILES); int* TILES64 = (int*)(ws + WS_ROUTE + RT_TILES64);
    unsigned char* XB8 = ws + WS_XB8; unsigned char* X1B8 = ws + WS_X1B8; unsigned char* WG8_T = ws + WS_WG8_T;
    bf16* HBUF = (bf16*)(ws + WS_HBUF); unsigned char* YS = (unsigned char*)(ws + WS_YS);

    PH_BEGIN(0)
        LAS float* scr = (LAS float*)(lds + wave * 16384);
        constexpr int I_IN = 16 * 184, I_MKV = 16 * 32, I_O = 8 * 32, I_OUT = 16 * 32, I_SGU = 16 * 16, I_R = 16 * 8, I_SD = 4 * 32, I_EGU = 16 * 16, I_ED = 4 * 32;
        constexpr int SMALL = I_IN + I_MKV + 3 * I_O + I_OUT + I_SGU + I_R + I_SD, NITEMS = SMALL;
        for (int it = gw; it < SMALL; it += NGW) {
            int r = it;
            if (r < I_IN) { const int nb = r % 184, kb = r / 184;
                if (nb < 88) p0_transpose_item(a.w_in, D, IN_COLS, WIN_T, 32 * nb, scr, 64 * kb, 32 * nb, lane);
                else p0_transpose_item(a.w_in, D, IN_COLS, WIN_T, 32 * (nb - 88), scr, 64 * kb, 32 * nb, lane, WG8_T);
                continue; } r -= I_IN;
            if (r < I_MKV) { p0_transpose_item(a.w_mem_kv, D, 1024, WMKV_T, 32 * (r % 32), scr, 64 * (r / 32), 32 * (r % 32), lane); continue; } r -= I_MKV;
            if (r < I_O) { p0_transpose_item(a.w_o_sb, 512, D, WOSB_T, 32 * (r % 32), scr, 64 * (r / 32), 32 * (r % 32), lane, (unsigned char*)WOSB_T); continue; } r -= I_O;
            if (r < I_O) { p0_transpose_item(a.w_o_swa, 512, D, WOSW_T, 32 * (r % 32), scr, 64 * (r / 32), 32 * (r % 32), lane, (unsigned char*)WOSW_T); continue; } r -= I_O;
            if (r < I_O) { p0_transpose_item(a.w_o_mem, 512, D, WOM_T, 32 * (r % 32), scr, 64 * (r / 32), 32 * (r % 32), lane, (unsigned char*)WOM_T); continue; } r -= I_O;
            if (r < I_OUT) { p0_transpose_item(a.w_out, D, D, WOUT_T, 32 * (r % 32), scr, 64 * (r / 32), 32 * (r % 32), lane, (unsigned char*)WOUT_T); continue; } r -= I_OUT;
            if (r < I_SGU) { p0_transpose_item(a.w_s_gu, D, 512, WRS_T, map_gu(32 * (r % 16)), scr, 64 * (r / 16), 32 * (r % 16), lane, (unsigned char*)WRS_T); continue; } r -= I_SGU;
            if (r < I_R) { p0_transpose_item(a.w_router, D, NE, WRS_T, 512 + 32 * (r % 8), scr, 64 * (r / 8), 32 * (r % 8), lane); continue; } r -= I_R;
            p0_transpose_item(a.w_s_down, EFF, D, WSD_T, 32 * (r % 32), scr, 64 * (r / 32), 32 * (r % 32), lane, (unsigned char*)WSD_T);
        }
        thin::cvt_rows(a.x, XB, XB8, T, gw, NGW, lane);
        thin::cvt_rows(a.mem, MEMB, nullptr, MROWS, gw, NGW, lane);
    PH_END(0)
    PH_BEGIN(1)
        const int GG = G - NCONV;
        if (bx >= GG) {
            LAS float* scr = (LAS float*)(lds + wave * 16384);
            constexpr int I_EGU = 8 * 16, I_ED = 2 * 32;
            const int cw = (bx - GG) * NWAVES + wave, ncw = NCONV * NWAVES;
            constexpr int NIT = NE * (I_EGU + I_ED);
#define EXP_ISSUE(t, r_) do { const int ri_ = (r_) < NIT ? (r_) : rlast;     \
                const bool gu = ri_ < NE * I_EGU; const int r2 = gu ? ri_ : ri_ - NE * I_EGU; const int per = gu ? I_EGU : I_ED, nbs = gu ? 16 : 32; \
                const int e = r2 / per, q = r2 % per, kb = q / nbs, nb = q % nbs; \
                const float* W = gu ? a.w_e_gu + (size_t)e * D * 512 : a.w_e_down + (size_t)e * EFF * D; \
                unsigned char* W8 = gu ? (unsigned char*)WEGU_T + (size_t)e * 512 * D : (unsigned char*)WED_T + (size_t)e * D * EFF; \
                tr8_issue(t, W, gu ? D : EFF, gu ? 512 : D, W8, gu ? map_gu(32 * nb) : 32 * nb, 128 * kb, 32 * nb, lane); } while (0)
            TrItem8 tA, tB;
            const int nmine = (NIT - cw + ncw - 1) / ncw, rlast = cw + (nmine - 1) * ncw;
            int r = cw;
            EXP_ISSUE(tA, r);
            for (; r < NIT; r += 2 * ncw) {
                EXP_ISSUE(tB, r + ncw); tr8_finish(tA, scr, lane);
                EXP_ISSUE(tA, r + 2 * ncw); tr8_finish(tB, scr, lane);
            }
#undef EXP_ISSUE
        } else {
        LAS float* bias_lds = (LAS float*)(lds + BIAS_OFF);
        for (int i = tid; i < 3 * D; i += NWAVES * 64) bias_lds[i] = a.b_gate[i] * -LOG2E - LOG2_255;
        __syncthreads();
        { pg8::GridOrder S; S.init(T, OFF_GATE, D, GG, bx, 1); S.A0 = (unsigned)WS_XB; S.B0 = (unsigned)WS_WIN_T;
          pg8::EpiProj E{PROJB};
          pg8::gemm_phase<pg8::EpiProj, pg8::GridOrder, false>(lds, ws, D, S, E, wave); }
        { pg8::GridOrder S; S.init(T, 3 * D, D / 2, GG, (bx + GG - ((T / 256) * (OFF_GATE / 256)) % GG) % GG, 1); S.A0 = (unsigned)WS_XB8; S.B0 = (unsigned)WS_WG8_T;
          pg8::EpiGate8 E{bias_lds, ws + WS_GT};
          pg8::gemm_phase<pg8::EpiGate8, pg8::GridOrder, false, false, true>(lds, ws, D / 2, S, E, wave); }
        { pg8::GridOrder S; S.init(MROWS, 1024, D, GG, GG - 1 - bx, 1); S.A0 = (unsigned)WS_MEMB; S.B0 = (unsigned)WS_WMKV_T;
          pg8::EpiBf16 E{MKVB, 1024, 1.f};
          pg8::gemm_phase<pg8::EpiBf16, pg8::GridOrder, false>(lds, ws, D, S, E, wave); }
        }
    PH_END(1)
    PH_BEGIN(2)
        const att::Params P{PROJB, MKVB, a.sinks, (unsigned char*)OSB, (unsigned char*)OSW, (unsigned char*)OM};
        att::phase((LAS char*)lds, P, ctl + CW_QUEUE + 64 * (a.li & 15), a.pad == 1 ? 512 : (a.pad == 2 ? 1536 : 0), a.pad == 3 ? 512 : (a.pad == 1 ? 1536 : att::NUNITS), wave);
    PH_END(2)
    PH_BEGIN(3)
        pg8::GridOrder S; S.init(T, D, 512 / 2, G, bx, 3);
        S.A0 = (unsigned)WS_OSB; S.B0 = (unsigned)WS_WOSB_T; S.asub = (unsigned)(WS_OSW - WS_OSB); S.bsub = (unsigned)(WS_WOSW_T - WS_WOSB_T);
        pg8::EpiOutProj E{(unsigned char*)MERGED, (const u32x4*)(ws + WS_GT)};
        pg8::gemm_phase<pg8::EpiOutProj, pg8::GridOrder, false, false, true>(lds, ws, 512 / 2, S, E, wave);
    PH_END(3)
    PH_BEGIN(4)
        pg8::GridOrder S; S.init(T, D, D / 2, G, bx, 1); S.A0 = (unsigned)WS_MERGED; S.B0 = (unsigned)WS_WOUT_T;
        pg8::EpiY E{Z, XB};
        pg8::gemm_phase<pg8::EpiY, pg8::GridOrder, false, false, true>(lds, ws, D / 2, S, E, wave);
    PH_END(4)
    PH_BEGIN(5) thin::ln1_rows(Z, a.ln1_g, a.ln1_b, X1B, X1B8, gw, NGW, lane); PH_END(5)
    PH_BEGIN(6)
        const bool split = (G % 16 == 0); const int Gs = split ? G / 2 : G, cs = split ? (((bx >> 4) << 3) | (bx & 7)) : bx, side = (bx >> 3) & 1;
        if (!split || side == 0) { pg8::GridOrder S; S.init(T, NE, D, Gs, cs, 1); S.A0 = (unsigned)WS_X1B; S.B0 = (unsigned)(WS_WRS_T + (size_t)512 * D * 2);
            pg8::EpiRouter E{LOGITS};
            pg8::gemm_phase<pg8::EpiRouter, pg8::GridOrder, false>(lds, ws, D, S, E, wave); }
        if (!split || side == 1) { pg8::GridOrder S; S.init(T, 2 * EFF, D / 2, Gs, cs, 1); S.A0 = (unsigned)WS_X1B8; S.B0 = (unsigned)WS_WRS_T;
            pg8::EpiShared8 E{(unsigned char*)HS};
            pg8::gemm_phase<pg8::EpiShared8, pg8::GridOrder, false, false, true>(lds, ws, D / 2, S, E, wave); }
    PH_END(6)
    PH_BEGIN(7) thin::route(LOGITS, a.router_bias, POS  , WGT, ctl + CW_COUNTS, (int*)(ws + WS_STOK2), (LAS int*)lds, bx, G, tid); PH_END(7)
    PH_BEGIN(9)
        { LAS int* tab = (LAS int*)(lds + BIAS_OFF);
          const int ntiles = __builtin_amdgcn_readfirstlane(pg8::build_tile_map(ctl + CW_COUNTS, tab, tid));
          pg8::ExpertOrder S; S.offs = tab; S.cnt = tab + 256; S.tmap = (const LAS unsigned short*)(tab + 512); S.nN = 2; S.nwg = ntiles * 2; S.G = G; S.c = bx; S.A = (unsigned)WS_X1B8; S.rows = (const int*)(ws + WS_STOK2); S.arow = 0; S.Bb = (unsigned)WS_WEGU_T; S.bexp = (unsigned)(512 * D); S.bstep = (unsigned)(256 * D);
          pg8::EpiExpGU8 E{(unsigned char*)HBUF};
          pg8::gemm_phase<pg8::EpiExpGU8, pg8::ExpertOrder, true, false, true>(lds, ws, D / 2, S, E, wave); }
    PH_END(9)
    PH_BEGIN(10)
        LAS int* tab = (LAS int*)(lds + BIAS_OFF);
        (void)pg8::build_tile_map(ctl + CW_COUNTS, tab, tid);
        LAS int* srt = tab + 1280;
        if (tid < NE) { const int ce = tab[256 + tid]; int rk = 0; for (int j = 0; j < NE; ++j) { const int cj = tab[256 + j]; rk += (cj > ce || (cj == ce && j < tid)) ? 1 : 0; } srt[rk] = tid; }
        __syncthreads();
        pg8::down_phase(lds, ws, tab, tab + 256, srt, G, bx, (unsigned)WS_HBUF, (unsigned)WS_WED_T, (unsigned)WS_YS, (unsigned)WS_HS, (unsigned)WS_WSD_T, (unsigned)WS_SHOUT, (unsigned)(WS_CTL + 768 * 1024), YS_SCALE / (W8_SCALE * H8_SCALE), wave, HYBRID ? a.pad : 0);
    PH_END(10)
    PH_BEGIN(11) LAS int* tab = (LAS int*)(lds + BIAS_OFF); (void)pg8::build_tile_map(ctl + CW_COUNTS, tab, tid);
        thin::final_rows(X1B, (const unsigned char*)SHOUT, YS, POS, tab, WGT, a.ln2_g, a.ln2_b, a.out, gw, NGW, lane); PH_END(11)
#undef IN
#undef SEAM
#undef PH_BEGIN
#undef PH_END
}
extern "C" void kernel_launch(void* const* d_in, const int* in_sizes, int n_in, void* d_out, int out_size, void* d_ws, size_t ws_size, hipStream_t stream) {
    static int grid = 0;
    if (grid == 0) {
        if (n_in != 20 || in_sizes[0] != T * D || out_size != T * D || ws_size < WS_END) { fprintf(stderr, "kernel_launch: unexpected problem shape / workspace (%d inputs, ws %zu)\n", n_in, ws_size); grid = -1; return; }
        int dev = 0, cus = 0;
        if (hipGetDevice(&dev) != hipSuccess || hipDeviceGetAttribute(&cus, hipDeviceAttributeMultiprocessorCount, dev) != hipSuccess) { grid = -1; return; }
        if (hipFuncSetAttribute((const void*)mega_fwd, hipFuncAttributeMaxDynamicSharedMemorySize, LDS_BYTES) != hipSuccess) { fprintf(stderr, "kernel_launch: hipFuncSetAttribute failed\n"); grid = -1; return; }
        (void)hipGetLastError();
        grid = cus;
    }
    if (grid < 0) return;
    (void)hipMemsetAsync((char*)d_ws + WS_CTL, 0, CTL_ZERO_BYTES, stream);
    Args a{};
    const float** f = (const float**)&a;
    for (int i = 0; i < 20; ++i) f[i] = (const float*)d_in[i];
    a.out = (float*)d_out; a.ws = (unsigned char*)d_ws;
#if HYBRID
#ifndef PROBE_ATT_MODE
#define PROBE_ATT_MODE 0
#endif
    unsigned char* ws = (unsigned char*)d_ws;
    bf16* XB = (bf16*)(ws + WS_XB); bf16* MEMB = (bf16*)(ws + WS_MEMB); bf16* MKVB = (bf16*)(ws + WS_MKVB); bf16* PROJB = (bf16*)(ws + WS_PROJB);
    bf16* OSB = (bf16*)(ws + WS_OSB); bf16* OSW = (bf16*)(ws + WS_OSW); bf16* OM = (bf16*)(ws + WS_OM); bf16* MERGED = (bf16*)(ws + WS_MERGED);
    bf16* Z = (bf16*)(ws + WS_Z); bf16* X1B = (bf16*)(ws + WS_X1B); float* LOGITS = (float*)(ws + WS_LOGITS); bf16* HS = (bf16*)(ws + WS_HS); bf16* SHOUT = (bf16*)(ws + WS_SHOUT);
    int* STOK = (int*)(ws + WS_ROUTE + RT_STOK); int* TILES64 = (int*)(ws + WS_ROUTE + RT_TILES64);
    bf16* HBUF = (bf16*)(ws + WS_HBUF); bf16* YS = (bf16*)(ws + WS_YS);
    float* SCR = (float*)(ws + WS_YS);
    static const int opt[NPHASE] = HYBRID_OPT;
#ifdef PROBE_REPS
    static const int reps[NPHASE] = PROBE_REPS;
#else
    static const int reps[NPHASE] = {1, 1, 1, 1, 1, 1, 1, 1, 1, 1, 1, 1};
#endif
    int li = 0;
    for (int p = 0; p < NPHASE; ++p) {
        if (opt[p]) { for (int r = 0; r < reps[p]; ++r) { a.ph_lo = p; a.ph_hi = p + 1; a.li = (li++) & 15; a.pad = (r + 1 < reps[p]) ? PROBE_ATT_MODE : 0;     hipLaunchKernelGGL(mega_fwd, dim3(grid), dim3(NWAVES * 64), LDS_BYTES, stream, a); }
#ifdef ATT_DIFF_TEST
        if (p == 2 && opt[p]) {
            bf16* nsb = (bf16*)(ws + WS_YS); bf16* nsw = nsb + (size_t)T * 512; bf16* nm = nsw + (size_t)T * 512;
            nv::k_sb_attn<<<BATCH * 8 * (SEQ / 64), 64, 0, stream>>>(PROJB, nsb);
            nv::k_swa_attn<<<BATCH * 8 * (SEQ / 64), 64, 0, stream>>>(PROJB, a.sinks, nsw);
            nv::k_mem_attn<<<BATCH * 4 * 2 * (SEQ / 64), 64, 0, stream>>>(PROJB, MKVB, nm);
            unsigned* cw = (unsigned*)(ws + WS_CTL);
            nv::k_maxdiff<<<1024, 256, 0, stream>>>(OSB, nsb, (size_t)T * 512, cw + (ATT_DIFF_TEST == 1 ? 900 : 910));
            nv::k_maxdiff<<<1024, 256, 0, stream>>>(OSW, nsw, (size_t)T * 512, cw + (ATT_DIFF_TEST == 2 ? 900 : 911));
            nv::k_maxdiff<<<1024, 256, 0, stream>>>(OM, nm, (size_t)T * 512, cw + (ATT_DIFF_TEST == 3 ? 900 : 912));
        }
        if (p == NPHASE - 1) nv::k_scale_out<<<1024, 256, 0, stream>>>((float*)d_out, (size_t)T * D, (const unsigned*)(ws + WS_CTL) + 900);
#endif
            continue; }
        switch (p) {
        case 1:
            nv::k_gemm<nv::M_PROJ><<<dim3(IN_COLS / 64, T / 64), 256, 0, stream>>>(XB, D, a.w_in, IN_COLS, PROJB, IN_COLS, D, nullptr, 0, a.b_gate, nullptr);
            nv::k_gemm<nv::M_BF16><<<dim3(1024 / 64, MROWS / 64), 256, 0, stream>>>(MEMB, D, a.w_mem_kv, 1024, MKVB, 1024, D, nullptr, 0, nullptr, nullptr);
            break;
        case 2:
            nv::k_sb_attn<<<BATCH * 8 * (SEQ / 64), 64, 0, stream>>>(PROJB, OSB);
            nv::k_swa_attn<<<BATCH * 8 * (SEQ / 64), 64, 0, stream>>>(PROJB, a.sinks, OSW);
            nv::k_mem_attn<<<BATCH * 4 * 2 * (SEQ / 64), 64, 0, stream>>>(PROJB, MKVB, OM);
            break;
        case 3:
            nv::k_gemm<nv::M_GSET><<<dim3(D / 64, T / 64), 256, 0, stream>>>(OSB, 512, a.w_o_sb, D, nullptr, 0, 512, PROJB + OFF_GATE, IN_COLS, nullptr, SCR);
            nv::k_gemm<nv::M_GADD><<<dim3(D / 64, T / 64), 256, 0, stream>>>(OSW, 512, a.w_o_swa, D, nullptr, 0, 512, PROJB + OFF_GATE + D, IN_COLS, nullptr, SCR);
            nv::k_gemm<nv::M_GFIN><<<dim3(D / 64, T / 64), 256, 0, stream>>>(OM, 512, a.w_o_mem, D, MERGED, D, 512, PROJB + OFF_GATE + 2 * D, IN_COLS, nullptr, SCR);
            break;
        case 4:
            nv::k_gemm<nv::M_Y><<<dim3(D / 64, T / 64), 256, 0, stream>>>(MERGED, D, a.w_out, D, Z, D, D, a.x, D, nullptr, nullptr);
            break;
        case 6:
            nv::k_gemm<nv::M_F32><<<dim3(NE / 64, T / 64), 256, 0, stream>>>(X1B, D, a.w_router, NE, LOGITS, NE, D, nullptr, 0, nullptr, nullptr);
            nv::k_gu<<<dim3(EFF / 64, T / 64), 256, 0, stream>>>(X1B, nullptr, nullptr, a.w_s_gu, 0, HS);
            break;
        case 9:
            nv::k_gu<<<dim3(EFF / 64, MAXT64), 256, 0, stream>>>(X1B, STOK, TILES64, a.w_e_gu, (size_t)D * 2 * EFF, HBUF);
            nv::k_down<false><<<dim3(D / 64, T / 64), 256, 0, stream>>>(HS, nullptr, a.w_s_down, 0, SHOUT);
            break;
        case 10:
            nv::k_down<true><<<dim3(D / 64, MAXT64), 256, 0, stream>>>(HBUF, TILES64, a.w_e_down, (size_t)EFF * D, YS);
            break;
        default: break;
        }
    }
#else
    a.ph_lo = 0; a.ph_hi = NPHASE; a.li = 0;
    hipLaunchKernelGGL(mega_fwd, dim3(grid), dim3(NWAVES * 64), LDS_BYTES, stream, a);
#endif
}
```
